# Optimizing an MI355X kernel written in HIP

```python
import math
import jax, jax.numpy as jnp
from jax import lax
import numpy as np

D_MODEL = 1024
BATCH = 16
SEQ = 4096
DEPTH = 1

D_MIX = D_MODEL
MLA_HEADS = 4
MLA_NOPE = 128
MLA_ROPE = 64
MLA_QK = MLA_NOPE + MLA_ROPE
MLA_V = 128
MLA_Q_LORA = 384
MLA_KV_LORA = 256
DIFF_HEADS = 4
DIFF_DQK = 64
DIFF_DV = 2 * DIFF_DQK
IN_MLA = MLA_Q_LORA + MLA_KV_LORA + MLA_ROPE
IN_DIFF_Q = DIFF_HEADS * 2 * DIFF_DQK
IN_DIFF_V = DIFF_HEADS * DIFF_DV
IN_COLS = IN_MLA + 2 * IN_DIFF_Q + IN_DIFF_V
ROPE_THETA = 10000.0
Q_BLOCK = 128
RMS_EPS = 1e-6
PEER_HEADS = 8
PEER_NKEYS = 128
PEER_EXPERTS = PEER_NKEYS * PEER_NKEYS
PEER_DK_HALF = 128
PEER_TOPK = 16
PEER_CHUNK = 128
ADA_INIT = 0.2

kernel_name = "hybrid_mla_diffattn_peer_adaln"


def rms_norm(x, g):
    xf = x.astype(jnp.float32)
    y = xf * lax.rsqrt(jnp.mean(xf * xf, axis=-1, keepdims=True) + RMS_EPS)
    return (y * g.astype(jnp.float32)).astype(x.dtype)


def rope_tables(seq, dim):
    half = dim // 2
    inv = 1.0 / (ROPE_THETA ** (jnp.arange(half, dtype=jnp.float32) / half))
    ang = jnp.arange(seq, dtype=jnp.float32)[:, None] * inv[None, :]
    return jnp.cos(ang), jnp.sin(ang)


def apply_rope(x, cos, sin):
    half = x.shape[-1] // 2
    xf = x.astype(jnp.float32)
    x1, x2 = xf[..., :half], xf[..., half:]
    return jnp.concatenate([x1 * cos - x2 * sin, x2 * cos + x1 * sin], axis=-1).astype(x.dtype)


def causal_attention(qs, ks, coeffs, v, scale):
    B, H, S, dv = v.shape
    nb = S // Q_BLOCK
    qbs = tuple(q.reshape(B, H, nb, Q_BLOCK, q.shape[-1]).transpose(2, 0, 1, 3, 4) for q in qs)
    kpos = jnp.arange(S)

    def one_block(args):
        i, qb = args
        qpos = i * Q_BLOCK + jnp.arange(Q_BLOCK)
        mask = kpos[None, :] <= qpos[:, None]
        w = None
        for qi, ki, ci in zip(qb, ks, coeffs):
            s = jnp.einsum('bhqd,bhkd->bhqk', qi, ki).astype(jnp.float32) * scale
            p = jax.nn.softmax(jnp.where(mask, s, -jnp.inf), axis=-1)
            w = ci * p if w is None else w + ci * p
        return jnp.einsum('bhqk,bhkd->bhqd', w.astype(v.dtype), v)

    out = lax.map(one_block, (jnp.arange(nb), qbs))
    return out.transpose(1, 2, 0, 3, 4).reshape(B, H, S, dv)


def peer_ffn(h, w_q, sub_keys, u_tab, v_tab):
    T, D = h.shape
    hc = h.reshape(T // PEER_CHUNK, PEER_CHUNK, D)

    def one_chunk(hb):
        C = hb.shape[0]
        q = (hb @ w_q).reshape(C, PEER_HEADS, 2, PEER_DK_HALF)
        s = jnp.einsum('thpd,hpnd->thpn', q, sub_keys).astype(jnp.float32)
        sv, si = lax.top_k(s, PEER_TOPK)
        cand = sv[:, :, 0, :, None] + sv[:, :, 1, None, :]
        cidx = si[:, :, 0, :, None] * PEER_NKEYS + si[:, :, 1, None, :]
        cand = cand.reshape(C, PEER_HEADS, PEER_TOPK * PEER_TOPK)
        cidx = cidx.reshape(C, PEER_HEADS, PEER_TOPK * PEER_TOPK)
        fv, fpos = lax.top_k(cand, PEER_TOPK)
        eidx = jnp.take_along_axis(cidx, fpos, axis=-1).reshape(C, PEER_HEADS * PEER_TOPK)
        g = jax.nn.softmax(fv, axis=-1).reshape(C, PEER_HEADS * PEER_TOPK)
        u = u_tab[eidx]
        a = jax.nn.gelu(jnp.einsum('ted,td->te', u, hb).astype(jnp.float32), approximate=False)
        coef = (g * a).astype(hb.dtype)
        vv = v_tab[eidx]
        return jnp.einsum('te,ted->td', coef, vv)

    return lax.map(one_chunk, hc).reshape(T, D)


def setup_inputs(seed: int = 0) -> dict:
    key = jax.random.key(seed)
    keys = iter(jax.random.split(key, 40))

    def nrm(shape, scale):
        return jax.random.normal(next(keys), shape, jnp.float32) * scale

    def gain(shape):
        return 1.0 + nrm(shape, 0.02)

    L = DEPTH
    return {
        'x': nrm((BATCH, SEQ, D_MODEL), 1.0),
        'c': nrm((BATCH, D_MODEL), 1.0),
        'ada_w': nrm((L, D_MODEL, 6 * D_MODEL), ADA_INIT * D_MODEL ** -0.5),
        'ada_b': nrm((L, 6 * D_MODEL), 0.02),
        'norm1_g': gain((L, D_MODEL)),
        'w_in': nrm((L, D_MODEL, IN_COLS), D_MODEL ** -0.5),
        'mla_q_lat_g': gain((L, MLA_Q_LORA)),
        'mla_w_q_up': nrm((L, MLA_Q_LORA, MLA_HEADS * MLA_QK), MLA_Q_LORA ** -0.5),
        'mla_kv_lat_g': gain((L, MLA_KV_LORA)),
        'mla_w_kv_up': nrm((L, MLA_KV_LORA, MLA_HEADS * (MLA_NOPE + MLA_V)), MLA_KV_LORA ** -0.5),
        'mla_q_g': gain((L, MLA_QK)),
        'mla_k_g': gain((L, MLA_QK)),
        'diff_q_g': gain((L, DIFF_DQK)),
        'diff_k_g': gain((L, DIFF_DQK)),
        'diff_lq1': nrm((L, DIFF_DQK), 0.1),
        'diff_lk1': nrm((L, DIFF_DQK), 0.1),
        'diff_lq2': nrm((L, DIFF_DQK), 0.1),
        'diff_lk2': nrm((L, DIFF_DQK), 0.1),
        'diff_subln_g': gain((L, DIFF_DV)),
        'w_out': nrm((L, D_MIX, D_MODEL), D_MIX ** -0.5),
        'norm2_g': gain((L, D_MODEL)),
        'peer_w_q': nrm((L, D_MODEL, PEER_HEADS * 2 * PEER_DK_HALF), D_MODEL ** -0.5),
        'peer_sub_keys': nrm((L, PEER_HEADS, 2, PEER_NKEYS, PEER_DK_HALF), PEER_DK_HALF ** -0.5),
        'peer_u': nrm((L, PEER_EXPERTS, D_MODEL), D_MODEL ** -0.5),
        'peer_v': nrm((L, PEER_EXPERTS, D_MODEL), PEER_HEADS ** -0.5),
    }


def reference(x, c, ada_w, ada_b, norm1_g, w_in, mla_q_lat_g, mla_w_q_up, mla_kv_lat_g,
              mla_w_kv_up, mla_q_g, mla_k_g, diff_q_g, diff_k_g, diff_lq1, diff_lk1, diff_lq2,
              diff_lk2, diff_subln_g, w_out, norm2_g, peer_w_q, peer_sub_keys, peer_u, peer_v):
    B, S, D = x.shape
    cos_m, sin_m = rope_tables(S, MLA_ROPE)
    cos_d, sin_d = rope_tables(S, DIFF_DQK)

    for l in range(DEPTH):
        mod = jax.nn.silu(c) @ ada_w[l] + ada_b[l]
        sh1, sc1, g1, sh2, sc2, g2 = [m[:, None, :] for m in jnp.split(mod, 6, axis=-1)]

        h = rms_norm(x, norm1_g[l]) * (1.0 + sc1) + sh1
        proj = h @ w_in[l]
        o0 = MLA_Q_LORA
        o1 = o0 + MLA_KV_LORA
        o2 = o1 + MLA_ROPE
        o3 = o2 + IN_DIFF_Q
        o4 = o3 + IN_DIFF_Q
        q_lat, kv_lat, kpe_raw = proj[..., :o0], proj[..., o0:o1], proj[..., o1:o2]
        dq, dk, dv = proj[..., o2:o3], proj[..., o3:o4], proj[..., o4:]

        q = (rms_norm(q_lat, mla_q_lat_g[l]) @ mla_w_q_up[l]).reshape(B, S, MLA_HEADS, MLA_QK)
        q = q.transpose(0, 2, 1, 3)
        q_nope = rms_norm(q[..., :MLA_NOPE], mla_q_g[l, :MLA_NOPE])
        q_pe = apply_rope(rms_norm(q[..., MLA_NOPE:], mla_q_g[l, MLA_NOPE:]), cos_m, sin_m)
        kv = (rms_norm(kv_lat, mla_kv_lat_g[l]) @ mla_w_kv_up[l]).reshape(B, S, MLA_HEADS, MLA_NOPE + MLA_V)
        kv = kv.transpose(0, 2, 1, 3)
        k_nope = rms_norm(kv[..., :MLA_NOPE], mla_k_g[l, :MLA_NOPE])
        v_m = kv[..., MLA_NOPE:]
        k_pe = apply_rope(rms_norm(kpe_raw, mla_k_g[l, MLA_NOPE:])[:, None], cos_m, sin_m)
        k_m = jnp.concatenate([k_nope, jnp.broadcast_to(k_pe, (B, MLA_HEADS, S, MLA_ROPE))], axis=-1)
        q_m = jnp.concatenate([q_nope, q_pe], axis=-1)
        out_m = causal_attention((q_m,), (k_m,), (1.0,), v_m, MLA_QK ** -0.5)

        qd = dq.reshape(B, S, DIFF_HEADS, 2, DIFF_DQK).transpose(0, 2, 3, 1, 4)
        kd = dk.reshape(B, S, DIFF_HEADS, 2, DIFF_DQK).transpose(0, 2, 3, 1, 4)
        qd = apply_rope(rms_norm(qd, diff_q_g[l]), cos_d, sin_d)
        kd = apply_rope(rms_norm(kd, diff_k_g[l]), cos_d, sin_d)
        vd = dv.reshape(B, S, DIFF_HEADS, DIFF_DV).transpose(0, 2, 1, 3)
        lambda_init = 0.8 - 0.6 * math.exp(-0.3 * l)
        lam = (jnp.exp(jnp.sum(diff_lq1[l].astype(jnp.float32) * diff_lk1[l].astype(jnp.float32)))
               - jnp.exp(jnp.sum(diff_lq2[l].astype(jnp.float32) * diff_lk2[l].astype(jnp.float32)))
               + lambda_init)
        out_d = causal_attention((qd[:, :, 0], qd[:, :, 1]), (kd[:, :, 0], kd[:, :, 1]),
                                 (1.0, -lam), vd, DIFF_DQK ** -0.5)
        out_d = rms_norm(out_d, diff_subln_g[l]) * (1.0 - lambda_init)

        mixed = jnp.concatenate([out_m.transpose(0, 2, 1, 3).reshape(B, S, MLA_HEADS * MLA_V),
                                 out_d.transpose(0, 2, 1, 3).reshape(B, S, DIFF_HEADS * DIFF_DV)], axis=-1)
        x = x + g1 * (mixed @ w_out[l])

        h2 = rms_norm(x, norm2_g[l]) * (1.0 + sc2) + sh2
        y = peer_ffn(h2.reshape(B * S, D), peer_w_q[l], peer_sub_keys[l], peer_u[l], peer_v[l])
        x = x + g2 * y.reshape(B, S, D)
    return x
```

```cpp
#include <hip/hip_runtime.h>
#include <hip/hip_cooperative_groups.h>
#include <cstdio>
namespace cg = cooperative_groups;

typedef unsigned short u16;
typedef short bf16x8 __attribute__((ext_vector_type(8)));
typedef short s16x4 __attribute__((ext_vector_type(4)));
typedef float f32x16 __attribute__((ext_vector_type(16)));
typedef __bf16 bf2_t __attribute__((ext_vector_type(2)));
typedef unsigned u32x4 __attribute__((ext_vector_type(4)));
#define DI __device__ __forceinline__
#define LDSP(T, p) ((__attribute__((address_space(3))) T*)(p))
#define MFMA(a, b, c) __builtin_amdgcn_mfma_f32_32x32x16_bf16((a), (b), (c), 0, 0, 0)

#ifndef COOP
#define COOP 1
#endif

constexpr int S_ = 4096, T_ = 65536, NPROJ = 2304;
constexpr int LDH = 1088;
constexpr float EPS = 1e-6f;
constexpr float LOG2E = 1.4426950408889634f;
constexpr float NEG_INF = -__builtin_inff();
constexpr float U_SCALE = 64.f, V_SCALE = 5.656854f;
typedef float f32x2 __attribute__((ext_vector_type(2)));

constexpr size_t OFF_MOD = 0;
constexpr size_t OFF_LAM = 393216;
constexpr size_t OFF_CNT = 397312;
constexpr size_t OFF_ROPE = 524288;
constexpr size_t OFF_WIN = 1572864;
constexpr size_t OFF_WQ = 6291456;
constexpr size_t OFF_WKV = 6881280;
constexpr size_t OFF_WOUT = 7405568;
constexpr size_t OFF_WPQ = 9502720;
constexpr size_t OFF_SK = 13697024;
constexpr size_t OFF_U = 16777216;
constexpr size_t OFF_V = 50331648;
constexpr size_t OFF_H = 83886080;
constexpr size_t OFF_PROJ = 226492416;
constexpr size_t OFF_QM = 528482304;
constexpr size_t OFF_KM = 629145600;
constexpr size_t OFF_VM = 729808896;
constexpr size_t OFF_QD = 796917760;
constexpr size_t OFF_KD = 864026624;
constexpr size_t OFF_H2 = OFF_QM;
constexpr size_t OFF_TOPK = OFF_VM;
constexpr size_t OFF_ABUF = OFF_QD;

struct Params {
  const float* in[25];
  float* out;
  char* ws;
  int ph_begin, ph_end;
};

DI unsigned pk2(float a, float b) {
  bf2_t r; r[0] = (__bf16)a; r[1] = (__bf16)b; return __builtin_bit_cast(unsigned, r);
}
DI float bflo(unsigned u) { return __uint_as_float(u << 16); }
DI float bfhi(unsigned u) { return __uint_as_float(u & 0xffff0000u); }
DI float dot2bf(unsigned a, unsigned b, float c) {
  return __builtin_amdgcn_fdot2_f32_bf16(__builtin_bit_cast(bf2_t, a), __builtin_bit_cast(bf2_t, b), c, false);
}
DI float wave_sum(float v) {
#pragma unroll
  for (int o = 32; o; o >>= 1) v += __shfl_xor(v, o);
  return v;
}
DI int lbid() { int t = blockIdx.x; asm volatile("" : "+s"(t)); return t; }
DI int lgdim() { int t = gridDim.x; asm volatile("" : "+s"(t)); return t; }
DI int ltid() { int t = threadIdx.x; asm volatile("" : "+v"(t)); return t; }
DI s16x4 trread(const char* p) { return __builtin_amdgcn_ds_read_tr16_b64_v4i16(LDSP(s16x4, p)); }
DI int vblock() {
  int G = lgdim(), g = lbid();
  return ((G & 7) == 0) ? (g & 7) * (G >> 3) + (g >> 3) : g;
}

DI unsigned xcc_id() { return (unsigned)__builtin_amdgcn_s_getreg((3 << 11) | 20) & 0x7u; }
template <class F>
DI void xcd_tiles(char* ws, int set, int nft, F body) {
  __shared__ int sh_item;
  unsigned* cnt = (unsigned*)(ws + OFF_CNT);
  const int x0 = (int)xcc_id();
  const int per = 32 * nft;
  for (int q = 0; q < 8; ++q) {
    const int x = (x0 + q) & 7;
    for (;;) {
      __syncthreads();
      if (threadIdx.x == 0) sh_item = (int)atomicAdd(cnt + (set * 8 + x) * 32, 1u);
      __syncthreads();
      const int it = sh_item;
      if (it >= per) break;
      body(32 * x + it / nft, it % nft);
    }
  }
}

constexpr int G_ARS = 576;
constexpr int G_ASZ = 64 * G_ARS, G_BSZ = 256 * 144, G_STAGE = G_ASZ + G_BSZ;

template <int K, bool SUMSQ, class Epi>
DI void gemm_tile(const u16* __restrict__ W, int ldw, int n0, const u16* __restrict__ X, int ldx, size_t t0,
                  char* smem, Epi epi) {
  constexpr int KT = K / 64;
  const int tid = ltid(), lane = tid & 63, w = tid >> 6, h = lane >> 5, r = lane & 31;
  const int wf = w & 1, wt = w >> 1;
  const int blk = (lane >> 4) & 1, q4 = (lane & 15) >> 2, p4 = lane & 3;
  u32x4 ra[4], rb[4];
  const unsigned aoff = (unsigned)((tid >> 5) * ldw + (tid & 31) * 8), boff = (unsigned)((tid >> 3) * ldx + (tid & 7) * 8);
  const unsigned asoff = (unsigned)((tid >> 5) * G_ARS + (tid & 31) * 16), bsoff = (unsigned)(G_ASZ + (tid >> 3) * 144 + (tid & 7) * 16);
  auto gload = [&](int kt) __attribute__((always_inline)) {
    const u16* wk = W + (size_t)kt * 64 * ldw + n0;
    const u16* xk = X + t0 * (size_t)ldx + kt * 64;
#pragma unroll
    for (int i = 0; i < 4; ++i) ra[i] = *(const u32x4*)(wk + (size_t)i * 16 * ldw + aoff);
#pragma unroll
    for (int i = 0; i < 4; ++i) rb[i] = *(const u32x4*)(xk + (size_t)i * 64 * ldx + boff);
  };
  auto sstore = [&](char* buf) __attribute__((always_inline)) {
#pragma unroll
    for (int i = 0; i < 4; ++i) *(u32x4*)(buf + asoff + i * 16 * G_ARS) = ra[i];
#pragma unroll
    for (int i = 0; i < 4; ++i) *(u32x4*)(buf + bsoff + i * 64 * 144) = rb[i];
  };
  f32x16 acc[2][4];
#pragma unroll
  for (int g = 0; g < 2; ++g)
#pragma unroll
    for (int c = 0; c < 4; ++c)
#pragma unroll
      for (int i = 0; i < 16; ++i) acc[g][c][i] = 0.f;
  float ss0 = 0.f, ss1 = 0.f;
  auto compute = [&](const char* buf) __attribute__((always_inline)) {
    u32x4 bfr[2][2];
    s16x4 alo[2][4], ahi[2][4];
    auto lfrag = [&](int s, int slot) __attribute__((always_inline)) {
      bfr[slot][0] = *(const u32x4*)(buf + G_ASZ + (64 * wt + r) * 144 + (16 * s + 8 * h) * 2);
      bfr[slot][1] = *(const u32x4*)(buf + G_ASZ + (64 * wt + 32 + r) * 144 + (16 * s + 8 * h) * 2);
#pragma unroll
      for (int c = 0; c < 4; ++c) {
        const char* ap = buf + (16 * s + 8 * h + q4) * G_ARS + (128 * wf + 32 * c + 16 * blk) * 2 + 8 * p4;
        alo[slot][c] = trread(ap); ahi[slot][c] = trread(ap + 4 * G_ARS);
      }
    };
    lfrag(0, 0);
#pragma unroll
    for (int s = 0; s < 4; ++s) {
      if (s < 3) lfrag(s + 1, (s + 1) & 1);
      __builtin_amdgcn_sched_barrier(0);
      const u32x4 b0r = bfr[s & 1][0], b1r = bfr[s & 1][1];
      if (SUMSQ) {
        ss0 = dot2bf(b0r.x, b0r.x, ss0); ss0 = dot2bf(b0r.y, b0r.y, ss0);
        ss0 = dot2bf(b0r.z, b0r.z, ss0); ss0 = dot2bf(b0r.w, b0r.w, ss0);
        ss1 = dot2bf(b1r.x, b1r.x, ss1); ss1 = dot2bf(b1r.y, b1r.y, ss1);
        ss1 = dot2bf(b1r.z, b1r.z, ss1); ss1 = dot2bf(b1r.w, b1r.w, ss1);
      }
      const bf16x8 b0 = __builtin_bit_cast(bf16x8, b0r), b1 = __builtin_bit_cast(bf16x8, b1r);
#pragma unroll
      for (int c = 0; c < 4; ++c) {
        const bf16x8 a = __builtin_shufflevector(alo[s & 1][c], ahi[s & 1][c], 0, 1, 2, 3, 4, 5, 6, 7);
        acc[0][c] = MFMA(a, b0, acc[0][c]);
        acc[1][c] = MFMA(a, b1, acc[1][c]);
      }
      __builtin_amdgcn_sched_barrier(0);
    }
  };
  gload(0);
  sstore(smem);
  __syncthreads();
  for (int kt = 0; kt < KT; ++kt) {
    char* buf = smem + (kt & 1) * G_STAGE;
    if (kt + 1 < KT) gload(kt + 1);
    __builtin_amdgcn_sched_barrier(0);
    compute(buf);
    if (kt + 1 < KT) sstore(smem + ((kt + 1) & 1) * G_STAGE);
    __syncthreads();
  }
  if (SUMSQ) { ss0 += __shfl_xor(ss0, 32); ss1 += __shfl_xor(ss1, 32); }
  epi(acc[0], ss0, (int)t0 + 64 * wt + r, h, wf, smem + w * 17408, 0);
  epi(acc[1], ss1, (int)t0 + 64 * wt + 32 + r, h, wf, smem + w * 17408, 1);
}

DI void phase0(const Params& p, char* smem) {
  const int tid = ltid(), G = lgdim(), g = lbid();
  const size_t gt = (size_t)g * 512 + tid, NT = (size_t)G * 512;
  float* mod = (float*)(p.ws + OFF_MOD);
  for (int item = g; item < 96; item += G) {
    float* sc = (float*)smem;
    float* red = sc + 16384;
    for (int i = tid; i < 16384; i += 512) { float v = p.in[1][i]; sc[i] = v / (1.f + expf(-v)); }
    __syncthreads();
    const int col = tid & 63, kg = tid >> 6, n = item * 64 + col;
    float acc[16];
#pragma unroll
    for (int b = 0; b < 16; ++b) acc[b] = 0.f;
    const float* aw = p.in[2] + (size_t)(kg * 128) * 6144 + n;
#pragma unroll 4
    for (int k = 0; k < 128; ++k) {
      float wv = aw[(size_t)k * 6144];
#pragma unroll
      for (int b = 0; b < 16; ++b) acc[b] += sc[b * 1024 + kg * 128 + k] * wv;
    }
#pragma unroll
    for (int b = 0; b < 16; ++b) red[(kg * 16 + b) * 64 + col] = acc[b];
    __syncthreads();
    for (int o = tid; o < 1024; o += 512) {
      int b = o >> 6, cc = o & 63;
      float s = 0.f;
#pragma unroll
      for (int k2 = 0; k2 < 8; ++k2) s += red[(k2 * 16 + b) * 64 + cc];
      mod[b * 6144 + item * 64 + cc] = s + p.in[3][item * 64 + cc];
    }
    __syncthreads();
  }
  if (g == 0) {
    unsigned* cnt = (unsigned*)(p.ws + OFF_CNT);
    for (int i = tid; i < 8 * 8 * 32; i += 512) cnt[i] = 0u;
  }
  if (g == 0 && tid < 64) {
    float d1 = wave_sum(p.in[14][tid] * p.in[15][tid]);
    float d2 = wave_sum(p.in[16][tid] * p.in[17][tid]);
    if (tid == 0) *(float*)(p.ws + OFF_LAM) = expf(d1) - expf(d2) + 0.2f;
  }
  {
    float2* rope = (float2*)(p.ws + OFF_ROPE);
    for (size_t i = gt; i < 131072; i += NT) {
      int j = (int)(i & 31), sp = (int)(i >> 5);
      float inv = 1.0f / powf(10000.f, (float)j / 32.f);
      float ang = (float)sp * inv, sn, cs;
      sincosf(ang, &sn, &cs);
      rope[i] = make_float2(cs, sn);
    }
  }
  {
    u16* d = (u16*)(p.ws + OFF_WIN);
    for (size_t i = gt; i < (size_t)1024 * 2304; i += NT) {
      int k = (int)(i / 2304), n = (int)(i % 2304);
      float v = (n < 2240) ? p.in[5][(size_t)k * 2240 + n] : 0.f;
      d[i] = (u16)(pk2(v, 0.f) & 0xffff);
    }
  }
  {
    u16* d = (u16*)(p.ws + OFF_WQ);
    for (size_t i = gt; i < (size_t)384 * 768; i += NT) {
      int k = (int)(i / 768), n = (int)(i % 768);
      int src = (n < 512) ? (n >> 7) * 192 + (n & 127) : ((n - 512) >> 6) * 192 + 128 + ((n - 512) & 63);
      float v = p.in[7][(size_t)k * 768 + src] * p.in[6][k];
      d[i] = (u16)(pk2(v, 0.f) & 0xffff);
    }
  }
  {
    u16* d = (u16*)(p.ws + OFF_WKV);
    for (size_t i = gt; i < (size_t)256 * 1024; i += NT) {
      int k = (int)(i >> 10), n = (int)(i & 1023);
      int src = (n < 512) ? (n >> 7) * 256 + (n & 127) : ((n - 512) >> 7) * 256 + 128 + (n & 127);
      float v = p.in[9][(size_t)k * 1024 + src] * p.in[8][k];
      d[i] = (u16)(pk2(v, 0.f) & 0xffff);
    }
  }
  auto conv8 = [&](const float* src, u16* dst, size_t n8) __attribute__((always_inline)) {
    for (size_t i = gt; i < n8; i += NT) {
      float4 a = ((const float4*)src)[2 * i], b = ((const float4*)src)[2 * i + 1];
      uint4 o; o.x = pk2(a.x, a.y); o.y = pk2(a.z, a.w); o.z = pk2(b.x, b.y); o.w = pk2(b.z, b.w);
      ((uint4*)dst)[i] = o;
    }
  };
  conv8(p.in[19], (u16*)(p.ws + OFF_WOUT), (size_t)1024 * 1024 / 8);
  conv8(p.in[21], (u16*)(p.ws + OFF_WPQ), (size_t)1024 * 2048 / 8);
  conv8(p.in[22], (u16*)(p.ws + OFF_SK), (size_t)16 * 128 * 128 / 8);
}

DI void rownorm_phase(const Params& p, const float* src, const float* gain, int sh_off, int sc_off, u16* dst) {
  const int lane = ltid() & 63;
  const int gw = lbid() * 8 + (ltid() >> 6), NW = lgdim() * 8;
  const float* mod = (const float*)(p.ws + OFF_MOD);
  for (int t = gw; t < T_; t += NW) {
    const int b = t >> 12;
    const float* mb = mod + b * 6144;
#pragma unroll
    for (int c = 0; c < 2; ++c) {
    }
    float xv[16];
#pragma unroll
    for (int c = 0; c < 2; ++c) {
      const float4* sp = (const float4*)(src + (size_t)t * 1024 + c * 512 + lane * 8);
      float4 a = sp[0], bq = sp[1];
      xv[c * 8 + 0] = a.x; xv[c * 8 + 1] = a.y; xv[c * 8 + 2] = a.z; xv[c * 8 + 3] = a.w;
      xv[c * 8 + 4] = bq.x; xv[c * 8 + 5] = bq.y; xv[c * 8 + 6] = bq.z; xv[c * 8 + 7] = bq.w;
    }
    float ss = 0.f;
#pragma unroll
    for (int i = 0; i < 16; ++i) ss += xv[i] * xv[i];
    ss = wave_sum(ss);
    const float rinv = rsqrtf(ss * (1.f / 1024.f) + EPS);
#pragma unroll
    for (int c = 0; c < 2; ++c) {
      const int d0 = c * 512 + lane * 8;
      float o[8];
#pragma unroll
      for (int q = 0; q < 2; ++q) {
        float4 gg = *(const float4*)(gain + d0 + 4 * q);
        float4 sc = *(const float4*)(mb + sc_off + d0 + 4 * q);
        float4 sh = *(const float4*)(mb + sh_off + d0 + 4 * q);
        o[4 * q + 0] = xv[c * 8 + 4 * q + 0] * rinv * gg.x * (1.f + sc.x) + sh.x;
        o[4 * q + 1] = xv[c * 8 + 4 * q + 1] * rinv * gg.y * (1.f + sc.y) + sh.y;
        o[4 * q + 2] = xv[c * 8 + 4 * q + 2] * rinv * gg.z * (1.f + sc.z) + sh.z;
        o[4 * q + 3] = xv[c * 8 + 4 * q + 3] * rinv * gg.w * (1.f + sc.w) + sh.w;
      }
      uint4 ov; ov.x = pk2(o[0], o[1]); ov.y = pk2(o[2], o[3]); ov.z = pk2(o[4], o[5]); ov.w = pk2(o[6], o[7]);
      *(uint4*)(dst + (size_t)t * LDH + d0) = ov;
    }
  }
}

DI void store_tile_bf16_lds(f32x16 (&acc)[4], char* wsm, u16* dst0, size_t ld, int lane) {
  const int h = lane >> 5, r = lane & 31;
#pragma unroll
  for (int c = 0; c < 4; ++c)
#pragma unroll
    for (int gq = 0; gq < 4; ++gq) {
      uint2 v; v.x = pk2(acc[c][4 * gq], acc[c][4 * gq + 1]); v.y = pk2(acc[c][4 * gq + 2], acc[c][4 * gq + 3]);
      *(uint2*)(wsm + r * 272 + (32 * c + 8 * gq + 4 * h) * 2) = v;
    }
#pragma unroll
  for (int j = 0; j < 8; ++j) {
    const int idx = lane + 64 * j, row = idx >> 4, c16 = idx & 15;
    const u32x4 v = *(const u32x4*)(wsm + row * 272 + c16 * 16);
    *(u32x4*)(dst0 + (size_t)row * ld + c16 * 8) = v;
  }
}

template <class AddrFn>
DI void store_rows_bf16_lds(f32x16 (&acc)[4], char* wsm, int lane, AddrFn addr) {
  const int h = lane >> 5, r = lane & 31;
#pragma unroll
  for (int c = 0; c < 4; ++c)
#pragma unroll
    for (int gq = 0; gq < 4; ++gq) {
      uint2 v; v.x = pk2(acc[c][4 * gq], acc[c][4 * gq + 1]); v.y = pk2(acc[c][4 * gq + 2], acc[c][4 * gq + 3]);
      *(uint2*)(wsm + r * 272 + (32 * c + 8 * gq + 4 * h) * 2) = v;
    }
#pragma unroll
  for (int j = 0; j < 8; ++j) {
    const int idx = lane + 64 * j, row = idx >> 4, c16 = idx & 15;
    const u32x4 v = *(const u32x4*)(wsm + row * 272 + c16 * 16);
    *(u32x4*)addr(row, c16) = v;
  }
}

DI void store_tile_bf16(f32x16 (&acc)[4], u16* dstrow, int h) {
#pragma unroll
  for (int c = 0; c < 4; ++c)
#pragma unroll
    for (int gq = 0; gq < 4; ++gq) {
      uint2 v; v.x = pk2(acc[c][4 * gq], acc[c][4 * gq + 1]); v.y = pk2(acc[c][4 * gq + 2], acc[c][4 * gq + 3]);
      *(uint2*)(dstrow + 32 * c + 8 * gq + 4 * h) = v;
    }
}

DI void phase_qkv(const Params& p, char* smem) {
  const int G = lgdim(), vb = vblock();
  const u16* proj = (const u16*)(p.ws + OFF_PROJ);
  const float2* rope = (const float2*)(p.ws + OFF_ROPE);
  u16* Qm = (u16*)(p.ws + OFF_QM); u16* Km = (u16*)(p.ws + OFF_KM); u16* Vm = (u16*)(p.ws + OFF_VM);
  u16* Qd = (u16*)(p.ws + OFF_QD); u16* Kd = (u16*)(p.ws + OFF_KD);
  const float QS = 0.07216878364870322f * LOG2E;
  xcd_tiles(p.ws, 1, 3, [&](int tt, int ft2) __attribute__((always_inline)) {
    const float* qg = p.in[10];
    gemm_tile<384, true>((const u16*)(p.ws + OFF_WQ), 768, ft2 * 256, proj, NPROJ, (size_t)tt * 256, smem,
      [&](f32x16 (&acc)[4], float ss, int t, int h, int wf, char* wbase, int tg) __attribute__((always_inline)) {
        const int ft = ft2 * 2 + wf;
        const float rinv = rsqrtf(ss * (1.f / 384.f) + EPS);
        const int lane = ltid() & 63, tg0 = t & ~31, b = tg0 >> 12, s0 = tg0 & 4095, s = t & 4095;
        char* wsm = wbase + tg * 8704;
        if (ft < 4) {
          float s2 = 0.f;
#pragma unroll
          for (int c = 0; c < 4; ++c)
#pragma unroll
            for (int k = 0; k < 16; ++k) { float v = acc[c][k] * rinv; s2 += v * v; }
          s2 += __shfl_xor(s2, 32);
          const float r2 = rsqrtf(s2 * (1.f / 128.f) + EPS) * rinv * QS;
#pragma unroll
          for (int c = 0; c < 4; ++c)
#pragma unroll
            for (int gq = 0; gq < 4; ++gq) {
              const int d = 32 * c + 8 * gq + 4 * h;
              float4 gg = *(const float4*)(qg + d);
              acc[c][4 * gq] *= r2 * gg.x; acc[c][4 * gq + 1] *= r2 * gg.y;
              acc[c][4 * gq + 2] *= r2 * gg.z; acc[c][4 * gq + 3] *= r2 * gg.w;
            }
          u16* base = Qm + ((size_t)(b * 4 + ft) * S_ + s0) * 192;
          store_rows_bf16_lds(acc, wsm, lane, [&](int row, int c16) __attribute__((always_inline)) { return base + (size_t)row * 192 + c16 * 8; });
        } else {
#pragma unroll
          for (int cp = 0; cp < 2; ++cp) {
            float s2 = 0.f;
#pragma unroll
            for (int k = 0; k < 16; ++k) {
              float v1 = acc[2 * cp][k] * rinv, v2 = acc[2 * cp + 1][k] * rinv;
              s2 += v1 * v1 + v2 * v2;
            }
            s2 += __shfl_xor(s2, 32);
            const float r2 = rsqrtf(s2 * (1.f / 64.f) + EPS) * rinv;
#pragma unroll
            for (int gq = 0; gq < 4; ++gq) {
              const int j = 8 * gq + 4 * h;
              float4 g1 = *(const float4*)(qg + 128 + j), g2 = *(const float4*)(qg + 160 + j);
              const float4* rp = (const float4*)(rope + s * 32 + j);
              float4 cs01 = rp[0], cs23 = rp[1];
              float x1, x2;
              x1 = acc[2 * cp][4 * gq + 0] * r2 * g1.x; x2 = acc[2 * cp + 1][4 * gq + 0] * r2 * g2.x;
              acc[2 * cp][4 * gq + 0] = (x1 * cs01.x - x2 * cs01.y) * QS; acc[2 * cp + 1][4 * gq + 0] = (x2 * cs01.x + x1 * cs01.y) * QS;
              x1 = acc[2 * cp][4 * gq + 1] * r2 * g1.y; x2 = acc[2 * cp + 1][4 * gq + 1] * r2 * g2.y;
              acc[2 * cp][4 * gq + 1] = (x1 * cs01.z - x2 * cs01.w) * QS; acc[2 * cp + 1][4 * gq + 1] = (x2 * cs01.z + x1 * cs01.w) * QS;
              x1 = acc[2 * cp][4 * gq + 2] * r2 * g1.z; x2 = acc[2 * cp + 1][4 * gq + 2] * r2 * g2.z;
              acc[2 * cp][4 * gq + 2] = (x1 * cs23.x - x2 * cs23.y) * QS; acc[2 * cp + 1][4 * gq + 2] = (x2 * cs23.x + x1 * cs23.y) * QS;
              x1 = acc[2 * cp][4 * gq + 3] * r2 * g1.w; x2 = acc[2 * cp + 1][4 * gq + 3] * r2 * g2.w;
              acc[2 * cp][4 * gq + 3] = (x1 * cs23.z - x2 * cs23.w) * QS; acc[2 * cp + 1][4 * gq + 3] = (x2 * cs23.z + x1 * cs23.w) * QS;
            }
          }
          u16* base = Qm + ((size_t)(b * 4 + (ft - 4) * 2) * S_ + s0) * 192 + 128;
          store_rows_bf16_lds(acc, wsm, lane, [&](int row, int c16) __attribute__((always_inline)) {
            return base + (size_t)(c16 >> 3) * S_ * 192 + (size_t)row * 192 + (c16 & 7) * 8; });
        }
      });
  });
  xcd_tiles(p.ws, 2, 4, [&](int tt, int ft2) __attribute__((always_inline)) {
    const float* kg = p.in[11];
    gemm_tile<256, true>((const u16*)(p.ws + OFF_WKV), 1024, ft2 * 256, proj + 384, NPROJ, (size_t)tt * 256, smem,
      [&](f32x16 (&acc)[4], float ss, int t, int h, int wf, char* wbase, int tg) __attribute__((always_inline)) {
        const int ft = ft2 * 2 + wf;
        const float rinv = rsqrtf(ss * (1.f / 256.f) + EPS);
        const int lane = ltid() & 63, tg0 = t & ~31, b = tg0 >> 12, s0 = tg0 & 4095;
        char* wsm = wbase + tg * 8704;
        if (ft < 4) {
          float s2 = 0.f;
#pragma unroll
          for (int c = 0; c < 4; ++c)
#pragma unroll
            for (int k = 0; k < 16; ++k) { float v = acc[c][k] * rinv; s2 += v * v; }
          s2 += __shfl_xor(s2, 32);
          const float r2 = rsqrtf(s2 * (1.f / 128.f) + EPS) * rinv;
#pragma unroll
          for (int c = 0; c < 4; ++c)
#pragma unroll
            for (int gq = 0; gq < 4; ++gq) {
              const int d = 32 * c + 8 * gq + 4 * h;
              float4 gg = *(const float4*)(kg + d);
              acc[c][4 * gq] *= r2 * gg.x; acc[c][4 * gq + 1] *= r2 * gg.y;
              acc[c][4 * gq + 2] *= r2 * gg.z; acc[c][4 * gq + 3] *= r2 * gg.w;
            }
          u16* base = Km + ((size_t)(b * 4 + ft) * S_ + s0) * 192;
          store_rows_bf16_lds(acc, wsm, lane, [&](int row, int c16) __attribute__((always_inline)) { return base + (size_t)row * 192 + c16 * 8; });
        } else {
#pragma unroll
          for (int c = 0; c < 4; ++c)
#pragma unroll
            for (int k = 0; k < 16; ++k) acc[c][k] *= rinv;
          u16* base = Vm + ((size_t)(b * 4 + (ft - 4)) * S_ + s0) * 128;
          store_rows_bf16_lds(acc, wsm, lane, [&](int row, int c16) __attribute__((always_inline)) { return base + (size_t)row * 128 + c16 * 8; });
        }
      });
  });
  {
    const size_t gt = (size_t)lbid() * 512 + ltid(), NT = (size_t)G * 512;
    for (size_t e = gt; e < (size_t)T_ * 17; e += NT) {
      const int t = (int)(e / 17), gi = (int)(e % 17);
      const int b = t >> 12, s = t & 4095;
      const u16* src; const float* gain; float scale; u16* dst; int ncopy = 1; size_t cstride = 0;
      if (gi == 0) {
        src = proj + (size_t)t * NPROJ + 640; gain = p.in[11] + 128; scale = 1.f;
        dst = Km + ((size_t)(b * 4) * S_ + s) * 192 + 128; ncopy = 4; cstride = (size_t)S_ * 192;
      } else if (gi < 9) {
        const int j = gi - 1;
        src = proj + (size_t)t * NPROJ + 704 + j * 64; gain = p.in[12]; scale = 0.125f * LOG2E;
        dst = Qd + ((size_t)(b * 8 + j) * S_ + s) * 64;
      } else {
        const int j = gi - 9;
        src = proj + (size_t)t * NPROJ + 1216 + j * 64; gain = p.in[13]; scale = 1.f;
        dst = Kd + ((size_t)(b * 8 + j) * S_ + s) * 64;
      }
      uint4 raw[8];
#pragma unroll
      for (int q = 0; q < 8; ++q) raw[q] = ((const uint4*)src)[q];
      float ss = 0.f;
#pragma unroll
      for (int q = 0; q < 8; ++q) {
        ss = dot2bf(raw[q].x, raw[q].x, ss); ss = dot2bf(raw[q].y, raw[q].y, ss);
        ss = dot2bf(raw[q].z, raw[q].z, ss); ss = dot2bf(raw[q].w, raw[q].w, ss);
      }
      const float rinv = rsqrtf(ss * (1.f / 64.f) + EPS);
      const float rs = rinv * scale;
#pragma unroll
      for (int q = 0; q < 4; ++q) {
        const unsigned lo[4] = {raw[q].x, raw[q].y, raw[q].z, raw[q].w};
        const unsigned hi[4] = {raw[q + 4].x, raw[q + 4].y, raw[q + 4].z, raw[q + 4].w};
        unsigned o1[4], o2[4];
#pragma unroll
        for (int e2 = 0; e2 < 4; ++e2) {
          const int k = 8 * q + 2 * e2;
          const float4 cs = *(const float4*)(rope + s * 32 + k);
          const float2 ga = *(const float2*)(gain + k), gb = *(const float2*)(gain + 32 + k);
          float x1a = bflo(lo[e2]) * rs * ga.x, x2a = bflo(hi[e2]) * rs * gb.x;
          float x1b = bfhi(lo[e2]) * rs * ga.y, x2b = bfhi(hi[e2]) * rs * gb.y;
          o1[e2] = pk2(x1a * cs.x - x2a * cs.y, x1b * cs.z - x2b * cs.w);
          o2[e2] = pk2(x2a * cs.x + x1a * cs.y, x2b * cs.z + x1b * cs.w);
        }
        uint4 v1 = make_uint4(o1[0], o1[1], o1[2], o1[3]), v2 = make_uint4(o2[0], o2[1], o2[2], o2[3]);
        for (int cpy = 0; cpy < ncopy; ++cpy) {
          ((uint4*)(dst + cpy * cstride))[q] = v1;
          ((uint4*)(dst + cpy * cstride))[q + 4] = v2;
        }
      }
    }
  }
}

template <int NS, int RSK, bool QLDS>
DI void qk_softmax32(const char* kbuf, const bf16x8 (&qf)[NS], const char* qlds, bool needmask, int keybase, int qrow, int h, int r,
                     float& mrun, float& lrun, f32x16 (&O)[4], bf16x8& pf0, bf16x8& pf1) {
  f32x16 sacc;
#pragma unroll
  for (int i = 0; i < 16; ++i) sacc[i] = 0.f;
#pragma unroll
  for (int s = 0; s < NS; ++s) {
    bf16x8 a = *(const bf16x8*)(kbuf + r * RSK + (16 * s + 8 * h) * 2);
    bf16x8 bq;
    if (QLDS) bq = *(const bf16x8*)(qlds + (16 * s + 8 * h) * 2); else bq = qf[s];
    sacc = MFMA(a, bq, sacc);
  }
  if (needmask) {
#pragma unroll
    for (int i = 0; i < 16; ++i) {
      const int key = keybase + 8 * (i >> 2) + 4 * h + (i & 3);
      if (key > qrow) sacc[i] = NEG_INF;
    }
  }
  float mx = sacc[0];
#pragma unroll
  for (int i = 1; i < 16; ++i) mx = fmaxf(mx, sacc[i]);
  mx = fmaxf(mx, __shfl_xor(mx, 32));
  if (__builtin_amdgcn_ballot_w64(mx > mrun + 8.f) != 0ull) {
    const float mnew = fmaxf(mrun, mx);
    const float alpha = __builtin_amdgcn_exp2f(mrun - mnew);
    mrun = mnew;
    lrun *= alpha;
#pragma unroll
    for (int c = 0; c < 4; ++c)
#pragma unroll
      for (int i = 0; i < 16; ++i) O[c][i] *= alpha;
  }
  float rs = 0.f;
#pragma unroll
  for (int i = 0; i < 16; ++i) {
    float pv = __builtin_amdgcn_exp2f(sacc[i] - mrun);
    rs += pv; sacc[i] = pv;
  }
  lrun += rs;
  uint4 pa, pb;
  pa.x = pk2(sacc[0], sacc[1]); pa.y = pk2(sacc[2], sacc[3]); pa.z = pk2(sacc[4], sacc[5]); pa.w = pk2(sacc[6], sacc[7]);
  pb.x = pk2(sacc[8], sacc[9]); pb.y = pk2(sacc[10], sacc[11]); pb.z = pk2(sacc[12], sacc[13]); pb.w = pk2(sacc[14], sacc[15]);
  pf0 = __builtin_bit_cast(bf16x8, pa);
  pf1 = __builtin_bit_cast(bf16x8, pb);
}

template <int DQK, int NMAP>
DI void attn_item(const u16* __restrict__ qb0, const u16* __restrict__ qb1, const u16* __restrict__ kb0,
                  const u16* __restrict__ kb1, const u16* __restrict__ vb, int vstride, int qblk,
                  u16* __restrict__ outp, const float* __restrict__ lamp, const float* __restrict__ subg, char* smem) {
  constexpr int NS = DQK / 16;
  constexpr int RSK = DQK * 2 + 16;
  constexpr int KTILE = 64 * RSK;
  constexpr int VOFF = NMAP * KTILE;
  constexpr int STAGE = VOFF + 64 * 320;
  constexpr int CPR = DQK / 8;
  constexpr int KCH = NMAP * 64 * CPR / 512;
  int tid_ = ltid();
  asm volatile("" : "+v"(tid_));
  const int tid = tid_, lane = tid & 63, w = tid >> 6, h = lane >> 5, r = lane & 31;
  const int blk = (lane >> 4) & 1, q4 = (lane & 15) >> 2, p4 = lane & 3;
  const int q0 = qblk * 256, wrow0 = q0 + 32 * w, qrow = wrow0 + r;
  const int nt = 4 * (qblk + 1);

  constexpr bool QL = (NMAP == 2);
  bf16x8 qfa[NS];
  if (!QL) {
#pragma unroll
    for (int s = 0; s < NS; ++s) qfa[s] = *(const bf16x8*)(qb0 + (size_t)qrow * DQK + 16 * s + 8 * h);
  } else {
#pragma unroll
    for (int s = 0; s < NS; ++s) qfa[s] = bf16x8{0, 0, 0, 0, 0, 0, 0, 0};
#pragma unroll
    for (int i = 0; i < 8; ++i) {
      const int id = tid + 512 * i, mp = id >> 11, rem = id & 2047, row = rem >> 3, c16 = rem & 7;
      *(u32x4*)(smem + 2 * STAGE + mp * 36864 + row * 144 + c16 * 16) =
          *(const u32x4*)((mp ? qb1 : qb0) + (size_t)(q0 + row) * DQK + c16 * 8);
    }
  }
  const char* qla = smem + 2 * STAGE + (32 * w + r) * 144;
  const char* qlb = qla + 36864;
  f32x16 Oa[4], Ob[4];
  float ma = NEG_INF, la = 0.f, mb = NEG_INF, lb = 0.f;
#pragma unroll
  for (int c = 0; c < 4; ++c)
#pragma unroll
    for (int i = 0; i < 16; ++i) { Oa[c][i] = 0.f; if (NMAP == 2) Ob[c][i] = 0.f; }

  u32x4 rk[KCH], rv[2];
  unsigned koff[KCH], voff[2];
#pragma unroll
  for (int i = 0; i < KCH; ++i) {
    const int id = tid + 512 * i;
    if (NMAP == 1) koff[i] = (unsigned)((id / CPR) * DQK + (id % CPR) * 8);
    else koff[i] = (unsigned)((((id & 511) >> 3)) * DQK + (id & 7) * 8);
  }
#pragma unroll
  for (int i = 0; i < 2; ++i) {
    const int id = tid + 512 * i;
    voff[i] = (unsigned)((id >> 4) * vstride + (id & 15) * 8);
  }
  auto gload = [&](int t) __attribute__((always_inline)) {
    const u16* k0t = kb0 + (size_t)t * 64 * DQK;
    const u16* k1t = (NMAP == 2) ? kb1 + (size_t)t * 64 * DQK : k0t;
    const u16* vt = vb + (size_t)t * 64 * vstride;
#pragma unroll
    for (int i = 0; i < KCH; ++i) rk[i] = *(const u32x4*)(((NMAP == 2 && i) ? k1t : k0t) + koff[i]);
#pragma unroll
    for (int i = 0; i < 2; ++i) rv[i] = *(const u32x4*)(vt + voff[i]);
  };
  auto sstore = [&](char* buf) __attribute__((always_inline)) {
#pragma unroll
    for (int i = 0; i < KCH; ++i) {
      const int id = tid + 512 * i;
      if (NMAP == 1) {
        const int row = id / CPR, c16 = id % CPR;
        *(u32x4*)(buf + row * RSK + c16 * 16) = rk[i];
      } else {
        const int rem = id & 511, row = rem >> 3, c16 = rem & 7;
        *(u32x4*)(buf + i * KTILE + row * RSK + c16 * 16) = rk[i];
      }
    }
#pragma unroll
    for (int i = 0; i < 2; ++i) {
      const int id = tid + 512 * i, row = id >> 4, c16 = id & 15;
      *(u32x4*)(buf + VOFF + row * 320 + c16 * 16) = rv[i];
    }
  };

  gload(0);
  sstore(smem);
  __syncthreads();
  for (int t = 0; t < nt; ++t) {
    char* buf = smem + (t & 1) * STAGE;
    if (t + 1 < nt) gload(t + 1);
    const int key0 = t * 64;
#pragma unroll
    for (int sub = 0; sub < 2; ++sub) {
      const int ko = sub * 32;
      if (key0 + ko <= wrow0 + 31) {
        const bool needmask = (key0 + ko + 31 > wrow0);
        bf16x8 pa0, pa1, pb0, pb1;
        qk_softmax32<NS, RSK, QL>(buf + ko * RSK, qfa, qla, needmask, key0 + ko, qrow, h, r, ma, la, Oa, pa0, pa1);
        if (NMAP == 2)
          qk_softmax32<NS, RSK, QL>(buf + KTILE + ko * RSK, qfa, qlb, needmask, key0 + ko, qrow, h, r, mb, lb, Ob, pb0, pb1);
#pragma unroll
        for (int ks = 0; ks < 2; ++ks)
#pragma unroll
          for (int c = 0; c < 4; ++c) {
            const char* ap = buf + VOFF + (ko + 16 * ks + 4 * h + q4) * 320 + (32 * c + 16 * blk) * 2 + 8 * p4;
            s16x4 lo = trread(ap), hi = trread(ap + 8 * 320);
            bf16x8 a = __builtin_shufflevector(lo, hi, 0, 1, 2, 3, 4, 5, 6, 7);
            Oa[c] = MFMA(a, ks ? pa1 : pa0, Oa[c]);
            if (NMAP == 2) Ob[c] = MFMA(a, ks ? pb1 : pb0, Ob[c]);
          }
      }
    }
    if (t + 1 < nt) sstore(smem + ((t + 1) & 1) * STAGE);
    __syncthreads();
  }
  const float inva = 1.f / (la + __shfl_xor(la, 32));
  if (NMAP == 1) {
#pragma unroll
    for (int c = 0; c < 4; ++c)
#pragma unroll
      for (int i = 0; i < 16; ++i) Oa[c][i] *= inva;
  } else {
    const float li = *lamp / (lb + __shfl_xor(lb, 32));
    float s2 = 0.f;
#pragma unroll
    for (int c = 0; c < 4; ++c)
#pragma unroll
      for (int i = 0; i < 16; ++i) {
        float v = Oa[c][i] * inva - li * Ob[c][i];
        Oa[c][i] = v; s2 += v * v;
      }
    s2 += __shfl_xor(s2, 32);
    const float rn = rsqrtf(s2 * (1.f / 128.f) + EPS) * 0.8f;
#pragma unroll
    for (int c = 0; c < 4; ++c)
#pragma unroll
      for (int gq = 0; gq < 4; ++gq) {
        const int d = 32 * c + 8 * gq + 4 * h;
        asm volatile("" ::: "memory");
        float4 gg = *(const float4*)(subg + d);
        Oa[c][4 * gq] *= rn * gg.x; Oa[c][4 * gq + 1] *= rn * gg.y; Oa[c][4 * gq + 2] *= rn * gg.z; Oa[c][4 * gq + 3] *= rn * gg.w;
      }
  }
  {
    u16* base = outp + (size_t)wrow0 * LDH;
    store_rows_bf16_lds(Oa, smem + w * 8704, lane, [&](int row, int c16) __attribute__((always_inline)) { return base + (size_t)row * LDH + c16 * 8; });
  }
  __syncthreads();
}

DI void conv_table_slice(const float* __restrict__ src, uint2* __restrict__ dst, float scale, int slice, int nslices) {
  const size_t groups = (size_t)16384 * 1024 / 16;
  const size_t gt = (size_t)lbid() * 512 + ltid(), NT = (size_t)lgdim() * 512;
  const size_t lo = groups * slice / nslices, hi = groups * (slice + 1) / nslices;
  for (size_t i = lo + gt; i < hi; i += NT) {
    const float4* sp = (const float4*)src + 4 * i;
    float4 a0 = sp[0], a1 = sp[1], a2 = sp[2], a3 = sp[3];
    unsigned w0 = 0, w1 = 0;
    w0 = __builtin_amdgcn_cvt_scalef32_pk_fp4_f32(w0, a0.x * scale, a0.y * scale, 1.0f, 0);
    w0 = __builtin_amdgcn_cvt_scalef32_pk_fp4_f32(w0, a0.z * scale, a0.w * scale, 1.0f, 1);
    w0 = __builtin_amdgcn_cvt_scalef32_pk_fp4_f32(w0, a1.x * scale, a1.y * scale, 1.0f, 2);
    w0 = __builtin_amdgcn_cvt_scalef32_pk_fp4_f32(w0, a1.z * scale, a1.w * scale, 1.0f, 3);
    w1 = __builtin_amdgcn_cvt_scalef32_pk_fp4_f32(w1, a2.x * scale, a2.y * scale, 1.0f, 0);
    w1 = __builtin_amdgcn_cvt_scalef32_pk_fp4_f32(w1, a2.z * scale, a2.w * scale, 1.0f, 1);
    w1 = __builtin_amdgcn_cvt_scalef32_pk_fp4_f32(w1, a3.x * scale, a3.y * scale, 1.0f, 2);
    w1 = __builtin_amdgcn_cvt_scalef32_pk_fp4_f32(w1, a3.z * scale, a3.w * scale, 1.0f, 3);
    dst[(i >> 6) * 128 + (i & 63)] = make_uint2(w0, w1);
  }
}

DI void phase_attn(const Params& p, char* smem) {
  const int G = lgdim(), g = lbid();
  const u16* Qm = (const u16*)(p.ws + OFF_QM); const u16* Km = (const u16*)(p.ws + OFF_KM);
  const u16* Vm = (const u16*)(p.ws + OFF_VM); const u16* Qd = (const u16*)(p.ws + OFF_QD);
  const u16* Kd = (const u16*)(p.ws + OFF_KD); const u16* proj = (const u16*)(p.ws + OFF_PROJ);
  u16* mixed = (u16*)(p.ws + OFF_H);
  const float* lamp = (const float*)(p.ws + OFF_LAM);
  const int nrounds = (2048 + G - 1) / G;
  for (int k = 0; k * G < 2048; ++k) {
    conv_table_slice(p.in[23], (uint2*)(p.ws + OFF_U), U_SCALE, k, nrounds);
    conv_table_slice(p.in[24], (uint2*)(p.ws + OFF_U + 512), V_SCALE, k, nrounds);
    const int idx = (k & 1) ? k * G + (G - 1 - g) : k * G + g;
    if (idx >= 2048) continue;
    const int level = idx >> 7, qblk = 15 - level, j = idx & 127, type = j & 1, bh = j >> 1;
    const int b = bh >> 2, hd = bh & 3;
#ifdef NO_MLA
    if (0) {
#else
    if (type == 0) {
#endif
      const size_t ho = (size_t)(b * 4 + hd) * S_;
      attn_item<192, 1>(Qm + ho * 192, nullptr, Km + ho * 192, nullptr, Vm + ho * 128, 128, qblk,
                        mixed + (size_t)b * S_ * LDH + hd * 128, lamp, nullptr, smem);
#ifdef NO_DIFF
    } else if (0) {
#else
    } else {
#endif
      const size_t h0 = (size_t)(b * 8 + 2 * hd) * S_ * 64, h1 = h0 + (size_t)S_ * 64;
      attn_item<64, 2>(Qd + h0, Qd + h1, Kd + h0, Kd + h1, proj + (size_t)b * S_ * NPROJ + 1728 + hd * 128, NPROJ,
                       qblk, mixed + (size_t)b * S_ * LDH + 512 + hd * 128, lamp, p.in[18], smem);
    }
  }
}

template <int ST>
DI void ins1(float (&T)[16], float s) {
#pragma unroll
  for (int j = 15; j > ST; --j) T[j] = __builtin_amdgcn_fmed3f(T[j - 1], s, T[j]);
  T[ST] = fmaxf(T[ST], s);
}
DI void ins2(float (&V)[16], int (&I)[16], const int st, float s, int id) {
#pragma unroll
  for (int j = 0; j < 16; ++j) {
    if (j >= st) {
      const bool c = s > V[j];
      const float nv = c ? s : V[j], ns = c ? V[j] : s;
      const int ni = c ? id : I[j], nid = c ? I[j] : id;
      V[j] = nv; s = ns; I[j] = ni; id = nid;
      __builtin_amdgcn_sched_barrier(0);
    }
  }
}

DI void peer_scores_top16(const char* sk, const u16* __restrict__ pqrow, int lane, float (&T)[16]) {
  const int h = lane >> 5, r = lane & 31;
  bf16x8 bq[8];
#pragma unroll
  for (int s = 0; s < 8; ++s) bq[s] = *(const bf16x8*)(pqrow + 16 * s + 8 * h);
#pragma unroll
  for (int j = 0; j < 16; ++j) T[j] = NEG_INF;
#pragma unroll
  for (int c = 0; c < 4; ++c) {
    f32x16 acc;
#pragma unroll
    for (int i = 0; i < 16; ++i) acc[i] = 0.f;
#pragma unroll
    for (int s = 0; s < 8; ++s) {
      bf16x8 a = *(const bf16x8*)(sk + (32 * c + r) * 272 + (16 * s + 8 * h) * 2);
      acc = MFMA(a, bq[s], acc);
    }
#pragma unroll
    for (int i = 0; i < 16; ++i) {
      const unsigned code = (unsigned)(127 - 32 * c - (i & 3) - 8 * (i >> 2)) - 4u * (unsigned)h;
      ins1<0>(T, __uint_as_float((__float_as_uint(acc[i]) & 0xffffff80u) | code));
    }
  }
  float o[16];
#pragma unroll
  for (int j = 0; j < 16; ++j) o[j] = __shfl_xor(T[j], 32);
  ins1<0>(T, o[0]); ins1<1>(T, o[1]); ins1<2>(T, o[2]); ins1<3>(T, o[3]);
  ins1<4>(T, o[4]); ins1<5>(T, o[5]); ins1<6>(T, o[6]); ins1<7>(T, o[7]);
  ins1<8>(T, o[8]); ins1<9>(T, o[9]); ins1<10>(T, o[10]); ins1<11>(T, o[11]);
  ins1<12>(T, o[12]); ins1<13>(T, o[13]); ins1<14>(T, o[14]); ins1<15>(T, o[15]);
}

DI float gelu_exact(float x) { return 0.5f * x * (1.f + erff(x * 0.7071067811865476f)); }

DI void load_sk(char* smem, const u16* SK, int hp, int tid) {
#pragma unroll
  for (int i = 0; i < 4; ++i) {
    const int id = tid + 512 * i, row = id >> 4, c16 = id & 15;
    *(u32x4*)(smem + row * 272 + c16 * 16) = *(const u32x4*)(SK + (size_t)hp * 16384 + row * 128 + c16 * 8);
  }
}

DI void peer_route(const Params& p, char* smem, int t0) {
  const int tid = ltid(), lane = tid & 63, w = tid >> 6, h = lane >> 5, r = lane & 31;
  const u16* pq = (const u16*)(p.ws + OFF_PROJ);
  const u16* SK = (const u16*)(p.ws + OFF_SK);
  uint2* topk = (uint2*)(p.ws + OFF_TOPK);
    const int tq = t0 + 32 * w + r;
#pragma unroll 1
    for (int hd = 0; hd < 8; ++hd) {
      float TA[16], TB[16];
      __syncthreads();
      load_sk(smem, SK, hd * 2, tid);
      __syncthreads();
      peer_scores_top16(smem, pq + (size_t)tq * 2048 + (hd * 2) * 128, lane, TA);
      __syncthreads();
      load_sk(smem, SK, hd * 2 + 1, tid);
      __syncthreads();
      peer_scores_top16(smem, pq + (size_t)tq * 2048 + (hd * 2 + 1) * 128, lane, TB);
      float FK[16];
#pragma unroll
      for (int j = 0; j < 16; ++j) FK[j] = NEG_INF;
#pragma unroll
      for (int i = 0; i < 16; ++i)
#pragma unroll
        for (int j = 0; j < 16; ++j)
          if ((i + 1) * (j + 1) <= 16) {
            const float cv = __uint_as_float(__float_as_uint(TA[i]) & 0xffffff80u) + __uint_as_float(__float_as_uint(TB[j]) & 0xffffff80u);
            const float key = __uint_as_float((__float_as_uint(cv) & 0xffffff00u) | (unsigned)(255 - (16 * i + j)));
            const int st = (i + 1) * (j + 1) - 1;
#pragma unroll
            for (int q = 15; q >= 1; --q)
              if (q > st) FK[q] = __builtin_amdgcn_fmed3f(FK[q - 1], key, FK[q]);
            FK[st] = fmaxf(FK[st], key);
          }
      float FV[16]; int FI[16];
#pragma unroll
      for (int m = 0; m < 16; ++m) {
        const unsigned kb = __float_as_uint(FK[m]);
        const int code = 255 - (int)(kb & 255u), ci = code >> 4, cj = code & 15;
        FV[m] = __uint_as_float(kb & 0xffffff00u);
        float ra = TA[0], rb = TB[0];
#pragma unroll
        for (int q = 1; q < 16; ++q) { ra = (ci == q) ? TA[q] : ra; rb = (cj == q) ? TB[q] : rb; }
        FI[m] = (127 - (int)(__float_as_uint(ra) & 127u)) * 128 + (127 - (int)(__float_as_uint(rb) & 127u));
      }
      float e[16], sum = 0.f;
#pragma unroll
      for (int j = 0; j < 16; ++j) { e[j] = expf(FV[j] - FV[0]); sum += e[j]; }
      const float rs = 1.f / sum;
      if (h == 0) {
        u32x4* dst = (u32x4*)(topk + (size_t)tq * 128 + hd * 16);
#pragma unroll
        for (int q = 0; q < 8; ++q) {
          u32x4 o;
          o.x = (unsigned)FI[2 * q]; o.y = __float_as_uint(e[2 * q] * rs);
          o.z = (unsigned)FI[2 * q + 1]; o.w = __float_as_uint(e[2 * q + 1] * rs);
          dst[q] = o;
        }
      }
    }
}

DI void peer_udots(const Params& p, int owner, int chunk) {
  const int tid = ltid(), lane = tid & 63, w = tid >> 6;
  const uint2* topk = (const uint2*)(p.ws + OFF_TOPK);
  const u16* H2 = (const u16*)(p.ws + OFF_H2);
  float* abuf = (float*)(p.ws + OFF_ABUF);
  const unsigned char* U8 = (const unsigned char*)(p.ws + OFF_U);
  const int tbase = chunk * 128 + w * 16;
  u32x4 tkn = *(const u32x4*)(topk + (size_t)tbase * 128 + lane * 2);
  u32x4 han = *(const u32x4*)(H2 + (size_t)tbase * 1024 + lane * 16);
  u32x4 hbn = *(const u32x4*)(H2 + (size_t)tbase * 1024 + lane * 16 + 8);
#pragma unroll 1
  for (int ti = 0; ti < 16; ++ti) {
    const int t = tbase + ti;
    const u32x4 tk = tkn, ha = han, hb = hbn;
    {
      const int tn = tbase + ((ti + 1) & 15);
      tkn = *(const u32x4*)(topk + (size_t)tn * 128 + lane * 2);
      han = *(const u32x4*)(H2 + (size_t)tn * 1024 + lane * 16);
      hbn = *(const u32x4*)(H2 + (size_t)tn * 1024 + lane * 16 + 8);
    }
    unsigned long long b0 = __ballot((int)(tk.x >> 11) == owner), b1 = __ballot((int)(tk.z >> 11) == owner);
    f32x2 hf[8];
#pragma unroll
    for (int i = 0; i < 4; ++i) { hf[i] = f32x2{bflo(ha[i]), bfhi(ha[i])}; hf[4 + i] = f32x2{bflo(hb[i]), bfhi(hb[i])}; }
#pragma unroll 1
    while ((b0 | b1) != 0ull) {
      int jv = -1;
      u32x4 uu[16];
#pragma unroll
      for (int k = 0; k < 16; ++k) {
        int e, j;
        if (b0 != 0ull) {
          const int l = __builtin_ctzll(b0); b0 &= b0 - 1ull;
          e = __builtin_amdgcn_readlane((int)tk.x, l); j = 2 * l;
        } else if (b1 != 0ull) {
          const int l = __builtin_ctzll(b1); b1 &= b1 - 1ull;
          e = __builtin_amdgcn_readlane((int)tk.z, l); j = 2 * l + 1;
        } else { e = owner << 11; j = -1; }
        jv = (lane == 4 * k) ? j : jv;
        uu[k] = *(const u32x4*)(U8 + (size_t)e * 1024 + lane * 16);
      }
      float d[16];
#pragma unroll
      for (int k = 0; k < 16; ++k) {
        f32x2 a2 = f32x2{0.f, 0.f};
#pragma unroll
        for (int q = 0; q < 4; ++q) {
          a2 = __builtin_amdgcn_cvt_pk_f32_fp8((int)uu[k][q], false) * hf[2 * q] + a2;
          a2 = __builtin_amdgcn_cvt_pk_f32_fp8((int)uu[k][q], true) * hf[2 * q + 1] + a2;
        }
        d[k] = a2.x + a2.y;
      }
      const bool h32 = (lane & 32) != 0, h16 = (lane & 16) != 0, h8 = (lane & 8) != 0, h4 = (lane & 4) != 0;
      float r8[8], r4[4], r2[2];
#pragma unroll
      for (int i = 0; i < 8; ++i) r8[i] = (h32 ? d[8 + i] : d[i]) + __shfl_xor(h32 ? d[i] : d[8 + i], 32);
#pragma unroll
      for (int i = 0; i < 4; ++i) r4[i] = (h16 ? r8[4 + i] : r8[i]) + __shfl_xor(h16 ? r8[i] : r8[4 + i], 16);
#pragma unroll
      for (int i = 0; i < 2; ++i) r2[i] = (h8 ? r4[2 + i] : r4[i]) + __shfl_xor(h8 ? r4[i] : r4[2 + i], 8);
      float r1 = (h4 ? r2[1] : r2[0]) + __shfl_xor(h4 ? r2[0] : r2[1], 4);
      r1 += __shfl_xor(r1, 2); r1 += __shfl_xor(r1, 1);
      if ((lane & 3) == 0 && jv >= 0) abuf[(size_t)t * 128 + jv] = r1 * (1.f / U_SCALE);
    }
  }
}

DI void peer_vgather(const Params& p, int t0) {
  const int tid = ltid(), lane = tid & 63, w = tid >> 6;
  const uint2* topk = (const uint2*)(p.ws + OFF_TOPK);
  const float* abuf = (const float*)(p.ws + OFF_ABUF);
  const float* mod = (const float*)(p.ws + OFF_MOD);
  const unsigned char* V8 = (const unsigned char*)(p.ws + OFF_V);
#pragma unroll 1
  for (int ti = 0; ti < 32; ++ti) {
    const int t = t0 + 32 * w + ti, b = t >> 12;
    const float* mb = mod + b * 6144;
    float* orow = p.out + (size_t)t * 1024 + lane * 16;
    const u32x4 tk = *(const u32x4*)(topk + (size_t)t * 128 + lane * 2);
    const float2 a2 = *(const float2*)(abuf + (size_t)t * 128 + lane * 2);
    const float coef0 = __uint_as_float(tk.y) * gelu_exact(a2.x) * (1.f / V_SCALE);
    const float coef1 = __uint_as_float(tk.w) * gelu_exact(a2.y) * (1.f / V_SCALE);
    f32x2 y[8];
#pragma unroll
    for (int i = 0; i < 8; ++i) y[i] = f32x2{0.f, 0.f};
    u32x4 cv[8], nv[8];
    float ccf[8], ncf[8];
    auto issue = [&](int jj, u32x4 (&vv)[8], float (&cf)[8]) __attribute__((always_inline)) {
#pragma unroll
      for (int k = 0; k < 4; ++k) {
        const int l = 4 * jj + k;
        const int e0 = __builtin_amdgcn_readlane((int)tk.x, l), e1 = __builtin_amdgcn_readlane((int)tk.z, l);
        cf[2 * k] = __uint_as_float(__builtin_amdgcn_readlane((int)__float_as_uint(coef0), l));
        cf[2 * k + 1] = __uint_as_float(__builtin_amdgcn_readlane((int)__float_as_uint(coef1), l));
        vv[2 * k] = *(const u32x4*)(V8 + (size_t)e0 * 1024 + lane * 16);
        vv[2 * k + 1] = *(const u32x4*)(V8 + (size_t)e1 * 1024 + lane * 16);
      }
    };
    auto accum = [&](const u32x4 (&vv)[8], const float (&cf)[8]) __attribute__((always_inline)) {
#pragma unroll
      for (int k = 0; k < 8; ++k) {
        const f32x2 cf2 = f32x2{cf[k], cf[k]};
#pragma unroll
        for (int q = 0; q < 4; ++q) {
          y[2 * q] = __builtin_amdgcn_cvt_pk_f32_fp8((int)vv[k][q], false) * cf2 + y[2 * q];
          y[2 * q + 1] = __builtin_amdgcn_cvt_pk_f32_fp8((int)vv[k][q], true) * cf2 + y[2 * q + 1];
        }
      }
    };
    issue(0, cv, ccf);
#pragma unroll 1
    for (int jj = 0; jj < 16; jj += 2) {
      issue(jj + 1, nv, ncf);
      __builtin_amdgcn_sched_barrier(0);
      accum(cv, ccf);
      __builtin_amdgcn_sched_barrier(0);
      issue((jj + 2) & 15, cv, ccf);
      __builtin_amdgcn_sched_barrier(0);
      accum(nv, ncf);
      __builtin_amdgcn_sched_barrier(0);
    }
#pragma unroll
    for (int q = 0; q < 4; ++q) {
      float4 xv = ((const float4*)orow)[q];
      float4 g2 = *(const float4*)(mb + 5120 + lane * 16 + 4 * q);
      float4 o;
      o.x = xv.x + g2.x * y[2 * q].x; o.y = xv.y + g2.y * y[2 * q].y;
      o.z = xv.z + g2.z * y[2 * q + 1].x; o.w = xv.w + g2.w * y[2 * q + 1].y;
      ((float4*)orow)[q] = o;
    }
  }
}

DI void peer_gather(const Params& p, int t0, bool dummy) {
  const int tid = ltid(), lane = tid & 63, w = tid >> 6;
  const uint2* topk = (const uint2*)(p.ws + OFF_TOPK);
  const float* mod = (const float*)(p.ws + OFF_MOD);
  const unsigned char* U8 = (const unsigned char*)(p.ws + OFF_U);
  const unsigned char* V8 = (const unsigned char*)(p.ws + OFF_U) + 512;
#pragma unroll 1
  for (int ti = 0; ti < 32; ++ti) {
    const int t = t0 + 32 * w + ti, b = t >> 12;
    const float* mb = mod + b * 6144;
    float* orow = p.out + (size_t)t * 1024 + lane * 16;
    f32x2 xr[8];
#pragma unroll
    for (int q = 0; q < 4; ++q) {
      float4 a = ((const float4*)orow)[q];
      xr[2 * q] = f32x2{a.x, a.y}; xr[2 * q + 1] = f32x2{a.z, a.w};
    }
    float ss = 0.f;
#pragma unroll
    for (int i = 0; i < 8; ++i) ss += xr[i].x * xr[i].x + xr[i].y * xr[i].y;
    ss = wave_sum(ss);
    const float rinv = rsqrtf(ss * (1.f / 1024.f) + EPS);
    f32x2 hf[8];
#pragma unroll
    for (int q = 0; q < 4; ++q) {
      const int d0 = lane * 16 + 4 * q;
      float4 gg = *(const float4*)(p.in[20] + d0);
      float4 sc = *(const float4*)(mb + 4096 + d0);
      float4 sh = *(const float4*)(mb + 3072 + d0);
      hf[2 * q] = f32x2{xr[2 * q].x * rinv * gg.x * (1.f + sc.x) + sh.x, xr[2 * q].y * rinv * gg.y * (1.f + sc.y) + sh.y};
      hf[2 * q + 1] = f32x2{xr[2 * q + 1].x * rinv * gg.z * (1.f + sc.z) + sh.z, xr[2 * q + 1].y * rinv * gg.w * (1.f + sc.w) + sh.w};
    }
    const u32x4 tk = *(const u32x4*)(topk + (size_t)t * 128 + lane * 2);
    f32x2 y[8];
#pragma unroll
    for (int i = 0; i < 8; ++i) y[i] = f32x2{0.f, 0.f};
    uint2 ua[16], va[16], ub[16], vb[16];
    float gA, gB;
    auto issue = [&](int jj, uint2 (&uu)[16], uint2 (&vv)[16], float& gsel) __attribute__((always_inline)) {
      float gs = 0.f;
#pragma unroll
      for (int k = 0; k < 16; ++k) {
        const int l = 8 * jj + (k >> 1);
        const int e = __builtin_amdgcn_readlane((int)((k & 1) ? tk.z : tk.x), l);
        const float g = __uint_as_float(__builtin_amdgcn_readlane((int)((k & 1) ? tk.w : tk.y), l));
        gs = ((lane >> 2) == k) ? g : gs;
        uu[k] = *(const uint2*)(U8 + (size_t)e * 1024 + lane * 8);
        vv[k] = *(const uint2*)(V8 + (size_t)e * 1024 + lane * 8);
      }
      gsel = gs;
    };
    auto process = [&](const uint2 (&uu)[16], const uint2 (&vv)[16], float gsel) __attribute__((always_inline)) {
      float d[16];
#pragma unroll
      for (int k = 0; k < 16; ++k) {
        f32x2 a2 = f32x2{0.f, 0.f};
        a2 = __builtin_amdgcn_cvt_scalef32_pk_f32_fp4(uu[k].x, 1.0f, 0) * hf[0] + a2;
        a2 = __builtin_amdgcn_cvt_scalef32_pk_f32_fp4(uu[k].x, 1.0f, 1) * hf[1] + a2;
        a2 = __builtin_amdgcn_cvt_scalef32_pk_f32_fp4(uu[k].x, 1.0f, 2) * hf[2] + a2;
        a2 = __builtin_amdgcn_cvt_scalef32_pk_f32_fp4(uu[k].x, 1.0f, 3) * hf[3] + a2;
        a2 = __builtin_amdgcn_cvt_scalef32_pk_f32_fp4(uu[k].y, 1.0f, 0) * hf[4] + a2;
        a2 = __builtin_amdgcn_cvt_scalef32_pk_f32_fp4(uu[k].y, 1.0f, 1) * hf[5] + a2;
        a2 = __builtin_amdgcn_cvt_scalef32_pk_f32_fp4(uu[k].y, 1.0f, 2) * hf[6] + a2;
        a2 = __builtin_amdgcn_cvt_scalef32_pk_f32_fp4(uu[k].y, 1.0f, 3) * hf[7] + a2;
        d[k] = a2.x + a2.y;
      }
      const bool h32 = (lane & 32) != 0, h16 = (lane & 16) != 0, h8 = (lane & 8) != 0, h4 = (lane & 4) != 0;
      float r8[8], r4[4], r2[2];
#pragma unroll
      for (int i = 0; i < 8; ++i) r8[i] = (h32 ? d[8 + i] : d[i]) + __shfl_xor(h32 ? d[i] : d[8 + i], 32);
#pragma unroll
      for (int i = 0; i < 4; ++i) r4[i] = (h16 ? r8[4 + i] : r8[i]) + __shfl_xor(h16 ? r8[i] : r8[4 + i], 16);
#pragma unroll
      for (int i = 0; i < 2; ++i) r2[i] = (h8 ? r4[2 + i] : r4[i]) + __shfl_xor(h8 ? r4[i] : r4[2 + i], 8);
      float kk = (h4 ? r2[1] : r2[0]) + __shfl_xor(h4 ? r2[0] : r2[1], 4);
      kk += __shfl_xor(kk, 2); kk += __shfl_xor(kk, 1);
      const float coefv = gsel * gelu_exact(kk * (1.f / U_SCALE)) * (1.f / V_SCALE);
#pragma unroll
      for (int k = 0; k < 16; ++k) {
        const float cf = __uint_as_float(__builtin_amdgcn_readlane((int)__float_as_uint(coefv), 4 * k));
        const f32x2 cf2 = f32x2{cf, cf};
        y[0] = __builtin_amdgcn_cvt_scalef32_pk_f32_fp4(vv[k].x, 1.0f, 0) * cf2 + y[0];
        y[1] = __builtin_amdgcn_cvt_scalef32_pk_f32_fp4(vv[k].x, 1.0f, 1) * cf2 + y[1];
        y[2] = __builtin_amdgcn_cvt_scalef32_pk_f32_fp4(vv[k].x, 1.0f, 2) * cf2 + y[2];
        y[3] = __builtin_amdgcn_cvt_scalef32_pk_f32_fp4(vv[k].x, 1.0f, 3) * cf2 + y[3];
        y[4] = __builtin_amdgcn_cvt_scalef32_pk_f32_fp4(vv[k].y, 1.0f, 0) * cf2 + y[4];
        y[5] = __builtin_amdgcn_cvt_scalef32_pk_f32_fp4(vv[k].y, 1.0f, 1) * cf2 + y[5];
        y[6] = __builtin_amdgcn_cvt_scalef32_pk_f32_fp4(vv[k].y, 1.0f, 2) * cf2 + y[6];
        y[7] = __builtin_amdgcn_cvt_scalef32_pk_f32_fp4(vv[k].y, 1.0f, 3) * cf2 + y[7];
      }
    };
    issue(0, ua, va, gA);
#pragma unroll 1
    for (int jj = 0; jj < 8; jj += 2) {
      issue(jj + 1, ub, vb, gB);
      __builtin_amdgcn_sched_barrier(0);
      process(ua, va, gA);
      __builtin_amdgcn_sched_barrier(0);
      issue((jj + 2) & 7, ua, va, gA);
      __builtin_amdgcn_sched_barrier(0);
      process(ub, vb, gB);
      __builtin_amdgcn_sched_barrier(0);
    }
#pragma unroll
    for (int q = 0; q < 4; ++q) {
      float4 g2 = *(const float4*)(mb + 5120 + lane * 16 + 4 * q);
      float4 o;
      o.x = xr[2 * q].x + g2.x * y[2 * q].x; o.y = xr[2 * q].y + g2.y * y[2 * q].y;
      o.z = xr[2 * q + 1].x + g2.z * y[2 * q + 1].x; o.w = xr[2 * q + 1].y + g2.w * y[2 * q + 1].y;
      float* wrow = dummy ? (float*)(p.ws + OFF_QM) + (size_t)(t & 32767) * 1024 + lane * 16 : orow;
      ((float4*)wrow)[q] = o;
    }
  }
}

typedef const __attribute__((address_space(4))) Params* KParamsPtr;
__global__ void __launch_bounds__(512) mega(Params p_arg) {
  __shared__ __attribute__((aligned(16))) char smem[151552];
  for (int ph = p_arg.ph_begin; ph < p_arg.ph_end; ++ph) {
#ifdef ONLY
    if (ph != ONLY) continue;
#endif
    KParamsPtr kp = (KParamsPtr)__builtin_amdgcn_kernarg_segment_ptr();
    asm volatile("" : "+s"(kp));
    Params p;
#pragma unroll
    for (int i = 0; i < 25; ++i) p.in[i] = kp->in[i];
    p.out = kp->out; p.ws = kp->ws; p.ph_begin = 0; p.ph_end = 0;
    const int G = lgdim();
#ifdef REP
    for (int rep_ = 0; rep_ < ((ph == REP && ph != 8) ? 2 : 1); ++rep_) {
    if (rep_) cg::this_grid().sync();
#endif
    if (ph == 0) {
      phase0(p, smem);
    } else if (ph == 1) {
      rownorm_phase(p, p.in[0], p.in[4], 0, 1024, (u16*)(p.ws + OFF_H));
    } else if (ph == 2) {
      u16* proj = (u16*)(p.ws + OFF_PROJ);
      xcd_tiles(p.ws, 0, 9, [&](int tt, int ft2) __attribute__((always_inline)) {
        gemm_tile<1024, false>((const u16*)(p.ws + OFF_WIN), NPROJ, ft2 * 256, (const u16*)(p.ws + OFF_H), LDH,
                               (size_t)tt * 256, smem, [&](f32x16 (&acc)[4], float, int t, int h, int wf, char* wbase, int tg) __attribute__((always_inline)) {
                                 store_tile_bf16_lds(acc, wbase + tg * 8704, proj + (size_t)(t & ~31) * NPROJ + ft2 * 256 + wf * 128, NPROJ, ltid() & 63);
                               });
      });
    } else if (ph == 3) {
      phase_qkv(p, smem);
    } else if (ph == 4) {
      phase_attn(p, smem);
    } else if (ph == 5) {
      const float* mod = (const float*)(p.ws + OFF_MOD);
      xcd_tiles(p.ws, 3, 4, [&](int tt, int ft2) __attribute__((always_inline)) {
        gemm_tile<1024, false>((const u16*)(p.ws + OFF_WOUT), 1024, ft2 * 256, (const u16*)(p.ws + OFF_H), LDH,
                               (size_t)tt * 256, smem, [&](f32x16 (&acc)[4], float, int t, int h, int wf, char* wbase, int tg) __attribute__((always_inline)) {
                                 const int ft = ft2 * 2 + wf, lane = ltid() & 63, r = lane & 31;
#pragma unroll
                                 for (int c = 0; c < 4; ++c)
#pragma unroll
                                   for (int gq = 0; gq < 4; ++gq)
                                     *(float4*)(wbase + r * 528 + (32 * c + 8 * gq + 4 * h) * 4) =
                                         make_float4(acc[c][4 * gq], acc[c][4 * gq + 1], acc[c][4 * gq + 2], acc[c][4 * gq + 3]);
                                 const int tg0 = t & ~31, b = tg0 >> 12;
#pragma unroll
                                 for (int j = 0; j < 16; ++j) {
                                   const int idx = lane + 64 * j, row = idx >> 5, c16 = idx & 31;
                                   const float4 a = *(const float4*)(wbase + row * 528 + c16 * 16);
                                   const int n = ft * 128 + c16 * 4;
                                   const size_t off = (size_t)(tg0 + row) * 1024 + n;
                                   const float4 xv = *(const float4*)(p.in[0] + off);
                                   const float4 g1 = *(const float4*)(mod + b * 6144 + 2048 + n);
                                   float4 o;
                                   o.x = xv.x + g1.x * a.x; o.y = xv.y + g1.y * a.y; o.z = xv.z + g1.z * a.z; o.w = xv.w + g1.w * a.w;
                                   *(float4*)(p.out + off) = o;
                                 }
                               });
      });
    } else if (ph == 6) {
      rownorm_phase(p, p.out, p.in[20], 3072, 4096, (u16*)(p.ws + OFF_H2));
    } else if (ph == 7) {
      u16* pq = (u16*)(p.ws + OFF_PROJ);
      xcd_tiles(p.ws, 4, 8, [&](int tt, int ft2) __attribute__((always_inline)) {
        gemm_tile<1024, false>((const u16*)(p.ws + OFF_WPQ), 2048, ft2 * 256, (const u16*)(p.ws + OFF_H2), LDH,
                               (size_t)tt * 256, smem, [&](f32x16 (&acc)[4], float, int t, int h, int wf, char* wbase, int tg) __attribute__((always_inline)) {
                                 store_tile_bf16_lds(acc, wbase + tg * 8704, pq + (size_t)(t & ~31) * 2048 + ft2 * 256 + wf * 128, 2048, ltid() & 63);
                               });
      });
    } else {
      for (int tt = lbid(); tt < 256; tt += G) {
#ifdef REP8
        peer_route(p, smem, tt * 256);
        __threadfence();
        __syncthreads();
        __threadfence();
        peer_gather(p, tt * 256, true);
        __syncthreads();
#endif
        peer_route(p, smem, tt * 256);
        __threadfence();
        __syncthreads();
        __threadfence();
        peer_gather(p, tt * 256, false);
      }
    }
#ifdef REP
    }
#endif
#if COOP
    if (ph + 1 < p_arg.ph_end) cg::this_grid().sync();
#endif
  }
}

extern "C" void kernel_launch(void* const* d_in, const int* in_sizes, int n_in, void* d_out, int out_size,
                              void* d_ws, size_t ws_size, hipStream_t stream) {
  static int grid_blocks = 0;
  if (!grid_blocks) {
    int dev = 0, cus = 0, per_cu = 0;
    hipGetDevice(&dev);
    hipDeviceGetAttribute(&cus, hipDeviceAttributeMultiprocessorCount, dev);
    hipOccupancyMaxActiveBlocksPerMultiprocessor(&per_cu, mega, 512, 0);
    if (per_cu < 1) per_cu = 1;
    if (per_cu > 1) per_cu = 1;
    grid_blocks = cus * per_cu;
  }
  Params p{};
  for (int i = 0; i < 25; ++i) p.in[i] = (const float*)d_in[i];
  p.out = (float*)d_out;
  p.ws = (char*)d_ws;
#if COOP
  p.ph_begin = 0; p.ph_end = 9;
  void* args[] = {&p};
  hipError_t e = hipLaunchCooperativeKernel((void*)mega, dim3(grid_blocks), dim3(512), args, 0, stream);
  if (e != hipSuccess) fprintf(stderr, "cooperative launch failed: %s (grid %d)\n", hipGetErrorString(e), grid_blocks);
#else
  for (int ph = 0; ph < 9; ++ph) {
    p.ph_begin = ph; p.ph_end = ph + 1;
    hipLaunchKernelGGL(mega, dim3(grid_blocks), dim3(512), 0, stream, p);
  }
#endif
}
```

```cpp
#include <hip/hip_runtime.h>
#include <hip/hip_cooperative_groups.h>
#include <cstdio>
namespace cg = cooperative_groups;

typedef unsigned short u16;
typedef short bf16x8 __attribute__((ext_vector_type(8)));
typedef short s16x4 __attribute__((ext_vector_type(4)));
typedef float f32x16 __attribute__((ext_vector_type(16)));
typedef __bf16 bf2_t __attribute__((ext_vector_type(2)));
typedef unsigned u32x4 __attribute__((ext_vector_type(4)));
#define DI __device__ __forceinline__
#define LDSP(T, p) ((__attribute__((address_space(3))) T*)(p))
#define MFMA(a, b, c) __builtin_amdgcn_mfma_f32_32x32x16_bf16((a), (b), (c), 0, 0, 0)

#ifndef COOP
#define COOP 1
#endif

constexpr int S_ = 4096, T_ = 65536, NPROJ = 2304;
constexpr int LDH = 1088;
constexpr float EPS = 1e-6f;
constexpr float LOG2E = 1.4426950408889634f;
constexpr float NEG_INF = -__builtin_inff();
constexpr float U_SCALE = 64.f, V_SCALE = 5.656854f;
typedef float f32x2 __attribute__((ext_vector_type(2)));

constexpr size_t OFF_MOD = 0;
constexpr size_t OFF_LAM = 393216;
constexpr size_t OFF_CNT = 397312;
constexpr size_t OFF_ROPE = 524288;
constexpr size_t OFF_WIN = 1572864;
constexpr size_t OFF_WQ = 6291456;
constexpr size_t OFF_WKV = 6881280;
constexpr size_t OFF_WOUT = 7405568;
constexpr size_t OFF_WPQ = 9502720;
constexpr size_t OFF_SK = 13697024;
constexpr size_t OFF_U = 16777216;
constexpr size_t OFF_V = 50331648;
constexpr size_t OFF_H = 83886080;
constexpr size_t OFF_PROJ = 226492416;
constexpr size_t OFF_QM = 528482304;
constexpr size_t OFF_KM = 629145600;
constexpr size_t OFF_VM = 729808896;
constexpr size_t OFF_QD = 796917760;
constexpr size_t OFF_KD = 864026624;
constexpr size_t OFF_H2 = OFF_QM;
constexpr size_t OFF_TOPK = OFF_VM;

struct Params {
  const float* in[25];
  float* out;
  char* ws;
  int ph_begin, ph_end;
};

DI unsigned pk2(float a, float b) {
  bf2_t r; r[0] = (__bf16)a; r[1] = (__bf16)b; return __builtin_bit_cast(unsigned, r);
}
DI float bflo(unsigned u) { return __uint_as_float(u << 16); }
DI float bfhi(unsigned u) { return __uint_as_float(u & 0xffff0000u); }
DI float dot2bf(unsigned a, unsigned b, float c) {
  return __builtin_amdgcn_fdot2_f32_bf16(__builtin_bit_cast(bf2_t, a), __builtin_bit_cast(bf2_t, b), c, false);
}
DI float wave_sum(float v) {
#pragma unroll
  for (int o = 32; o; o >>= 1) v += __shfl_xor(v, o);
  return v;
}
DI int lbid() { int t = blockIdx.x; asm volatile("" : "+s"(t)); return t; }
DI int lgdim() { int t = gridDim.x; asm volatile("" : "+s"(t)); return t; }
DI int ltid() { int t = threadIdx.x; asm volatile("" : "+v"(t)); return t; }
DI s16x4 trread(const char* p) { return __builtin_amdgcn_ds_read_tr16_b64_v4i16(LDSP(s16x4, p)); }
DI unsigned xcc_id() { return (unsigned)__builtin_amdgcn_s_getreg((3 << 11) | 20) & 0x7u; }
template <class F>
DI void xcd_tiles(char* ws, int set, int nft, F body) {
  __shared__ int sh_item;
  unsigned* cnt = (unsigned*)(ws + OFF_CNT);
  const int x0 = (int)xcc_id();
  const int per = 32 * nft;
  for (int q = 0; q < 8; ++q) {
    const int x = (x0 + q) & 7;
    for (;;) {
      __syncthreads();
      if (threadIdx.x == 0) sh_item = (int)atomicAdd(cnt + (set * 8 + x) * 32, 1u);
      __syncthreads();
      const int it = sh_item;
      if (it >= per) break;
      body(32 * x + it / nft, it % nft);
    }
  }
}

constexpr int G_ARS = 576;
constexpr int G_ASZ = 64 * G_ARS, G_BSZ = 256 * 144, G_STAGE = G_ASZ + G_BSZ;

template <int K, bool SUMSQ, class Epi>
DI void gemm_tile(const u16* __restrict__ W, int ldw, int n0, const u16* __restrict__ X, int ldx, size_t t0,
                  char* smem, Epi epi) {
  constexpr int KT = K / 64;
  const int tid = ltid(), lane = tid & 63, w = tid >> 6, h = lane >> 5, r = lane & 31;
  const int wf = w & 1, wt = w >> 1;
  const int blk = (lane >> 4) & 1, q4 = (lane & 15) >> 2, p4 = lane & 3;
  u32x4 ra[4], rb[4];
  const unsigned aoff = (unsigned)((tid >> 5) * ldw + (tid & 31) * 8), boff = (unsigned)((tid >> 3) * ldx + (tid & 7) * 8);
  const unsigned asoff = (unsigned)((tid >> 5) * G_ARS + (tid & 31) * 16), bsoff = (unsigned)(G_ASZ + (tid >> 3) * 144 + (tid & 7) * 16);
  auto gload = [&](int kt) __attribute__((always_inline)) {
    const u16* wk = W + (size_t)kt * 64 * ldw + n0;
    const u16* xk = X + t0 * (size_t)ldx + kt * 64;
#pragma unroll
    for (int i = 0; i < 4; ++i) ra[i] = *(const u32x4*)(wk + (size_t)i * 16 * ldw + aoff);
#pragma unroll
    for (int i = 0; i < 4; ++i) rb[i] = *(const u32x4*)(xk + (size_t)i * 64 * ldx + boff);
  };
  auto sstore = [&](char* buf) __attribute__((always_inline)) {
#pragma unroll
    for (int i = 0; i < 4; ++i) *(u32x4*)(buf + asoff + i * 16 * G_ARS) = ra[i];
#pragma unroll
    for (int i = 0; i < 4; ++i) *(u32x4*)(buf + bsoff + i * 64 * 144) = rb[i];
  };
  f32x16 acc[2][4];
#pragma unroll
  for (int g = 0; g < 2; ++g)
#pragma unroll
    for (int c = 0; c < 4; ++c)
#pragma unroll
      for (int i = 0; i < 16; ++i) acc[g][c][i] = 0.f;
  float ss0 = 0.f, ss1 = 0.f;
  auto compute = [&](const char* buf) __attribute__((always_inline)) {
    u32x4 bfr[2][2];
    s16x4 alo[2][4], ahi[2][4];
    auto lfrag = [&](int s, int slot) __attribute__((always_inline)) {
      bfr[slot][0] = *(const u32x4*)(buf + G_ASZ + (64 * wt + r) * 144 + (16 * s + 8 * h) * 2);
      bfr[slot][1] = *(const u32x4*)(buf + G_ASZ + (64 * wt + 32 + r) * 144 + (16 * s + 8 * h) * 2);
#pragma unroll
      for (int c = 0; c < 4; ++c) {
        const char* ap = buf + (16 * s + 8 * h + q4) * G_ARS + (128 * wf + 32 * c + 16 * blk) * 2 + 8 * p4;
        alo[slot][c] = trread(ap); ahi[slot][c] = trread(ap + 4 * G_ARS);
      }
    };
    lfrag(0, 0);
#pragma unroll
    for (int s = 0; s < 4; ++s) {
      if (s < 3) lfrag(s + 1, (s + 1) & 1);
      __builtin_amdgcn_sched_barrier(0);
      const u32x4 b0r = bfr[s & 1][0], b1r = bfr[s & 1][1];
      if (SUMSQ) {
        ss0 = dot2bf(b0r.x, b0r.x, ss0); ss0 = dot2bf(b0r.y, b0r.y, ss0);
        ss0 = dot2bf(b0r.z, b0r.z, ss0); ss0 = dot2bf(b0r.w, b0r.w, ss0);
        ss1 = dot2bf(b1r.x, b1r.x, ss1); ss1 = dot2bf(b1r.y, b1r.y, ss1);
        ss1 = dot2bf(b1r.z, b1r.z, ss1); ss1 = dot2bf(b1r.w, b1r.w, ss1);
      }
      const bf16x8 b0 = __builtin_bit_cast(bf16x8, b0r), b1 = __builtin_bit_cast(bf16x8, b1r);
#pragma unroll
      for (int c = 0; c < 4; ++c) {
        const bf16x8 a = __builtin_shufflevector(alo[s & 1][c], ahi[s & 1][c], 0, 1, 2, 3, 4, 5, 6, 7);
        acc[0][c] = MFMA(a, b0, acc[0][c]);
        acc[1][c] = MFMA(a, b1, acc[1][c]);
      }
      __builtin_amdgcn_sched_barrier(0);
    }
  };
  gload(0);
  sstore(smem);
  __syncthreads();
  for (int kt = 0; kt < KT; ++kt) {
    char* buf = smem + (kt & 1) * G_STAGE;
    if (kt + 1 < KT) gload(kt + 1);
    __builtin_amdgcn_sched_barrier(0);
    compute(buf);
    if (kt + 1 < KT) sstore(smem + ((kt + 1) & 1) * G_STAGE);
    __syncthreads();
  }
  if (SUMSQ) { ss0 += __shfl_xor(ss0, 32); ss1 += __shfl_xor(ss1, 32); }
  epi(acc[0], ss0, (int)t0 + 64 * wt + r, h, wf, smem + w * 17408, 0);
  epi(acc[1], ss1, (int)t0 + 64 * wt + 32 + r, h, wf, smem + w * 17408, 1);
}

DI void phase0(const Params& p, char* smem) {
  const int tid = ltid(), G = lgdim(), g = lbid();
  const size_t gt = (size_t)g * 512 + tid, NT = (size_t)G * 512;
  float* mod = (float*)(p.ws + OFF_MOD);
  for (int item = g; item < 96; item += G) {
    float* sc = (float*)smem;
    float* red = sc + 16384;
    for (int i = tid; i < 16384; i += 512) { float v = p.in[1][i]; sc[i] = v / (1.f + expf(-v)); }
    __syncthreads();
    const int col = tid & 63, kg = tid >> 6, n = item * 64 + col;
    float acc[16];
#pragma unroll
    for (int b = 0; b < 16; ++b) acc[b] = 0.f;
    const float* aw = p.in[2] + (size_t)(kg * 128) * 6144 + n;
#pragma unroll 4
    for (int k = 0; k < 128; ++k) {
      float wv = aw[(size_t)k * 6144];
#pragma unroll
      for (int b = 0; b < 16; ++b) acc[b] += sc[b * 1024 + kg * 128 + k] * wv;
    }
#pragma unroll
    for (int b = 0; b < 16; ++b) red[(kg * 16 + b) * 64 + col] = acc[b];
    __syncthreads();
    for (int o = tid; o < 1024; o += 512) {
      int b = o >> 6, cc = o & 63;
      float s = 0.f;
#pragma unroll
      for (int k2 = 0; k2 < 8; ++k2) s += red[(k2 * 16 + b) * 64 + cc];
      mod[b * 6144 + item * 64 + cc] = s + p.in[3][item * 64 + cc];
    }
    __syncthreads();
  }
  if (g == 0) {
    unsigned* cnt = (unsigned*)(p.ws + OFF_CNT);
    for (int i = tid; i < 8 * 8 * 32; i += 512) cnt[i] = 0u;
  }
  if (g == 0 && tid < 64) {
    float d1 = wave_sum(p.in[14][tid] * p.in[15][tid]);
    float d2 = wave_sum(p.in[16][tid] * p.in[17][tid]);
    if (tid == 0) *(float*)(p.ws + OFF_LAM) = expf(d1) - expf(d2) + 0.2f;
  }
  {
    float2* rope = (float2*)(p.ws + OFF_ROPE);
    for (size_t i = gt; i < 131072; i += NT) {
      int j = (int)(i & 31), sp = (int)(i >> 5);
      float inv = 1.0f / powf(10000.f, (float)j / 32.f);
      float ang = (float)sp * inv, sn, cs;
      sincosf(ang, &sn, &cs);
      rope[i] = make_float2(cs, sn);
    }
  }
  {
    u16* d = (u16*)(p.ws + OFF_WIN);
    for (size_t i = gt; i < (size_t)1024 * 2304; i += NT) {
      int k = (int)(i / 2304), n = (int)(i % 2304);
      float v = (n < 2240) ? p.in[5][(size_t)k * 2240 + n] : 0.f;
      d[i] = (u16)(pk2(v, 0.f) & 0xffff);
    }
  }
  {
    u16* d = (u16*)(p.ws + OFF_WQ);
    for (size_t i = gt; i < (size_t)384 * 768; i += NT) {
      int k = (int)(i / 768), n = (int)(i % 768);
      int src = (n < 512) ? (n >> 7) * 192 + (n & 127) : ((n - 512) >> 6) * 192 + 128 + ((n - 512) & 63);
      float v = p.in[7][(size_t)k * 768 + src] * p.in[6][k];
      d[i] = (u16)(pk2(v, 0.f) & 0xffff);
    }
  }
  {
    u16* d = (u16*)(p.ws + OFF_WKV);
    for (size_t i = gt; i < (size_t)256 * 1024; i += NT) {
      int k = (int)(i >> 10), n = (int)(i & 1023);
      int src = (n < 512) ? (n >> 7) * 256 + (n & 127) : ((n - 512) >> 7) * 256 + 128 + (n & 127);
      float v = p.in[9][(size_t)k * 1024 + src] * p.in[8][k];
      d[i] = (u16)(pk2(v, 0.f) & 0xffff);
    }
  }
  auto conv8 = [&](const float* src, u16* dst, size_t n8) __attribute__((always_inline)) {
    for (size_t i = gt; i < n8; i += NT) {
      float4 a = ((const float4*)src)[2 * i], b = ((const float4*)src)[2 * i + 1];
      uint4 o; o.x = pk2(a.x, a.y); o.y = pk2(a.z, a.w); o.z = pk2(b.x, b.y); o.w = pk2(b.z, b.w);
      ((uint4*)dst)[i] = o;
    }
  };
  conv8(p.in[19], (u16*)(p.ws + OFF_WOUT), (size_t)1024 * 1024 / 8);
  conv8(p.in[21], (u16*)(p.ws + OFF_WPQ), (size_t)1024 * 2048 / 8);
  conv8(p.in[22], (u16*)(p.ws + OFF_SK), (size_t)16 * 128 * 128 / 8);
}

DI void rownorm_phase(const Params& p, const float* src, const float* gain, int sh_off, int sc_off, u16* dst) {
  const int lane = ltid() & 63;
  const int gw = lbid() * 8 + (ltid() >> 6), NW = lgdim() * 8;
  const float* mod = (const float*)(p.ws + OFF_MOD);
  for (int t = gw; t < T_; t += NW) {
    const int b = t >> 12;
    const float* mb = mod + b * 6144;
#pragma unroll
    for (int c = 0; c < 2; ++c) {
    }
    float xv[16];
#pragma unroll
    for (int c = 0; c < 2; ++c) {
      const float4* sp = (const float4*)(src + (size_t)t * 1024 + c * 512 + lane * 8);
      float4 a = sp[0], bq = sp[1];
      xv[c * 8 + 0] = a.x; xv[c * 8 + 1] = a.y; xv[c * 8 + 2] = a.z; xv[c * 8 + 3] = a.w;
      xv[c * 8 + 4] = bq.x; xv[c * 8 + 5] = bq.y; xv[c * 8 + 6] = bq.z; xv[c * 8 + 7] = bq.w;
    }
    float ss = 0.f;
#pragma unroll
    for (int i = 0; i < 16; ++i) ss += xv[i] * xv[i];
    ss = wave_sum(ss);
    const float rinv = rsqrtf(ss * (1.f / 1024.f) + EPS);
#pragma unroll
    for (int c = 0; c < 2; ++c) {
      const int d0 = c * 512 + lane * 8;
      float o[8];
#pragma unroll
      for (int q = 0; q < 2; ++q) {
        float4 gg = *(const float4*)(gain + d0 + 4 * q);
        float4 sc = *(const float4*)(mb + sc_off + d0 + 4 * q);
        float4 sh = *(const float4*)(mb + sh_off + d0 + 4 * q);
        o[4 * q + 0] = xv[c * 8 + 4 * q + 0] * rinv * gg.x * (1.f + sc.x) + sh.x;
        o[4 * q + 1] = xv[c * 8 + 4 * q + 1] * rinv * gg.y * (1.f + sc.y) + sh.y;
        o[4 * q + 2] = xv[c * 8 + 4 * q + 2] * rinv * gg.z * (1.f + sc.z) + sh.z;
        o[4 * q + 3] = xv[c * 8 + 4 * q + 3] * rinv * gg.w * (1.f + sc.w) + sh.w;
      }
      uint4 ov; ov.x = pk2(o[0], o[1]); ov.y = pk2(o[2], o[3]); ov.z = pk2(o[4], o[5]); ov.w = pk2(o[6], o[7]);
      *(uint4*)(dst + (size_t)t * LDH + d0) = ov;
    }
  }
}

DI void store_tile_bf16_lds(f32x16 (&acc)[4], char* wsm, u16* dst0, size_t ld, int lane) {
  const int h = lane >> 5, r = lane & 31;
#pragma unroll
  for (int c = 0; c < 4; ++c)
#pragma unroll
    for (int gq = 0; gq < 4; ++gq) {
      uint2 v; v.x = pk2(acc[c][4 * gq], acc[c][4 * gq + 1]); v.y = pk2(acc[c][4 * gq + 2], acc[c][4 * gq + 3]);
      *(uint2*)(wsm + r * 272 + (32 * c + 8 * gq + 4 * h) * 2) = v;
    }
#pragma unroll
  for (int j = 0; j < 8; ++j) {
    const int idx = lane + 64 * j, row = idx >> 4, c16 = idx & 15;
    const u32x4 v = *(const u32x4*)(wsm + row * 272 + c16 * 16);
    *(u32x4*)(dst0 + (size_t)row * ld + c16 * 8) = v;
  }
}

template <class AddrFn>
DI void store_rows_bf16_lds(f32x16 (&acc)[4], char* wsm, int lane, AddrFn addr) {
  const int h = lane >> 5, r = lane & 31;
#pragma unroll
  for (int c = 0; c < 4; ++c)
#pragma unroll
    for (int gq = 0; gq < 4; ++gq) {
      uint2 v; v.x = pk2(acc[c][4 * gq], acc[c][4 * gq + 1]); v.y = pk2(acc[c][4 * gq + 2], acc[c][4 * gq + 3]);
      *(uint2*)(wsm + r * 272 + (32 * c + 8 * gq + 4 * h) * 2) = v;
    }
#pragma unroll
  for (int j = 0; j < 8; ++j) {
    const int idx = lane + 64 * j, row = idx >> 4, c16 = idx & 15;
    const u32x4 v = *(const u32x4*)(wsm + row * 272 + c16 * 16);
    *(u32x4*)addr(row, c16) = v;
  }
}

DI void phase_qkv(const Params& p, char* smem) {
  const int G = lgdim();
  const u16* proj = (const u16*)(p.ws + OFF_PROJ);
  const float2* rope = (const float2*)(p.ws + OFF_ROPE);
  u16* Qm = (u16*)(p.ws + OFF_QM); u16* Km = (u16*)(p.ws + OFF_KM); u16* Vm = (u16*)(p.ws + OFF_VM);
  u16* Qd = (u16*)(p.ws + OFF_QD); u16* Kd = (u16*)(p.ws + OFF_KD);
  const float QS = 0.07216878364870322f * LOG2E;
  xcd_tiles(p.ws, 1, 3, [&](int tt, int ft2) __attribute__((always_inline)) {
    const float* qg = p.in[10];
    gemm_tile<384, true>((const u16*)(p.ws + OFF_WQ), 768, ft2 * 256, proj, NPROJ, (size_t)tt * 256, smem,
      [&](f32x16 (&acc)[4], float ss, int t, int h, int wf, char* wbase, int tg) __attribute__((always_inline)) {
        const int ft = ft2 * 2 + wf;
        const float rinv = rsqrtf(ss * (1.f / 384.f) + EPS);
        const int lane = ltid() & 63, tg0 = t & ~31, b = tg0 >> 12, s0 = tg0 & 4095, s = t & 4095;
        char* wsm = wbase + tg * 8704;
        if (ft < 4) {
          float s2 = 0.f;
#pragma unroll
          for (int c = 0; c < 4; ++c)
#pragma unroll
            for (int k = 0; k < 16; ++k) { float v = acc[c][k] * rinv; s2 += v * v; }
          s2 += __shfl_xor(s2, 32);
          const float r2 = rsqrtf(s2 * (1.f / 128.f) + EPS) * rinv * QS;
#pragma unroll
          for (int c = 0; c < 4; ++c)
#pragma unroll
            for (int gq = 0; gq < 4; ++gq) {
              const int d = 32 * c + 8 * gq + 4 * h;
              float4 gg = *(const float4*)(qg + d);
              acc[c][4 * gq] *= r2 * gg.x; acc[c][4 * gq + 1] *= r2 * gg.y;
              acc[c][4 * gq + 2] *= r2 * gg.z; acc[c][4 * gq + 3] *= r2 * gg.w;
            }
          u16* base = Qm + ((size_t)(b * 4 + ft) * S_ + s0) * 192;
          store_rows_bf16_lds(acc, wsm, lane, [&](int row, int c16) __attribute__((always_inline)) { return base + (size_t)row * 192 + c16 * 8; });
        } else {
#pragma unroll
          for (int cp = 0; cp < 2; ++cp) {
            float s2 = 0.f;
#pragma unroll
            for (int k = 0; k < 16; ++k) {
              float v1 = acc[2 * cp][k] * rinv, v2 = acc[2 * cp + 1][k] * rinv;
              s2 += v1 * v1 + v2 * v2;
            }
            s2 += __shfl_xor(s2, 32);
            const float r2 = rsqrtf(s2 * (1.f / 64.f) + EPS) * rinv;
#pragma unroll
            for (int gq = 0; gq < 4; ++gq) {
              const int j = 8 * gq + 4 * h;
              float4 g1 = *(const float4*)(qg + 128 + j), g2 = *(const float4*)(qg + 160 + j);
              const float4* rp = (const float4*)(rope + s * 32 + j);
              float4 cs01 = rp[0], cs23 = rp[1];
              float x1, x2;
              x1 = acc[2 * cp][4 * gq + 0] * r2 * g1.x; x2 = acc[2 * cp + 1][4 * gq + 0] * r2 * g2.x;
              acc[2 * cp][4 * gq + 0] = (x1 * cs01.x - x2 * cs01.y) * QS; acc[2 * cp + 1][4 * gq + 0] = (x2 * cs01.x + x1 * cs01.y) * QS;
              x1 = acc[2 * cp][4 * gq + 1] * r2 * g1.y; x2 = acc[2 * cp + 1][4 * gq + 1] * r2 * g2.y;
              acc[2 * cp][4 * gq + 1] = (x1 * cs01.z - x2 * cs01.w) * QS; acc[2 * cp + 1][4 * gq + 1] = (x2 * cs01.z + x1 * cs01.w) * QS;
              x1 = acc[2 * cp][4 * gq + 2] * r2 * g1.z; x2 = acc[2 * cp + 1][4 * gq + 2] * r2 * g2.z;
              acc[2 * cp][4 * gq + 2] = (x1 * cs23.x - x2 * cs23.y) * QS; acc[2 * cp + 1][4 * gq + 2] = (x2 * cs23.x + x1 * cs23.y) * QS;
              x1 = acc[2 * cp][4 * gq + 3] * r2 * g1.w; x2 = acc[2 * cp + 1][4 * gq + 3] * r2 * g2.w;
              acc[2 * cp][4 * gq + 3] = (x1 * cs23.z - x2 * cs23.w) * QS; acc[2 * cp + 1][4 * gq + 3] = (x2 * cs23.z + x1 * cs23.w) * QS;
            }
          }
          u16* base = Qm + ((size_t)(b * 4 + (ft - 4) * 2) * S_ + s0) * 192 + 128;
          store_rows_bf16_lds(acc, wsm, lane, [&](int row, int c16) __attribute__((always_inline)) {
            return base + (size_t)(c16 >> 3) * S_ * 192 + (size_t)row * 192 + (c16 & 7) * 8; });
        }
      });
  });
  xcd_tiles(p.ws, 2, 4, [&](int tt, int ft2) __attribute__((always_inline)) {
    const float* kg = p.in[11];
    gemm_tile<256, true>((const u16*)(p.ws + OFF_WKV), 1024, ft2 * 256, proj + 384, NPROJ, (size_t)tt * 256, smem,
      [&](f32x16 (&acc)[4], float ss, int t, int h, int wf, char* wbase, int tg) __attribute__((always_inline)) {
        const int ft = ft2 * 2 + wf;
        const float rinv = rsqrtf(ss * (1.f / 256.f) + EPS);
        const int lane = ltid() & 63, tg0 = t & ~31, b = tg0 >> 12, s0 = tg0 & 4095;
        char* wsm = wbase + tg * 8704;
        if (ft < 4) {
          float s2 = 0.f;
#pragma unroll
          for (int c = 0; c < 4; ++c)
#pragma unroll
            for (int k = 0; k < 16; ++k) { float v = acc[c][k] * rinv; s2 += v * v; }
          s2 += __shfl_xor(s2, 32);
          const float r2 = rsqrtf(s2 * (1.f / 128.f) + EPS) * rinv;
#pragma unroll
          for (int c = 0; c < 4; ++c)
#pragma unroll
            for (int gq = 0; gq < 4; ++gq) {
              const int d = 32 * c + 8 * gq + 4 * h;
              float4 gg = *(const float4*)(kg + d);
              acc[c][4 * gq] *= r2 * gg.x; acc[c][4 * gq + 1] *= r2 * gg.y;
              acc[c][4 * gq + 2] *= r2 * gg.z; acc[c][4 * gq + 3] *= r2 * gg.w;
            }
          u16* base = Km + ((size_t)(b * 4 + ft) * S_ + s0) * 192;
          store_rows_bf16_lds(acc, wsm, lane, [&](int row, int c16) __attribute__((always_inline)) { return base + (size_t)row * 192 + c16 * 8; });
        } else {
#pragma unroll
          for (int c = 0; c < 4; ++c)
#pragma unroll
            for (int k = 0; k < 16; ++k) acc[c][k] *= rinv;
          u16* base = Vm + ((size_t)(b * 4 + (ft - 4)) * S_ + s0) * 128;
          store_rows_bf16_lds(acc, wsm, lane, [&](int row, int c16) __attribute__((always_inline)) { return base + (size_t)row * 128 + c16 * 8; });
        }
      });
  });
  {
    const size_t gt = (size_t)lbid() * 512 + ltid(), NT = (size_t)G * 512;
    for (size_t e = gt; e < (size_t)T_ * 17; e += NT) {
      const int t = (int)(e / 17), gi = (int)(e % 17);
      const int b = t >> 12, s = t & 4095;
      const u16* src; const float* gain; float scale; u16* dst; int ncopy = 1; size_t cstride = 0;
      if (gi == 0) {
        src = proj + (size_t)t * NPROJ + 640; gain = p.in[11] + 128; scale = 1.f;
        dst = Km + ((size_t)(b * 4) * S_ + s) * 192 + 128; ncopy = 4; cstride = (size_t)S_ * 192;
      } else if (gi < 9) {
        const int j = gi - 1;
        src = proj + (size_t)t * NPROJ + 704 + j * 64; gain = p.in[12]; scale = 0.125f * LOG2E;
        dst = Qd + ((size_t)(b * 8 + j) * S_ + s) * 64;
      } else {
        const int j = gi - 9;
        src = proj + (size_t)t * NPROJ + 1216 + j * 64; gain = p.in[13]; scale = 1.f;
        dst = Kd + ((size_t)(b * 8 + j) * S_ + s) * 64;
      }
      uint4 raw[8];
#pragma unroll
      for (int q = 0; q < 8; ++q) raw[q] = ((const uint4*)src)[q];
      float ss = 0.f;
#pragma unroll
      for (int q = 0; q < 8; ++q) {
        ss = dot2bf(raw[q].x, raw[q].x, ss); ss = dot2bf(raw[q].y, raw[q].y, ss);
        ss = dot2bf(raw[q].z, raw[q].z, ss); ss = dot2bf(raw[q].w, raw[q].w, ss);
      }
      const float rinv = rsqrtf(ss * (1.f / 64.f) + EPS);
      const float rs = rinv * scale;
#pragma unroll
      for (int q = 0; q < 4; ++q) {
        const unsigned lo[4] = {raw[q].x, raw[q].y, raw[q].z, raw[q].w};
        const unsigned hi[4] = {raw[q + 4].x, raw[q + 4].y, raw[q + 4].z, raw[q + 4].w};
        unsigned o1[4], o2[4];
#pragma unroll
        for (int e2 = 0; e2 < 4; ++e2) {
          const int k = 8 * q + 2 * e2;
          const float4 cs = *(const float4*)(rope + s * 32 + k);
          const float2 ga = *(const float2*)(gain + k), gb = *(const float2*)(gain + 32 + k);
          float x1a = bflo(lo[e2]) * rs * ga.x, x2a = bflo(hi[e2]) * rs * gb.x;
          float x1b = bfhi(lo[e2]) * rs * ga.y, x2b = bfhi(hi[e2]) * rs * gb.y;
          o1[e2] = pk2(x1a * cs.x - x2a * cs.y, x1b * cs.z - x2b * cs.w);
          o2[e2] = pk2(x2a * cs.x + x1a * cs.y, x2b * cs.z + x1b * cs.w);
        }
        uint4 v1 = make_uint4(o1[0], o1[1], o1[2], o1[3]), v2 = make_uint4(o2[0], o2[1], o2[2], o2[3]);
        for (int cpy = 0; cpy < ncopy; ++cpy) {
          ((uint4*)(dst + cpy * cstride))[q] = v1;
          ((uint4*)(dst + cpy * cstride))[q + 4] = v2;
        }
      }
    }
  }
}

template <int NS, int RSK, bool QLDS>
DI void qk_softmax32(const char* kbuf, const bf16x8 (&qf)[NS], const char* qlds, bool needmask, int keybase, int qrow, int h, int r,
                     float& mrun, float& lrun, f32x16 (&O)[4], bf16x8& pf0, bf16x8& pf1) {
  f32x16 sacc;
#pragma unroll
  for (int i = 0; i < 16; ++i) sacc[i] = 0.f;
#pragma unroll
  for (int s = 0; s < NS; ++s) {
    bf16x8 a = *(const bf16x8*)(kbuf + r * RSK + (16 * s + 8 * h) * 2);
    bf16x8 bq;
    if (QLDS) bq = *(const bf16x8*)(qlds + (16 * s + 8 * h) * 2); else bq = qf[s];
    sacc = MFMA(a, bq, sacc);
  }
  if (needmask) {
#pragma unroll
    for (int i = 0; i < 16; ++i) {
      const int key = keybase + 8 * (i >> 2) + 4 * h + (i & 3);
      if (key > qrow) sacc[i] = NEG_INF;
    }
  }
  float mx = sacc[0];
#pragma unroll
  for (int i = 1; i < 16; ++i) mx = fmaxf(mx, sacc[i]);
  mx = fmaxf(mx, __shfl_xor(mx, 32));
  if (__builtin_amdgcn_ballot_w64(mx > mrun + 8.f) != 0ull) {
    const float mnew = fmaxf(mrun, mx);
    const float alpha = __builtin_amdgcn_exp2f(mrun - mnew);
    mrun = mnew;
    lrun *= alpha;
#pragma unroll
    for (int c = 0; c < 4; ++c)
#pragma unroll
      for (int i = 0; i < 16; ++i) O[c][i] *= alpha;
  }
  float rs = 0.f;
#pragma unroll
  for (int i = 0; i < 16; ++i) {
    float pv = __builtin_amdgcn_exp2f(sacc[i] - mrun);
    rs += pv; sacc[i] = pv;
  }
  lrun += rs;
  uint4 pa, pb;
  pa.x = pk2(sacc[0], sacc[1]); pa.y = pk2(sacc[2], sacc[3]); pa.z = pk2(sacc[4], sacc[5]); pa.w = pk2(sacc[6], sacc[7]);
  pb.x = pk2(sacc[8], sacc[9]); pb.y = pk2(sacc[10], sacc[11]); pb.z = pk2(sacc[12], sacc[13]); pb.w = pk2(sacc[14], sacc[15]);
  pf0 = __builtin_bit_cast(bf16x8, pa);
  pf1 = __builtin_bit_cast(bf16x8, pb);
}

template <int DQK, int NMAP>
DI void attn_item(const u16* __restrict__ qb0, const u16* __restrict__ qb1, const u16* __restrict__ kb0,
                  const u16* __restrict__ kb1, const u16* __restrict__ vb, int vstride, int qblk,
                  u16* __restrict__ outp, const float* __restrict__ lamp, const float* __restrict__ subg, char* smem) {
  constexpr int NS = DQK / 16;
  constexpr int RSK = DQK * 2 + 16;
  constexpr int KTILE = 64 * RSK;
  constexpr int VOFF = NMAP * KTILE;
  constexpr int STAGE = VOFF + 64 * 320;
  constexpr int CPR = DQK / 8;
  constexpr int KCH = NMAP * 64 * CPR / 512;
  int tid_ = ltid();
  asm volatile("" : "+v"(tid_));
  const int tid = tid_, lane = tid & 63, w = tid >> 6, h = lane >> 5, r = lane & 31;
  const int blk = (lane >> 4) & 1, q4 = (lane & 15) >> 2, p4 = lane & 3;
  const int q0 = qblk * 256, wrow0 = q0 + 32 * w, qrow = wrow0 + r;
  const int nt = 4 * (qblk + 1);

  constexpr bool QL = (NMAP == 2);
  bf16x8 qfa[NS];
  if (!QL) {
#pragma unroll
    for (int s = 0; s < NS; ++s) qfa[s] = *(const bf16x8*)(qb0 + (size_t)qrow * DQK + 16 * s + 8 * h);
  } else {
#pragma unroll
    for (int s = 0; s < NS; ++s) qfa[s] = bf16x8{0, 0, 0, 0, 0, 0, 0, 0};
#pragma unroll
    for (int i = 0; i < 8; ++i) {
      const int id = tid + 512 * i, mp = id >> 11, rem = id & 2047, row = rem >> 3, c16 = rem & 7;
      *(u32x4*)(smem + 2 * STAGE + mp * 36864 + row * 144 + c16 * 16) =
          *(const u32x4*)((mp ? qb1 : qb0) + (size_t)(q0 + row) * DQK + c16 * 8);
    }
  }
  const char* qla = smem + 2 * STAGE + (32 * w + r) * 144;
  const char* qlb = qla + 36864;
  f32x16 Oa[4], Ob[4];
  float ma = NEG_INF, la = 0.f, mb = NEG_INF, lb = 0.f;
#pragma unroll
  for (int c = 0; c < 4; ++c)
#pragma unroll
    for (int i = 0; i < 16; ++i) { Oa[c][i] = 0.f; if (NMAP == 2) Ob[c][i] = 0.f; }

  u32x4 rk[KCH], rv[2];
  unsigned koff[KCH], voff[2];
#pragma unroll
  for (int i = 0; i < KCH; ++i) {
    const int id = tid + 512 * i;
    if (NMAP == 1) koff[i] = (unsigned)((id / CPR) * DQK + (id % CPR) * 8);
    else koff[i] = (unsigned)((((id & 511) >> 3)) * DQK + (id & 7) * 8);
  }
#pragma unroll
  for (int i = 0; i < 2; ++i) {
    const int id = tid + 512 * i;
    voff[i] = (unsigned)((id >> 4) * vstride + (id & 15) * 8);
  }
  auto gload = [&](int t) __attribute__((always_inline)) {
    const u16* k0t = kb0 + (size_t)t * 64 * DQK;
    const u16* k1t = (NMAP == 2) ? kb1 + (size_t)t * 64 * DQK : k0t;
    const u16* vt = vb + (size_t)t * 64 * vstride;
#pragma unroll
    for (int i = 0; i < KCH; ++i) rk[i] = *(const u32x4*)(((NMAP == 2 && i) ? k1t : k0t) + koff[i]);
#pragma unroll
    for (int i = 0; i < 2; ++i) rv[i] = *(const u32x4*)(vt + voff[i]);
  };
  auto sstore = [&](char* buf) __attribute__((always_inline)) {
#pragma unroll
    for (int i = 0; i < KCH; ++i) {
      const int id = tid + 512 * i;
      if (NMAP == 1) {
        const int row = id / CPR, c16 = id % CPR;
        *(u32x4*)(buf + row * RSK + c16 * 16) = rk[i];
      } else {
        const int rem = id & 511, row = rem >> 3, c16 = rem & 7;
        *(u32x4*)(buf + i * KTILE + row * RSK + c16 * 16) = rk[i];
      }
    }
#pragma unroll
    for (int i = 0; i < 2; ++i) {
      const int id = tid + 512 * i, row = id >> 4, c16 = id & 15;
      *(u32x4*)(buf + VOFF + row * 320 + c16 * 16) = rv[i];
    }
  };

  gload(0);
  sstore(smem);
  __syncthreads();
  for (int t = 0; t < nt; ++t) {
    char* buf = smem + (t & 1) * STAGE;
    if (t + 1 < nt) gload(t + 1);
    const int key0 = t * 64;
#pragma unroll
    for (int sub = 0; sub < 2; ++sub) {
      const int ko = sub * 32;
      if (key0 + ko <= wrow0 + 31) {
        const bool needmask = (key0 + ko + 31 > wrow0);
        bf16x8 pa0, pa1, pb0, pb1;
        qk_softmax32<NS, RSK, QL>(buf + ko * RSK, qfa, qla, needmask, key0 + ko, qrow, h, r, ma, la, Oa, pa0, pa1);
        if (NMAP == 2)
          qk_softmax32<NS, RSK, QL>(buf + KTILE + ko * RSK, qfa, qlb, needmask, key0 + ko, qrow, h, r, mb, lb, Ob, pb0, pb1);
#pragma unroll
        for (int ks = 0; ks < 2; ++ks)
#pragma unroll
          for (int c = 0; c < 4; ++c) {
            const char* ap = buf + VOFF + (ko + 16 * ks + 4 * h + q4) * 320 + (32 * c + 16 * blk) * 2 + 8 * p4;
            s16x4 lo = trread(ap), hi = trread(ap + 8 * 320);
            bf16x8 a = __builtin_shufflevector(lo, hi, 0, 1, 2, 3, 4, 5, 6, 7);
            Oa[c] = MFMA(a, ks ? pa1 : pa0, Oa[c]);
            if (NMAP == 2) Ob[c] = MFMA(a, ks ? pb1 : pb0, Ob[c]);
          }
      }
    }
    if (t + 1 < nt) sstore(smem + ((t + 1) & 1) * STAGE);
    __syncthreads();
  }
  const float inva = 1.f / (la + __shfl_xor(la, 32));
  if (NMAP == 1) {
#pragma unroll
    for (int c = 0; c < 4; ++c)
#pragma unroll
      for (int i = 0; i < 16; ++i) Oa[c][i] *= inva;
  } else {
    const float li = *lamp / (lb + __shfl_xor(lb, 32));
    float s2 = 0.f;
#pragma unroll
    for (int c = 0; c < 4; ++c)
#pragma unroll
      for (int i = 0; i < 16; ++i) {
        float v = Oa[c][i] * inva - li * Ob[c][i];
        Oa[c][i] = v; s2 += v * v;
      }
    s2 += __shfl_xor(s2, 32);
    const float rn = rsqrtf(s2 * (1.f / 128.f) + EPS) * 0.8f;
#pragma unroll
    for (int c = 0; c < 4; ++c)
#pragma unroll
      for (int gq = 0; gq < 4; ++gq) {
        const int d = 32 * c + 8 * gq + 4 * h;
        asm volatile("" ::: "memory");
        float4 gg = *(const float4*)(subg + d);
        Oa[c][4 * gq] *= rn * gg.x; Oa[c][4 * gq + 1] *= rn * gg.y; Oa[c][4 * gq + 2] *= rn * gg.z; Oa[c][4 * gq + 3] *= rn * gg.w;
      }
  }
  {
    u16* base = outp + (size_t)wrow0 * LDH;
    store_rows_bf16_lds(Oa, smem + w * 8704, lane, [&](int row, int c16) __attribute__((always_inline)) { return base + (size_t)row * LDH + c16 * 8; });
  }
  __syncthreads();
}

DI void conv_table_slice(const float* __restrict__ src, uint2* __restrict__ dst, float scale, int slice, int nslices) {
  const size_t groups = (size_t)16384 * 1024 / 16;
  const size_t gt = (size_t)lbid() * 512 + ltid(), NT = (size_t)lgdim() * 512;
  const size_t lo = groups * slice / nslices, hi = groups * (slice + 1) / nslices;
  for (size_t i = lo + gt; i < hi; i += NT) {
    const float4* sp = (const float4*)src + 4 * i;
    float4 a0 = sp[0], a1 = sp[1], a2 = sp[2], a3 = sp[3];
    unsigned w0 = 0, w1 = 0;
    w0 = __builtin_amdgcn_cvt_scalef32_pk_fp4_f32(w0, a0.x * scale, a0.y * scale, 1.0f, 0);
    w0 = __builtin_amdgcn_cvt_scalef32_pk_fp4_f32(w0, a0.z * scale, a0.w * scale, 1.0f, 1);
    w0 = __builtin_amdgcn_cvt_scalef32_pk_fp4_f32(w0, a1.x * scale, a1.y * scale, 1.0f, 2);
    w0 = __builtin_amdgcn_cvt_scalef32_pk_fp4_f32(w0, a1.z * scale, a1.w * scale, 1.0f, 3);
    w1 = __builtin_amdgcn_cvt_scalef32_pk_fp4_f32(w1, a2.x * scale, a2.y * scale, 1.0f, 0);
    w1 = __builtin_amdgcn_cvt_scalef32_pk_fp4_f32(w1, a2.z * scale, a2.w * scale, 1.0f, 1);
    w1 = __builtin_amdgcn_cvt_scalef32_pk_fp4_f32(w1, a3.x * scale, a3.y * scale, 1.0f, 2);
    w1 = __builtin_amdgcn_cvt_scalef32_pk_fp4_f32(w1, a3.z * scale, a3.w * scale, 1.0f, 3);
    dst[i] = make_uint2(w0, w1);
  }
}

DI void phase_attn(const Params& p, char* smem) {
  const int G = lgdim(), g = lbid();
  const u16* Qm = (const u16*)(p.ws + OFF_QM); const u16* Km = (const u16*)(p.ws + OFF_KM);
  const u16* Vm = (const u16*)(p.ws + OFF_VM); const u16* Qd = (const u16*)(p.ws + OFF_QD);
  const u16* Kd = (const u16*)(p.ws + OFF_KD); const u16* proj = (const u16*)(p.ws + OFF_PROJ);
  u16* mixed = (u16*)(p.ws + OFF_H);
  const float* lamp = (const float*)(p.ws + OFF_LAM);
  const int nrounds = (2048 + G - 1) / G;
  for (int k = 0; k * G < 2048; ++k) {
    conv_table_slice(p.in[23], (uint2*)(p.ws + OFF_U), U_SCALE, k, nrounds);
    conv_table_slice(p.in[24], (uint2*)(p.ws + OFF_V), V_SCALE, k, nrounds);
    const int idx = (k & 1) ? k * G + (G - 1 - g) : k * G + g;
    if (idx >= 2048) continue;
    const int level = idx >> 7, qblk = 15 - level, j = idx & 127, type = j & 1, bh = j >> 1;
    const int b = bh >> 2, hd = bh & 3;
    if (type == 0) {
      const size_t ho = (size_t)(b * 4 + hd) * S_;
      attn_item<192, 1>(Qm + ho * 192, nullptr, Km + ho * 192, nullptr, Vm + ho * 128, 128, qblk,
                        mixed + (size_t)b * S_ * LDH + hd * 128, lamp, nullptr, smem);
    } else {
      const size_t h0 = (size_t)(b * 8 + 2 * hd) * S_ * 64, h1 = h0 + (size_t)S_ * 64;
      attn_item<64, 2>(Qd + h0, Qd + h1, Kd + h0, Kd + h1, proj + (size_t)b * S_ * NPROJ + 1728 + hd * 128, NPROJ,
                       qblk, mixed + (size_t)b * S_ * LDH + 512 + hd * 128, lamp, p.in[18], smem);
    }
  }
}

template <int ST>
DI void ins1(float (&T)[16], float s) {
#pragma unroll
  for (int j = 15; j > ST; --j) T[j] = __builtin_amdgcn_fmed3f(T[j - 1], s, T[j]);
  T[ST] = fmaxf(T[ST], s);
}
DI void peer_scores_top16(const char* sk, const u16* __restrict__ pqrow, int lane, float (&T)[16]) {
  const int h = lane >> 5, r = lane & 31;
  bf16x8 bq[8];
#pragma unroll
  for (int s = 0; s < 8; ++s) bq[s] = *(const bf16x8*)(pqrow + 16 * s + 8 * h);
#pragma unroll
  for (int j = 0; j < 16; ++j) T[j] = NEG_INF;
#pragma unroll
  for (int c = 0; c < 4; ++c) {
    f32x16 acc;
#pragma unroll
    for (int i = 0; i < 16; ++i) acc[i] = 0.f;
#pragma unroll
    for (int s = 0; s < 8; ++s) {
      bf16x8 a = *(const bf16x8*)(sk + (32 * c + r) * 272 + (16 * s + 8 * h) * 2);
      acc = MFMA(a, bq[s], acc);
    }
#pragma unroll
    for (int i = 0; i < 16; ++i) {
      const unsigned code = (unsigned)(127 - 32 * c - (i & 3) - 8 * (i >> 2)) - 4u * (unsigned)h;
      ins1<0>(T, __uint_as_float((__float_as_uint(acc[i]) & 0xffffff80u) | code));
    }
  }
  float o[16];
#pragma unroll
  for (int j = 0; j < 16; ++j) o[j] = __shfl_xor(T[j], 32);
  ins1<0>(T, o[0]); ins1<1>(T, o[1]); ins1<2>(T, o[2]); ins1<3>(T, o[3]);
  ins1<4>(T, o[4]); ins1<5>(T, o[5]); ins1<6>(T, o[6]); ins1<7>(T, o[7]);
  ins1<8>(T, o[8]); ins1<9>(T, o[9]); ins1<10>(T, o[10]); ins1<11>(T, o[11]);
  ins1<12>(T, o[12]); ins1<13>(T, o[13]); ins1<14>(T, o[14]); ins1<15>(T, o[15]);
}

DI float gelu_exact(float x) { return 0.5f * x * (1.f + erff(x * 0.7071067811865476f)); }

DI void load_sk(char* smem, const u16* SK, int hp, int tid) {
#pragma unroll
  for (int i = 0; i < 4; ++i) {
    const int id = tid + 512 * i, row = id >> 4, c16 = id & 15;
    *(u32x4*)(smem + row * 272 + c16 * 16) = *(const u32x4*)(SK + (size_t)hp * 16384 + row * 128 + c16 * 8);
  }
}

DI void peer_route(const Params& p, char* smem, int t0) {
  const int tid = ltid(), lane = tid & 63, w = tid >> 6, h = lane >> 5, r = lane & 31;
  const u16* pq = (const u16*)(p.ws + OFF_PROJ);
  const u16* SK = (const u16*)(p.ws + OFF_SK);
  uint2* topk = (uint2*)(p.ws + OFF_TOPK);
    const int tq = t0 + 32 * w + r;
#pragma unroll 1
    for (int hd = 0; hd < 8; ++hd) {
      float TA[16], TB[16];
      __syncthreads();
      load_sk(smem, SK, hd * 2, tid);
      __syncthreads();
      peer_scores_top16(smem, pq + (size_t)tq * 2048 + (hd * 2) * 128, lane, TA);
      __syncthreads();
      load_sk(smem, SK, hd * 2 + 1, tid);
      __syncthreads();
      peer_scores_top16(smem, pq + (size_t)tq * 2048 + (hd * 2 + 1) * 128, lane, TB);
      float FK[16];
#pragma unroll
      for (int j = 0; j < 16; ++j) FK[j] = NEG_INF;
#pragma unroll
      for (int i = 0; i < 16; ++i)
#pragma unroll
        for (int j = 0; j < 16; ++j)
          if ((i + 1) * (j + 1) <= 16) {
            const float cv = __uint_as_float(__float_as_uint(TA[i]) & 0xffffff80u) + __uint_as_float(__float_as_uint(TB[j]) & 0xffffff80u);
            const float key = __uint_as_float((__float_as_uint(cv) & 0xffffff00u) | (unsigned)(255 - (16 * i + j)));
            const int st = (i + 1) * (j + 1) - 1;
#pragma unroll
            for (int q = 15; q >= 1; --q)
              if (q > st) FK[q] = __builtin_amdgcn_fmed3f(FK[q - 1], key, FK[q]);
            FK[st] = fmaxf(FK[st], key);
          }
      float FV[16]; int FI[16];
#pragma unroll
      for (int m = 0; m < 16; ++m) {
        const unsigned kb = __float_as_uint(FK[m]);
        const int code = 255 - (int)(kb & 255u), ci = code >> 4, cj = code & 15;
        FV[m] = __uint_as_float(kb & 0xffffff00u);
        float ra = TA[0], rb = TB[0];
#pragma unroll
        for (int q = 1; q < 16; ++q) { ra = (ci == q) ? TA[q] : ra; rb = (cj == q) ? TB[q] : rb; }
        FI[m] = (127 - (int)(__float_as_uint(ra) & 127u)) * 128 + (127 - (int)(__float_as_uint(rb) & 127u));
      }
      float e[16], sum = 0.f;
#pragma unroll
      for (int j = 0; j < 16; ++j) { e[j] = expf(FV[j] - FV[0]); sum += e[j]; }
      const float rs = 1.f / sum;
      if (h == 0) {
        u32x4* dst = (u32x4*)(topk + (size_t)tq * 128 + hd * 16);
#pragma unroll
        for (int q = 0; q < 8; ++q) {
          u32x4 o;
          o.x = (unsigned)FI[2 * q]; o.y = __float_as_uint(e[2 * q] * rs);
          o.z = (unsigned)FI[2 * q + 1]; o.w = __float_as_uint(e[2 * q + 1] * rs);
          dst[q] = o;
        }
      }
    }
}

DI void peer_gather(const Params& p, int t0) {
  const int tid = ltid(), lane = tid & 63, w = tid >> 6;
  const uint2* topk = (const uint2*)(p.ws + OFF_TOPK);
  const float* mod = (const float*)(p.ws + OFF_MOD);
  const unsigned char* U8 = (const unsigned char*)(p.ws + OFF_U);
  const unsigned char* V8 = (const unsigned char*)(p.ws + OFF_V);
#pragma unroll 1
  for (int ti = 0; ti < 32; ++ti) {
    const int t = t0 + 32 * w + ti, b = t >> 12;
    const float* mb = mod + b * 6144;
    float* orow = p.out + (size_t)t * 1024 + lane * 16;
    f32x2 xr[8];
#pragma unroll
    for (int q = 0; q < 4; ++q) {
      float4 a = ((const float4*)orow)[q];
      xr[2 * q] = f32x2{a.x, a.y}; xr[2 * q + 1] = f32x2{a.z, a.w};
    }
    float ss = 0.f;
#pragma unroll
    for (int i = 0; i < 8; ++i) ss += xr[i].x * xr[i].x + xr[i].y * xr[i].y;
    ss = wave_sum(ss);
    const float rinv = rsqrtf(ss * (1.f / 1024.f) + EPS);
    f32x2 hf[8];
#pragma unroll
    for (int q = 0; q < 4; ++q) {
      const int d0 = lane * 16 + 4 * q;
      float4 gg = *(const float4*)(p.in[20] + d0);
      float4 sc = *(const float4*)(mb + 4096 + d0);
      float4 sh = *(const float4*)(mb + 3072 + d0);
      hf[2 * q] = f32x2{xr[2 * q].x * rinv * gg.x * (1.f + sc.x) + sh.x, xr[2 * q].y * rinv * gg.y * (1.f + sc.y) + sh.y};
      hf[2 * q + 1] = f32x2{xr[2 * q + 1].x * rinv * gg.z * (1.f + sc.z) + sh.z, xr[2 * q + 1].y * rinv * gg.w * (1.f + sc.w) + sh.w};
    }
    const u32x4 tk = *(const u32x4*)(topk + (size_t)t * 128 + lane * 2);
    f32x2 y[8];
#pragma unroll
    for (int i = 0; i < 8; ++i) y[i] = f32x2{0.f, 0.f};
    uint2 ua[16], va[16], ub[16], vb[16];
    float gA, gB;
    auto issue = [&](int jj, uint2 (&uu)[16], uint2 (&vv)[16], float& gsel) __attribute__((always_inline)) {
      float gs = 0.f;
#pragma unroll
      for (int k = 0; k < 16; ++k) {
        const int l = 8 * jj + (k >> 1);
        const int e = __builtin_amdgcn_readlane((int)((k & 1) ? tk.z : tk.x), l);
        const float g = __uint_as_float(__builtin_amdgcn_readlane((int)((k & 1) ? tk.w : tk.y), l));
        gs = ((lane >> 2) == k) ? g : gs;
        uu[k] = *(const uint2*)(U8 + (size_t)e * 512 + lane * 8);
        vv[k] = *(const uint2*)(V8 + (size_t)e * 512 + lane * 8);
      }
      gsel = gs;
    };
    auto process = [&](const uint2 (&uu)[16], const uint2 (&vv)[16], float gsel) __attribute__((always_inline)) {
      float d[16];
#pragma unroll
      for (int k = 0; k < 16; ++k) {
        f32x2 a2 = f32x2{0.f, 0.f};
        a2 = __builtin_amdgcn_cvt_scalef32_pk_f32_fp4(uu[k].x, 1.0f, 0) * hf[0] + a2;
        a2 = __builtin_amdgcn_cvt_scalef32_pk_f32_fp4(uu[k].x, 1.0f, 1) * hf[1] + a2;
        a2 = __builtin_amdgcn_cvt_scalef32_pk_f32_fp4(uu[k].x, 1.0f, 2) * hf[2] + a2;
        a2 = __builtin_amdgcn_cvt_scalef32_pk_f32_fp4(uu[k].x, 1.0f, 3) * hf[3] + a2;
        a2 = __builtin_amdgcn_cvt_scalef32_pk_f32_fp4(uu[k].y, 1.0f, 0) * hf[4] + a2;
        a2 = __builtin_amdgcn_cvt_scalef32_pk_f32_fp4(uu[k].y, 1.0f, 1) * hf[5] + a2;
        a2 = __builtin_amdgcn_cvt_scalef32_pk_f32_fp4(uu[k].y, 1.0f, 2) * hf[6] + a2;
        a2 = __builtin_amdgcn_cvt_scalef32_pk_f32_fp4(uu[k].y, 1.0f, 3) * hf[7] + a2;
        d[k] = a2.x + a2.y;
      }
      const bool h32 = (lane & 32) != 0, h16 = (lane & 16) != 0, h8 = (lane & 8) != 0, h4 = (lane & 4) != 0;
      float r8[8], r4[4], r2[2];
#pragma unroll
      for (int i = 0; i < 8; ++i) r8[i] = (h32 ? d[8 + i] : d[i]) + __shfl_xor(h32 ? d[i] : d[8 + i], 32);
#pragma unroll
      for (int i = 0; i < 4; ++i) r4[i] = (h16 ? r8[4 + i] : r8[i]) + __shfl_xor(h16 ? r8[i] : r8[4 + i], 16);
#pragma unroll
      for (int i = 0; i < 2; ++i) r2[i] = (h8 ? r4[2 + i] : r4[i]) + __shfl_xor(h8 ? r4[i] : r4[2 + i], 8);
      float kk = (h4 ? r2[1] : r2[0]) + __shfl_xor(h4 ? r2[0] : r2[1], 4);
      kk += __shfl_xor(kk, 2); kk += __shfl_xor(kk, 1);
      const float coefv = gsel * gelu_exact(kk * (1.f / U_SCALE)) * (1.f / V_SCALE);
#pragma unroll
      for (int k = 0; k < 16; ++k) {
        const float cf = __uint_as_float(__builtin_amdgcn_readlane((int)__float_as_uint(coefv), 4 * k));
        const f32x2 cf2 = f32x2{cf, cf};
        y[0] = __builtin_amdgcn_cvt_scalef32_pk_f32_fp4(vv[k].x, 1.0f, 0) * cf2 + y[0];
        y[1] = __builtin_amdgcn_cvt_scalef32_pk_f32_fp4(vv[k].x, 1.0f, 1) * cf2 + y[1];
        y[2] = __builtin_amdgcn_cvt_scalef32_pk_f32_fp4(vv[k].x, 1.0f, 2) * cf2 + y[2];
        y[3] = __builtin_amdgcn_cvt_scalef32_pk_f32_fp4(vv[k].x, 1.0f, 3) * cf2 + y[3];
        y[4] = __builtin_amdgcn_cvt_scalef32_pk_f32_fp4(vv[k].y, 1.0f, 0) * cf2 + y[4];
        y[5] = __builtin_amdgcn_cvt_scalef32_pk_f32_fp4(vv[k].y, 1.0f, 1) * cf2 + y[5];
        y[6] = __builtin_amdgcn_cvt_scalef32_pk_f32_fp4(vv[k].y, 1.0f, 2) * cf2 + y[6];
        y[7] = __builtin_amdgcn_cvt_scalef32_pk_f32_fp4(vv[k].y, 1.0f, 3) * cf2 + y[7];
      }
    };
    issue(0, ua, va, gA);
#pragma unroll 1
    for (int jj = 0; jj < 8; jj += 2) {
      issue(jj + 1, ub, vb, gB);
      __builtin_amdgcn_sched_barrier(0);
      process(ua, va, gA);
      __builtin_amdgcn_sched_barrier(0);
      issue((jj + 2) & 7, ua, va, gA);
      __builtin_amdgcn_sched_barrier(0);
      process(ub, vb, gB);
      __builtin_amdgcn_sched_barrier(0);
    }
#pragma unroll
    for (int q = 0; q < 4; ++q) {
      float4 g2 = *(const float4*)(mb + 5120 + lane * 16 + 4 * q);
      float4 o;
      o.x = xr[2 * q].x + g2.x * y[2 * q].x; o.y = xr[2 * q].y + g2.y * y[2 * q].y;
      o.z = xr[2 * q + 1].x + g2.z * y[2 * q + 1].x; o.w = xr[2 * q + 1].y + g2.w * y[2 * q + 1].y;
      ((float4*)orow)[q] = o;
    }
  }
}

typedef const __attribute__((address_space(4))) Params* KParamsPtr;
__global__ void __launch_bounds__(512) mega(Params p_arg) {
  __shared__ __attribute__((aligned(16))) char smem[151552];
  for (int ph = p_arg.ph_begin; ph < p_arg.ph_end; ++ph) {
    KParamsPtr kp = (KParamsPtr)__builtin_amdgcn_kernarg_segment_ptr();
    asm volatile("" : "+s"(kp));
    Params p;
#pragma unroll
    for (int i = 0; i < 25; ++i) p.in[i] = kp->in[i];
    p.out = kp->out; p.ws = kp->ws; p.ph_begin = 0; p.ph_end = 0;
    const int G = lgdim();
    if (ph == 0) {
      phase0(p, smem);
    } else if (ph == 1) {
      rownorm_phase(p, p.in[0], p.in[4], 0, 1024, (u16*)(p.ws + OFF_H));
    } else if (ph == 2) {
      u16* proj = (u16*)(p.ws + OFF_PROJ);
      xcd_tiles(p.ws, 0, 9, [&](int tt, int ft2) __attribute__((always_inline)) {
        gemm_tile<1024, false>((const u16*)(p.ws + OFF_WIN), NPROJ, ft2 * 256, (const u16*)(p.ws + OFF_H), LDH,
                               (size_t)tt * 256, smem, [&](f32x16 (&acc)[4], float, int t, int h, int wf, char* wbase, int tg) __attribute__((always_inline)) {
                                 store_tile_bf16_lds(acc, wbase + tg * 8704, proj + (size_t)(t & ~31) * NPROJ + ft2 * 256 + wf * 128, NPROJ, ltid() & 63);
                               });
      });
    } else if (ph == 3) {
      phase_qkv(p, smem);
    } else if (ph == 4) {
      phase_attn(p, smem);
    } else if (ph == 5) {
      const float* mod = (const float*)(p.ws + OFF_MOD);
      xcd_tiles(p.ws, 3, 4, [&](int tt, int ft2) __attribute__((always_inline)) {
        gemm_tile<1024, false>((const u16*)(p.ws + OFF_WOUT), 1024, ft2 * 256, (const u16*)(p.ws + OFF_H), LDH,
                               (size_t)tt * 256, smem, [&](f32x16 (&acc)[4], float, int t, int h, int wf, char* wbase, int tg) __attribute__((always_inline)) {
                                 const int ft = ft2 * 2 + wf, lane = ltid() & 63, r = lane & 31;
#pragma unroll
                                 for (int c = 0; c < 4; ++c)
#pragma unroll
                                   for (int gq = 0; gq < 4; ++gq)
                                     *(float4*)(wbase + r * 528 + (32 * c + 8 * gq + 4 * h) * 4) =
                                         make_float4(acc[c][4 * gq], acc[c][4 * gq + 1], acc[c][4 * gq + 2], acc[c][4 * gq + 3]);
                                 const int tg0 = t & ~31, b = tg0 >> 12;
#pragma unroll
                                 for (int j = 0; j < 16; ++j) {
                                   const int idx = lane + 64 * j, row = idx >> 5, c16 = idx & 31;
                                   const float4 a = *(const float4*)(wbase + row * 528 + c16 * 16);
                                   const int n = ft * 128 + c16 * 4;
                                   const size_t off = (size_t)(tg0 + row) * 1024 + n;
                                   const float4 xv = *(const float4*)(p.in[0] + off);
                                   const float4 g1 = *(const float4*)(mod + b * 6144 + 2048 + n);
                                   float4 o;
                                   o.x = xv.x + g1.x * a.x; o.y = xv.y + g1.y * a.y; o.z = xv.z + g1.z * a.z; o.w = xv.w + g1.w * a.w;
                                   *(float4*)(p.out + off) = o;
                                 }
                               });
      });
    } else if (ph == 6) {
      rownorm_phase(p, p.out, p.in[20], 3072, 4096, (u16*)(p.ws + OFF_H2));
    } else if (ph == 7) {
      u16* pq = (u16*)(p.ws + OFF_PROJ);
      xcd_tiles(p.ws, 4, 8, [&](int tt, int ft2) __attribute__((always_inline)) {
        gemm_tile<1024, false>((const u16*)(p.ws + OFF_WPQ), 2048, ft2 * 256, (const u16*)(p.ws + OFF_H2), LDH,
                               (size_t)tt * 256, smem, [&](f32x16 (&acc)[4], float, int t, int h, int wf, char* wbase, int tg) __attribute__((always_inline)) {
                                 store_tile_bf16_lds(acc, wbase + tg * 8704, pq + (size_t)(t & ~31) * 2048 + ft2 * 256 + wf * 128, 2048, ltid() & 63);
                               });
      });
    } else {
      for (int tt = lbid(); tt < 256; tt += G) {
        peer_route(p, smem, tt * 256);
        __threadfence();
        __syncthreads();
        __threadfence();
        peer_gather(p, tt * 256);
      }
    }
#if COOP
    if (ph + 1 < p_arg.ph_end) cg::this_grid().sync();
#endif
  }
}

extern "C" void kernel_launch(void* const* d_in, const int* in_sizes, int n_in, void* d_out, int out_size,
                              void* d_ws, size_t ws_size, hipStream_t stream) {
  static int grid_blocks = 0;
  if (!grid_blocks) {
    int dev = 0, cus = 0, per_cu = 0;
    hipGetDevice(&dev);
    hipDeviceGetAttribute(&cus, hipDeviceAttributeMultiprocessorCount, dev);
    hipOccupancyMaxActiveBlocksPerMultiprocessor(&per_cu, mega, 512, 0);
    if (per_cu < 1) per_cu = 1;
    if (per_cu > 1) per_cu = 1;
    grid_blocks = cus * per_cu;
  }
  Params p{};
  for (int i = 0; i < 25; ++i) p.in[i] = (const float*)d_in[i];
  p.out = (float*)d_out;
  p.ws = (char*)d_ws;
#if COOP
  p.ph_begin = 0; p.ph_end = 9;
  void* args[] = {&p};
  hipError_t e = hipLaunchCooperativeKernel((void*)mega, dim3(grid_blocks), dim3(512), args, 0, stream);
  if (e != hipSuccess) fprintf(stderr, "cooperative launch failed: %s (grid %d)\n", hipGetErrorString(e), grid_blocks);
#else
  for (int ph = 0; ph < 9; ++ph) {
    p.ph_begin = ph; p.ph_end = ph + 1;
    hipLaunchKernelGGL(mega, dim3(grid_blocks), dim3(512), 0, stream, p);
  }
#endif
}
```

```cpp
#include <hip/hip_runtime.h>
#include <hip/hip_cooperative_groups.h>
#include <cstdio>
namespace cg = cooperative_groups;

typedef unsigned short u16;
typedef short bf16x8 __attribute__((ext_vector_type(8)));
typedef short s16x4 __attribute__((ext_vector_type(4)));
typedef float f32x16 __attribute__((ext_vector_type(16)));
typedef __bf16 bf2_t __attribute__((ext_vector_type(2)));
typedef unsigned u32x4 __attribute__((ext_vector_type(4)));
#define DI __device__ __forceinline__
#define LDSP(T, p) ((__attribute__((address_space(3))) T*)(p))
#define MFMA(a, b, c) __builtin_amdgcn_mfma_f32_32x32x16_bf16((a), (b), (c), 0, 0, 0)

#ifndef COOP
#define COOP 1
#endif

constexpr int S_ = 4096, T_ = 65536, NPROJ = 2304;
constexpr int LDH = 1088;
constexpr float EPS = 1e-6f;
constexpr float LOG2E = 1.4426950408889634f;
constexpr float NEG_INF = -__builtin_inff();
constexpr float U_SCALE = 64.f, V_SCALE = 5.656854f;
typedef float f32x2 __attribute__((ext_vector_type(2)));

constexpr size_t OFF_MOD = 0;
constexpr size_t OFF_LAM = 393216;
constexpr size_t OFF_CNT = 397312;
constexpr size_t OFF_ROPE = 524288;
constexpr size_t OFF_WIN = 1572864;
constexpr size_t OFF_WQ = 6291456;
constexpr size_t OFF_WKV = 6881280;
constexpr size_t OFF_WOUT = 7405568;
constexpr size_t OFF_WPQ = 9502720;
constexpr size_t OFF_SK = 13697024;
constexpr size_t OFF_U = 16777216;
constexpr size_t OFF_V = 50331648;
constexpr size_t OFF_H = 83886080;
constexpr size_t OFF_PROJ = 226492416;
constexpr size_t OFF_QM = 528482304;
constexpr size_t OFF_KM = 629145600;
constexpr size_t OFF_VM = 729808896;
constexpr size_t OFF_QD = 796917760;
constexpr size_t OFF_KD = 864026624;
constexpr size_t OFF_H2 = OFF_QM;
constexpr size_t OFF_TOPK = OFF_VM;

struct Params {
  const float* in[25];
  float* out;
  char* ws;
  int ph_begin, ph_end;
};

DI unsigned pk2(float a, float b) {
  bf2_t r; r[0] = (__bf16)a; r[1] = (__bf16)b; return __builtin_bit_cast(unsigned, r);
}
DI float bflo(unsigned u) { return __uint_as_float(u << 16); }
DI float bfhi(unsigned u) { return __uint_as_float(u & 0xffff0000u); }
DI float dot2bf(unsigned a, unsigned b, float c) {
  return __builtin_amdgcn_fdot2_f32_bf16(__builtin_bit_cast(bf2_t, a), __builtin_bit_cast(bf2_t, b), c, false);
}
DI float wave_sum(float v) {
#pragma unroll
  for (int o = 32; o; o >>= 1) v += __shfl_xor(v, o);
  return v;
}
DI int lbid() { int t = blockIdx.x; asm volatile("" : "+s"(t)); return t; }
DI int lgdim() { int t = gridDim.x; asm volatile("" : "+s"(t)); return t; }
DI int ltid() { int t = threadIdx.x; asm volatile("" : "+v"(t)); return t; }
DI s16x4 trread(const char* p) { return __builtin_amdgcn_ds_read_tr16_b64_v4i16(LDSP(s16x4, p)); }
DI unsigned xcc_id() { return (unsigned)__builtin_amdgcn_s_getreg((3 << 11) | 20) & 0x7u; }
template <class F>
DI void xcd_tiles(char* ws, int set, int nft, F body) {
  __shared__ int sh_item;
  unsigned* cnt = (unsigned*)(ws + OFF_CNT);
  const int x0 = (int)xcc_id();
  const int per = 32 * nft;
  for (int q = 0; q < 8; ++q) {
    const int x = (x0 + q) & 7;
    for (;;) {
      __syncthreads();
      if (threadIdx.x == 0) sh_item = (int)atomicAdd(cnt + (set * 8 + x) * 32, 1u);
      __syncthreads();
      const int it = sh_item;
      if (it >= per) break;
      body(32 * x + it / nft, it % nft);
    }
  }
}

constexpr int G_ARS = 576;
constexpr int G_ASZ = 64 * G_ARS, G_BSZ = 256 * 144, G_STAGE = G_ASZ + G_BSZ;

template <int K, bool SUMSQ, class Epi>
DI void gemm_tile(const u16* __restrict__ W, int ldw, int n0, const u16* __restrict__ X, int ldx, size_t t0,
                  char* smem, Epi epi) {
  constexpr int KT = K / 64;
  const int tid = ltid(), lane = tid & 63, w = tid >> 6, h = lane >> 5, r = lane & 31;
  const int wf = w & 1, wt = w >> 1;
  const int blk = (lane >> 4) & 1, q4 = (lane & 15) >> 2, p4 = lane & 3;
  u32x4 ra[4], rb[4];
  const unsigned aoff = (unsigned)((tid >> 5) * ldw + (tid & 31) * 8), boff = (unsigned)((tid >> 3) * ldx + (tid & 7) * 8);
  const unsigned asoff = (unsigned)((tid >> 5) * G_ARS + (tid & 31) * 16), bsoff = (unsigned)(G_ASZ + (tid >> 3) * 144 + (tid & 7) * 16);
  auto gload = [&](int kt) __attribute__((always_inline)) {
    const u16* wk = W + (size_t)kt * 64 * ldw + n0;
    const u16* xk = X + t0 * (size_t)ldx + kt * 64;
#pragma unroll
    for (int i = 0; i < 4; ++i) ra[i] = *(const u32x4*)(wk + (size_t)i * 16 * ldw + aoff);
#pragma unroll
    for (int i = 0; i < 4; ++i) rb[i] = *(const u32x4*)(xk + (size_t)i * 64 * ldx + boff);
  };
  auto sstore = [&](char* buf) __attribute__((always_inline)) {
#pragma unroll
    for (int i = 0; i < 4; ++i) *(u32x4*)(buf + asoff + i * 16 * G_ARS) = ra[i];
#pragma unroll
    for (int i = 0; i < 4; ++i) *(u32x4*)(buf + bsoff + i * 64 * 144) = rb[i];
  };
  f32x16 acc[2][4];
#pragma unroll
  for (int g = 0; g < 2; ++g)
#pragma unroll
    for (int c = 0; c < 4; ++c)
#pragma unroll
      for (int i = 0; i < 16; ++i) acc[g][c][i] = 0.f;
  float ss0 = 0.f, ss1 = 0.f;
  auto compute = [&](const char* buf) __attribute__((always_inline)) {
    u32x4 bfr[2][2];
    s16x4 alo[2][4], ahi[2][4];
    auto lfrag = [&](int s, int slot) __attribute__((always_inline)) {
      bfr[slot][0] = *(const u32x4*)(buf + G_ASZ + (64 * wt + r) * 144 + (16 * s + 8 * h) * 2);
      bfr[slot][1] = *(const u32x4*)(buf + G_ASZ + (64 * wt + 32 + r) * 144 + (16 * s + 8 * h) * 2);
#pragma unroll
      for (int c = 0; c < 4; ++c) {
        const char* ap = buf + (16 * s + 8 * h + q4) * G_ARS + (128 * wf + 32 * c + 16 * blk) * 2 + 8 * p4;
        alo[slot][c] = trread(ap); ahi[slot][c] = trread(ap + 4 * G_ARS);
      }
    };
    lfrag(0, 0);
#pragma unroll
    for (int s = 0; s < 4; ++s) {
      if (s < 3) lfrag(s + 1, (s + 1) & 1);
      __builtin_amdgcn_sched_barrier(0);
      const u32x4 b0r = bfr[s & 1][0], b1r = bfr[s & 1][1];
      if (SUMSQ) {
        ss0 = dot2bf(b0r.x, b0r.x, ss0); ss0 = dot2bf(b0r.y, b0r.y, ss0);
        ss0 = dot2bf(b0r.z, b0r.z, ss0); ss0 = dot2bf(b0r.w, b0r.w, ss0);
        ss1 = dot2bf(b1r.x, b1r.x, ss1); ss1 = dot2bf(b1r.y, b1r.y, ss1);
        ss1 = dot2bf(b1r.z, b1r.z, ss1); ss1 = dot2bf(b1r.w, b1r.w, ss1);
      }
      const bf16x8 b0 = __builtin_bit_cast(bf16x8, b0r), b1 = __builtin_bit_cast(bf16x8, b1r);
#pragma unroll
      for (int c = 0; c < 4; ++c) {
        const bf16x8 a = __builtin_shufflevector(alo[s & 1][c], ahi[s & 1][c], 0, 1, 2, 3, 4, 5, 6, 7);
        acc[0][c] = MFMA(a, b0, acc[0][c]);
        acc[1][c] = MFMA(a, b1, acc[1][c]);
      }
      __builtin_amdgcn_sched_barrier(0);
    }
  };
  gload(0);
  sstore(smem);
  if (KT > 1) gload(1);
  __syncthreads();
  for (int kt = 0; kt < KT; ++kt) {
    char* buf = smem + (kt & 1) * G_STAGE;
    if (kt + 1 < KT) {
      sstore(smem + ((kt + 1) & 1) * G_STAGE);
      if (kt + 2 < KT) gload(kt + 2);
    }
    __builtin_amdgcn_sched_barrier(0);
    compute(buf);
    __syncthreads();
  }
  if (SUMSQ) { ss0 += __shfl_xor(ss0, 32); ss1 += __shfl_xor(ss1, 32); }
  epi(acc[0], ss0, (int)t0 + 64 * wt + r, h, wf, smem + w * 17408, 0);
  epi(acc[1], ss1, (int)t0 + 64 * wt + 32 + r, h, wf, smem + w * 17408, 1);
}

DI void phase0(const Params& p, char* smem) {
  const int tid = ltid(), G = lgdim(), g = lbid();
  const size_t gt = (size_t)g * 512 + tid, NT = (size_t)G * 512;
  float* mod = (float*)(p.ws + OFF_MOD);
  for (int item = g; item < 96; item += G) {
    float* sc = (float*)smem;
    float* red = sc + 16384;
    for (int i = tid; i < 16384; i += 512) { float v = p.in[1][i]; sc[i] = v / (1.f + expf(-v)); }
    __syncthreads();
    const int col = tid & 63, kg = tid >> 6, n = item * 64 + col;
    float acc[16];
#pragma unroll
    for (int b = 0; b < 16; ++b) acc[b] = 0.f;
    const float* aw = p.in[2] + (size_t)(kg * 128) * 6144 + n;
#pragma unroll 4
    for (int k = 0; k < 128; ++k) {
      float wv = aw[(size_t)k * 6144];
#pragma unroll
      for (int b = 0; b < 16; ++b) acc[b] += sc[b * 1024 + kg * 128 + k] * wv;
    }
#pragma unroll
    for (int b = 0; b < 16; ++b) red[(kg * 16 + b) * 64 + col] = acc[b];
    __syncthreads();
    for (int o = tid; o < 1024; o += 512) {
      int b = o >> 6, cc = o & 63;
      float s = 0.f;
#pragma unroll
      for (int k2 = 0; k2 < 8; ++k2) s += red[(k2 * 16 + b) * 64 + cc];
      mod[b * 6144 + item * 64 + cc] = s + p.in[3][item * 64 + cc];
    }
    __syncthreads();
  }
  if (g == 0) {
    unsigned* cnt = (unsigned*)(p.ws + OFF_CNT);
    for (int i = tid; i < 8 * 8 * 32; i += 512) cnt[i] = 0u;
  }
  if (g == 0 && tid < 64) {
    float d1 = wave_sum(p.in[14][tid] * p.in[15][tid]);
    float d2 = wave_sum(p.in[16][tid] * p.in[17][tid]);
    if (tid == 0) *(float*)(p.ws + OFF_LAM) = expf(d1) - expf(d2) + 0.2f;
  }
  {
    float2* rope = (float2*)(p.ws + OFF_ROPE);
    for (size_t i = gt; i < 131072; i += NT) {
      int j = (int)(i & 31), sp = (int)(i >> 5);
      float inv = 1.0f / powf(10000.f, (float)j / 32.f);
      float ang = (float)sp * inv, sn, cs;
      sincosf(ang, &sn, &cs);
      rope[i] = make_float2(cs, sn);
    }
  }
  {
    u16* d = (u16*)(p.ws + OFF_WIN);
    for (size_t i = gt; i < (size_t)1024 * 2304; i += NT) {
      int k = (int)(i / 2304), n = (int)(i % 2304);
      float v = (n < 2240) ? p.in[5][(size_t)k * 2240 + n] : 0.f;
      d[i] = (u16)(pk2(v, 0.f) & 0xffff);
    }
  }
  {
    u16* d = (u16*)(p.ws + OFF_WQ);
    for (size_t i = gt; i < (size_t)384 * 768; i += NT) {
      int k = (int)(i / 768), n = (int)(i % 768);
      int src = (n < 512) ? (n >> 7) * 192 + (n & 127) : ((n - 512) >> 6) * 192 + 128 + ((n - 512) & 63);
      float v = p.in[7][(size_t)k * 768 + src] * p.in[6][k];
      d[i] = (u16)(pk2(v, 0.f) & 0xffff);
    }
  }
  {
    u16* d = (u16*)(p.ws + OFF_WKV);
    for (size_t i = gt; i < (size_t)256 * 1024; i += NT) {
      int k = (int)(i >> 10), n = (int)(i & 1023);
      int src = (n < 512) ? (n >> 7) * 256 + (n & 127) : ((n - 512) >> 7) * 256 + 128 + (n & 127);
      float v = p.in[9][(size_t)k * 1024 + src] * p.in[8][k];
      d[i] = (u16)(pk2(v, 0.f) & 0xffff);
    }
  }
  auto conv8 = [&](const float* src, u16* dst, size_t n8) __attribute__((always_inline)) {
    for (size_t i = gt; i < n8; i += NT) {
      float4 a = ((const float4*)src)[2 * i], b = ((const float4*)src)[2 * i + 1];
      uint4 o; o.x = pk2(a.x, a.y); o.y = pk2(a.z, a.w); o.z = pk2(b.x, b.y); o.w = pk2(b.z, b.w);
      ((uint4*)dst)[i] = o;
    }
  };
  conv8(p.in[19], (u16*)(p.ws + OFF_WOUT), (size_t)1024 * 1024 / 8);
  conv8(p.in[21], (u16*)(p.ws + OFF_WPQ), (size_t)1024 * 2048 / 8);
  conv8(p.in[22], (u16*)(p.ws + OFF_SK), (size_t)16 * 128 * 128 / 8);
}

DI void rownorm_phase(const Params& p, const float* src, const float* gain, int sh_off, int sc_off, u16* dst) {
  const int lane = ltid() & 63;
  const int gw = lbid() * 8 + (ltid() >> 6), NW = lgdim() * 8;
  const float* mod = (const float*)(p.ws + OFF_MOD);
  for (int t = gw; t < T_; t += NW) {
    const int b = t >> 12;
    const float* mb = mod + b * 6144;
#pragma unroll
    for (int c = 0; c < 2; ++c) {
    }
    float xv[16];
#pragma unroll
    for (int c = 0; c < 2; ++c) {
      const float4* sp = (const float4*)(src + (size_t)t * 1024 + c * 512 + lane * 8);
      float4 a = sp[0], bq = sp[1];
      xv[c * 8 + 0] = a.x; xv[c * 8 + 1] = a.y; xv[c * 8 + 2] = a.z; xv[c * 8 + 3] = a.w;
      xv[c * 8 + 4] = bq.x; xv[c * 8 + 5] = bq.y; xv[c * 8 + 6] = bq.z; xv[c * 8 + 7] = bq.w;
    }
    float ss = 0.f;
#pragma unroll
    for (int i = 0; i < 16; ++i) ss += xv[i] * xv[i];
    ss = wave_sum(ss);
    const float rinv = rsqrtf(ss * (1.f / 1024.f) + EPS);
#pragma unroll
    for (int c = 0; c < 2; ++c) {
      const int d0 = c * 512 + lane * 8;
      float o[8];
#pragma unroll
      for (int q = 0; q < 2; ++q) {
        float4 gg = *(const float4*)(gain + d0 + 4 * q);
        float4 sc = *(const float4*)(mb + sc_off + d0 + 4 * q);
        float4 sh = *(const float4*)(mb + sh_off + d0 + 4 * q);
        o[4 * q + 0] = xv[c * 8 + 4 * q + 0] * rinv * gg.x * (1.f + sc.x) + sh.x;
        o[4 * q + 1] = xv[c * 8 + 4 * q + 1] * rinv * gg.y * (1.f + sc.y) + sh.y;
        o[4 * q + 2] = xv[c * 8 + 4 * q + 2] * rinv * gg.z * (1.f + sc.z) + sh.z;
        o[4 * q + 3] = xv[c * 8 + 4 * q + 3] * rinv * gg.w * (1.f + sc.w) + sh.w;
      }
      uint4 ov; ov.x = pk2(o[0], o[1]); ov.y = pk2(o[2], o[3]); ov.z = pk2(o[4], o[5]); ov.w = pk2(o[6], o[7]);
      *(uint4*)(dst + (size_t)t * LDH + d0) = ov;
    }
  }
}

DI void store_tile_bf16_lds(f32x16 (&acc)[4], char* wsm, u16* dst0, size_t ld, int lane) {
  const int h = lane >> 5, r = lane & 31;
#pragma unroll
  for (int c = 0; c < 4; ++c)
#pragma unroll
    for (int gq = 0; gq < 4; ++gq) {
      uint2 v; v.x = pk2(acc[c][4 * gq], acc[c][4 * gq + 1]); v.y = pk2(acc[c][4 * gq + 2], acc[c][4 * gq + 3]);
      *(uint2*)(wsm + r * 272 + (32 * c + 8 * gq + 4 * h) * 2) = v;
    }
#pragma unroll
  for (int j = 0; j < 8; ++j) {
    const int idx = lane + 64 * j, row = idx >> 4, c16 = idx & 15;
    const u32x4 v = *(const u32x4*)(wsm + row * 272 + c16 * 16);
    *(u32x4*)(dst0 + (size_t)row * ld + c16 * 8) = v;
  }
}

template <class AddrFn>
DI void store_rows_bf16_lds(f32x16 (&acc)[4], char* wsm, int lane, AddrFn addr) {
  const int h = lane >> 5, r = lane & 31;
#pragma unroll
  for (int c = 0; c < 4; ++c)
#pragma unroll
    for (int gq = 0; gq < 4; ++gq) {
      uint2 v; v.x = pk2(acc[c][4 * gq], acc[c][4 * gq + 1]); v.y = pk2(acc[c][4 * gq + 2], acc[c][4 * gq + 3]);
      *(uint2*)(wsm + r * 272 + (32 * c + 8 * gq + 4 * h) * 2) = v;
    }
#pragma unroll
  for (int j = 0; j < 8; ++j) {
    const int idx = lane + 64 * j, row = idx >> 4, c16 = idx & 15;
    const u32x4 v = *(const u32x4*)(wsm + row * 272 + c16 * 16);
    *(u32x4*)addr(row, c16) = v;
  }
}

DI void phase_qkv(const Params& p, char* smem) {
  const int G = lgdim();
  const u16* proj = (const u16*)(p.ws + OFF_PROJ);
  const float2* rope = (const float2*)(p.ws + OFF_ROPE);
  u16* Qm = (u16*)(p.ws + OFF_QM); u16* Km = (u16*)(p.ws + OFF_KM); u16* Vm = (u16*)(p.ws + OFF_VM);
  u16* Qd = (u16*)(p.ws + OFF_QD); u16* Kd = (u16*)(p.ws + OFF_KD);
  const float QS = 0.07216878364870322f * LOG2E;
  xcd_tiles(p.ws, 1, 3, [&](int tt, int ft2) __attribute__((always_inline)) {
    const float* qg = p.in[10];
    gemm_tile<384, true>((const u16*)(p.ws + OFF_WQ), 768, ft2 * 256, proj, NPROJ, (size_t)tt * 256, smem,
      [&](f32x16 (&acc)[4], float ss, int t, int h, int wf, char* wbase, int tg) __attribute__((always_inline)) {
        const int ft = ft2 * 2 + wf;
        const float rinv = rsqrtf(ss * (1.f / 384.f) + EPS);
        const int lane = ltid() & 63, tg0 = t & ~31, b = tg0 >> 12, s0 = tg0 & 4095, s = t & 4095;
        char* wsm = wbase + tg * 8704;
        if (ft < 4) {
          float s2 = 0.f;
#pragma unroll
          for (int c = 0; c < 4; ++c)
#pragma unroll
            for (int k = 0; k < 16; ++k) { float v = acc[c][k] * rinv; s2 += v * v; }
          s2 += __shfl_xor(s2, 32);
          const float r2 = rsqrtf(s2 * (1.f / 128.f) + EPS) * rinv * QS;
#pragma unroll
          for (int c = 0; c < 4; ++c)
#pragma unroll
            for (int gq = 0; gq < 4; ++gq) {
              const int d = 32 * c + 8 * gq + 4 * h;
              float4 gg = *(const float4*)(qg + d);
              acc[c][4 * gq] *= r2 * gg.x; acc[c][4 * gq + 1] *= r2 * gg.y;
              acc[c][4 * gq + 2] *= r2 * gg.z; acc[c][4 * gq + 3] *= r2 * gg.w;
            }
          u16* base = Qm + ((size_t)(b * 4 + ft) * S_ + s0) * 192;
          store_rows_bf16_lds(acc, wsm, lane, [&](int row, int c16) __attribute__((always_inline)) { return base + (size_t)row * 192 + c16 * 8; });
        } else {
#pragma unroll
          for (int cp = 0; cp < 2; ++cp) {
            float s2 = 0.f;
#pragma unroll
            for (int k = 0; k < 16; ++k) {
              float v1 = acc[2 * cp][k] * rinv, v2 = acc[2 * cp + 1][k] * rinv;
              s2 += v1 * v1 + v2 * v2;
            }
            s2 += __shfl_xor(s2, 32);
            const float r2 = rsqrtf(s2 * (1.f / 64.f) + EPS) * rinv;
#pragma unroll
            for (int gq = 0; gq < 4; ++gq) {
              const int j = 8 * gq + 4 * h;
              float4 g1 = *(const float4*)(qg + 128 + j), g2 = *(const float4*)(qg + 160 + j);
              const float4* rp = (const float4*)(rope + s * 32 + j);
              float4 cs01 = rp[0], cs23 = rp[1];
              float x1, x2;
              x1 = acc[2 * cp][4 * gq + 0] * r2 * g1.x; x2 = acc[2 * cp + 1][4 * gq + 0] * r2 * g2.x;
              acc[2 * cp][4 * gq + 0] = (x1 * cs01.x - x2 * cs01.y) * QS; acc[2 * cp + 1][4 * gq + 0] = (x2 * cs01.x + x1 * cs01.y) * QS;
              x1 = acc[2 * cp][4 * gq + 1] * r2 * g1.y; x2 = acc[2 * cp + 1][4 * gq + 1] * r2 * g2.y;
              acc[2 * cp][4 * gq + 1] = (x1 * cs01.z - x2 * cs01.w) * QS; acc[2 * cp + 1][4 * gq + 1] = (x2 * cs01.z + x1 * cs01.w) * QS;
              x1 = acc[2 * cp][4 * gq + 2] * r2 * g1.z; x2 = acc[2 * cp + 1][4 * gq + 2] * r2 * g2.z;
              acc[2 * cp][4 * gq + 2] = (x1 * cs23.x - x2 * cs23.y) * QS; acc[2 * cp + 1][4 * gq + 2] = (x2 * cs23.x + x1 * cs23.y) * QS;
              x1 = acc[2 * cp][4 * gq + 3] * r2 * g1.w; x2 = acc[2 * cp + 1][4 * gq + 3] * r2 * g2.w;
              acc[2 * cp][4 * gq + 3] = (x1 * cs23.z - x2 * cs23.w) * QS; acc[2 * cp + 1][4 * gq + 3] = (x2 * cs23.z + x1 * cs23.w) * QS;
            }
          }
          u16* base = Qm + ((size_t)(b * 4 + (ft - 4) * 2) * S_ + s0) * 192 + 128;
          store_rows_bf16_lds(acc, wsm, lane, [&](int row, int c16) __attribute__((always_inline)) {
            return base + (size_t)(c16 >> 3) * S_ * 192 + (size_t)row * 192 + (c16 & 7) * 8; });
        }
      });
  });
  xcd_tiles(p.ws, 2, 4, [&](int tt, int ft2) __attribute__((always_inline)) {
    const float* kg = p.in[11];
    gemm_tile<256, true>((const u16*)(p.ws + OFF_WKV), 1024, ft2 * 256, proj + 384, NPROJ, (size_t)tt * 256, smem,
      [&](f32x16 (&acc)[4], float ss, int t, int h, int wf, char* wbase, int tg) __attribute__((always_inline)) {
        const int ft = ft2 * 2 + wf;
        const float rinv = rsqrtf(ss * (1.f / 256.f) + EPS);
        const int lane = ltid() & 63, tg0 = t & ~31, b = tg0 >> 12, s0 = tg0 & 4095;
        char* wsm = wbase + tg * 8704;
        if (ft < 4) {
          float s2 = 0.f;
#pragma unroll
          for (int c = 0; c < 4; ++c)
#pragma unroll
            for (int k = 0; k < 16; ++k) { float v = acc[c][k] * rinv; s2 += v * v; }
          s2 += __shfl_xor(s2, 32);
          const float r2 = rsqrtf(s2 * (1.f / 128.f) + EPS) * rinv;
#pragma unroll
          for (int c = 0; c < 4; ++c)
#pragma unroll
            for (int gq = 0; gq < 4; ++gq) {
              const int d = 32 * c + 8 * gq + 4 * h;
              float4 gg = *(const float4*)(kg + d);
              acc[c][4 * gq] *= r2 * gg.x; acc[c][4 * gq + 1] *= r2 * gg.y;
              acc[c][4 * gq + 2] *= r2 * gg.z; acc[c][4 * gq + 3] *= r2 * gg.w;
            }
          u16* base = Km + ((size_t)(b * 4 + ft) * S_ + s0) * 192;
          store_rows_bf16_lds(acc, wsm, lane, [&](int row, int c16) __attribute__((always_inline)) { return base + (size_t)row * 192 + c16 * 8; });
        } else {
#pragma unroll
          for (int c = 0; c < 4; ++c)
#pragma unroll
            for (int k = 0; k < 16; ++k) acc[c][k] *= rinv;
          u16* base = Vm + ((size_t)(b * 4 + (ft - 4)) * S_ + s0) * 128;
          store_rows_bf16_lds(acc, wsm, lane, [&](int row, int c16) __attribute__((always_inline)) { return base + (size_t)row * 128 + c16 * 8; });
        }
      });
  });
  {
    const size_t gt = (size_t)lbid() * 512 + ltid(), NT = (size_t)G * 512;
    for (size_t e = gt; e < (size_t)T_ * 17; e += NT) {
      const int t = (int)(e / 17), gi = (int)(e % 17);
      const int b = t >> 12, s = t & 4095;
      const u16* src; const float* gain; float scale; u16* dst; int ncopy = 1; size_t cstride = 0;
      if (gi == 0) {
        src = proj + (size_t)t * NPROJ + 640; gain = p.in[11] + 128; scale = 1.f;
        dst = Km + ((size_t)(b * 4) * S_ + s) * 192 + 128; ncopy = 4; cstride = (size_t)S_ * 192;
      } else if (gi < 9) {
        const int j = gi - 1;
        src = proj + (size_t)t * NPROJ + 704 + j * 64; gain = p.in[12]; scale = 0.125f * LOG2E;
        dst = Qd + ((size_t)(b * 8 + j) * S_ + s) * 64;
      } else {
        const int j = gi - 9;
        src = proj + (size_t)t * NPROJ + 1216 + j * 64; gain = p.in[13]; scale = 1.f;
        dst = Kd + ((size_t)(b * 8 + j) * S_ + s) * 64;
      }
      uint4 raw[8];
#pragma unroll
      for (int q = 0; q < 8; ++q) raw[q] = ((const uint4*)src)[q];
      float ss = 0.f;
#pragma unroll
      for (int q = 0; q < 8; ++q) {
        ss = dot2bf(raw[q].x, raw[q].x, ss); ss = dot2bf(raw[q].y, raw[q].y, ss);
        ss = dot2bf(raw[q].z, raw[q].z, ss); ss = dot2bf(raw[q].w, raw[q].w, ss);
      }
      const float rinv = rsqrtf(ss * (1.f / 64.f) + EPS);
      const float rs = rinv * scale;
#pragma unroll
      for (int q = 0; q < 4; ++q) {
        const unsigned lo[4] = {raw[q].x, raw[q].y, raw[q].z, raw[q].w};
        const unsigned hi[4] = {raw[q + 4].x, raw[q + 4].y, raw[q + 4].z, raw[q + 4].w};
        unsigned o1[4], o2[4];
#pragma unroll
        for (int e2 = 0; e2 < 4; ++e2) {
          const int k = 8 * q + 2 * e2;
          const float4 cs = *(const float4*)(rope + s * 32 + k);
          const float2 ga = *(const float2*)(gain + k), gb = *(const float2*)(gain + 32 + k);
          float x1a = bflo(lo[e2]) * rs * ga.x, x2a = bflo(hi[e2]) * rs * gb.x;
          float x1b = bfhi(lo[e2]) * rs * ga.y, x2b = bfhi(hi[e2]) * rs * gb.y;
          o1[e2] = pk2(x1a * cs.x - x2a * cs.y, x1b * cs.z - x2b * cs.w);
          o2[e2] = pk2(x2a * cs.x + x1a * cs.y, x2b * cs.z + x1b * cs.w);
        }
        uint4 v1 = make_uint4(o1[0], o1[1], o1[2], o1[3]), v2 = make_uint4(o2[0], o2[1], o2[2], o2[3]);
        for (int cpy = 0; cpy < ncopy; ++cpy) {
          ((uint4*)(dst + cpy * cstride))[q] = v1;
          ((uint4*)(dst + cpy * cstride))[q + 4] = v2;
        }
      }
    }
  }
}

template <int NS, int RSK, bool QLDS>
DI void qk_softmax32(const char* kbuf, const bf16x8 (&qf)[NS], const char* qlds, bool needmask, int keybase, int qrow, int h, int r,
                     float& mrun, float& lrun, f32x16 (&O)[4], bf16x8& pf0, bf16x8& pf1) {
  f32x16 sacc;
#pragma unroll
  for (int i = 0; i < 16; ++i) sacc[i] = 0.f;
#pragma unroll
  for (int s = 0; s < NS; ++s) {
    bf16x8 a = *(const bf16x8*)(kbuf + r * RSK + (16 * s + 8 * h) * 2);
    bf16x8 bq;
    if (QLDS) bq = *(const bf16x8*)(qlds + (16 * s + 8 * h) * 2); else bq = qf[s];
    sacc = MFMA(a, bq, sacc);
  }
  if (needmask) {
#pragma unroll
    for (int i = 0; i < 16; ++i) {
      const int key = keybase + 8 * (i >> 2) + 4 * h + (i & 3);
      if (key > qrow) sacc[i] = NEG_INF;
    }
  }
  float mx = sacc[0];
#pragma unroll
  for (int i = 1; i < 16; ++i) mx = fmaxf(mx, sacc[i]);
  mx = fmaxf(mx, __shfl_xor(mx, 32));
  if (__builtin_amdgcn_ballot_w64(mx > mrun + 8.f) != 0ull) {
    const float mnew = fmaxf(mrun, mx);
    const float alpha = __builtin_amdgcn_exp2f(mrun - mnew);
    mrun = mnew;
    lrun *= alpha;
#pragma unroll
    for (int c = 0; c < 4; ++c)
#pragma unroll
      for (int i = 0; i < 16; ++i) O[c][i] *= alpha;
  }
  float rs = 0.f;
#pragma unroll
  for (int i = 0; i < 16; ++i) {
    float pv = __builtin_amdgcn_exp2f(sacc[i] - mrun);
    rs += pv; sacc[i] = pv;
  }
  lrun += rs;
  uint4 pa, pb;
  pa.x = pk2(sacc[0], sacc[1]); pa.y = pk2(sacc[2], sacc[3]); pa.z = pk2(sacc[4], sacc[5]); pa.w = pk2(sacc[6], sacc[7]);
  pb.x = pk2(sacc[8], sacc[9]); pb.y = pk2(sacc[10], sacc[11]); pb.z = pk2(sacc[12], sacc[13]); pb.w = pk2(sacc[14], sacc[15]);
  pf0 = __builtin_bit_cast(bf16x8, pa);
  pf1 = __builtin_bit_cast(bf16x8, pb);
}

template <int DQK, int NMAP>
DI void attn_item(const u16* __restrict__ qb0, const u16* __restrict__ qb1, const u16* __restrict__ kb0,
                  const u16* __restrict__ kb1, const u16* __restrict__ vb, int vstride, int qblk,
                  u16* __restrict__ outp, const float* __restrict__ lamp, const float* __restrict__ subg, char* smem) {
  constexpr int NS = DQK / 16;
  constexpr int RSK = DQK * 2 + 16;
  constexpr int KTILE = 64 * RSK;
  constexpr int VOFF = NMAP * KTILE;
  constexpr int STAGE = VOFF + 64 * 320;
  constexpr int CPR = DQK / 8;
  constexpr int KCH = NMAP * 64 * CPR / 512;
  int tid_ = ltid();
  asm volatile("" : "+v"(tid_));
  const int tid = tid_, lane = tid & 63, w = tid >> 6, h = lane >> 5, r = lane & 31;
  const int blk = (lane >> 4) & 1, q4 = (lane & 15) >> 2, p4 = lane & 3;
  const int q0 = qblk * 256, wrow0 = q0 + 32 * w, qrow = wrow0 + r;
  const int nt = 4 * (qblk + 1);

  constexpr bool QL = (NMAP == 2);
  bf16x8 qfa[NS];
  if (!QL) {
#pragma unroll
    for (int s = 0; s < NS; ++s) qfa[s] = *(const bf16x8*)(qb0 + (size_t)qrow * DQK + 16 * s + 8 * h);
  } else {
#pragma unroll
    for (int s = 0; s < NS; ++s) qfa[s] = bf16x8{0, 0, 0, 0, 0, 0, 0, 0};
#pragma unroll
    for (int i = 0; i < 8; ++i) {
      const int id = tid + 512 * i, mp = id >> 11, rem = id & 2047, row = rem >> 3, c16 = rem & 7;
      *(u32x4*)(smem + 2 * STAGE + mp * 36864 + row * 144 + c16 * 16) =
          *(const u32x4*)((mp ? qb1 : qb0) + (size_t)(q0 + row) * DQK + c16 * 8);
    }
  }
  const char* qla = smem + 2 * STAGE + (32 * w + r) * 144;
  const char* qlb = qla + 36864;
  f32x16 Oa[4], Ob[4];
  float ma = NEG_INF, la = 0.f, mb = NEG_INF, lb = 0.f;
#pragma unroll
  for (int c = 0; c < 4; ++c)
#pragma unroll
    for (int i = 0; i < 16; ++i) { Oa[c][i] = 0.f; if (NMAP == 2) Ob[c][i] = 0.f; }

  u32x4 rk[KCH], rv[2];
  unsigned koff[KCH], voff[2];
#pragma unroll
  for (int i = 0; i < KCH; ++i) {
    const int id = tid + 512 * i;
    if (NMAP == 1) koff[i] = (unsigned)((id / CPR) * DQK + (id % CPR) * 8);
    else koff[i] = (unsigned)((((id & 511) >> 3)) * DQK + (id & 7) * 8);
  }
#pragma unroll
  for (int i = 0; i < 2; ++i) {
    const int id = tid + 512 * i;
    voff[i] = (unsigned)((id >> 4) * vstride + (id & 15) * 8);
  }
  auto gload = [&](int t) __attribute__((always_inline)) {
    const u16* k0t = kb0 + (size_t)t * 64 * DQK;
    const u16* k1t = (NMAP == 2) ? kb1 + (size_t)t * 64 * DQK : k0t;
    const u16* vt = vb + (size_t)t * 64 * vstride;
#pragma unroll
    for (int i = 0; i < KCH; ++i) rk[i] = *(const u32x4*)(((NMAP == 2 && i) ? k1t : k0t) + koff[i]);
#pragma unroll
    for (int i = 0; i < 2; ++i) rv[i] = *(const u32x4*)(vt + voff[i]);
  };
  auto sstore = [&](char* buf) __attribute__((always_inline)) {
#pragma unroll
    for (int i = 0; i < KCH; ++i) {
      const int id = tid + 512 * i;
      if (NMAP == 1) {
        const int row = id / CPR, c16 = id % CPR;
        *(u32x4*)(buf + row * RSK + c16 * 16) = rk[i];
      } else {
        const int rem = id & 511, row = rem >> 3, c16 = rem & 7;
        *(u32x4*)(buf + i * KTILE + row * RSK + c16 * 16) = rk[i];
      }
    }
#pragma unroll
    for (int i = 0; i < 2; ++i) {
      const int id = tid + 512 * i, row = id >> 4, c16 = id & 15;
      *(u32x4*)(buf + VOFF + row * 320 + c16 * 16) = rv[i];
    }
  };

  gload(0);
  sstore(smem);
  __syncthreads();
  for (int t = 0; t < nt; ++t) {
    char* buf = smem + (t & 1) * STAGE;
    if (t + 1 < nt) gload(t + 1);
    const int key0 = t * 64;
#pragma unroll
    for (int sub = 0; sub < 2; ++sub) {
      const int ko = sub * 32;
      if (key0 + ko <= wrow0 + 31) {
        const bool needmask = (key0 + ko + 31 > wrow0);
        bf16x8 pa0, pa1, pb0, pb1;
        qk_softmax32<NS, RSK, QL>(buf + ko * RSK, qfa, qla, needmask, key0 + ko, qrow, h, r, ma, la, Oa, pa0, pa1);
        if (NMAP == 2)
          qk_softmax32<NS, RSK, QL>(buf + KTILE + ko * RSK, qfa, qlb, needmask, key0 + ko, qrow, h, r, mb, lb, Ob, pb0, pb1);
#pragma unroll
        for (int ks = 0; ks < 2; ++ks)
#pragma unroll
          for (int c = 0; c < 4; ++c) {
            const char* ap = buf + VOFF + (ko + 16 * ks + 4 * h + q4) * 320 + (32 * c + 16 * blk) * 2 + 8 * p4;
            s16x4 lo = trread(ap), hi = trread(ap + 8 * 320);
            bf16x8 a = __builtin_shufflevector(lo, hi, 0, 1, 2, 3, 4, 5, 6, 7);
            Oa[c] = MFMA(a, ks ? pa1 : pa0, Oa[c]);
            if (NMAP == 2) Ob[c] = MFMA(a, ks ? pb1 : pb0, Ob[c]);
          }
      }
    }
    if (t + 1 < nt) sstore(smem + ((t + 1) & 1) * STAGE);
    __syncthreads();
  }
  const float inva = 1.f / (la + __shfl_xor(la, 32));
  if (NMAP == 1) {
#pragma unroll
    for (int c = 0; c < 4; ++c)
#pragma unroll
      for (int i = 0; i < 16; ++i) Oa[c][i] *= inva;
  } else {
    const float li = *lamp / (lb + __shfl_xor(lb, 32));
    float s2 = 0.f;
#pragma unroll
    for (int c = 0; c < 4; ++c)
#pragma unroll
      for (int i = 0; i < 16; ++i) {
        float v = Oa[c][i] * inva - li * Ob[c][i];
        Oa[c][i] = v; s2 += v * v;
      }
    s2 += __shfl_xor(s2, 32);
    const float rn = rsqrtf(s2 * (1.f / 128.f) + EPS) * 0.8f;
#pragma unroll
    for (int c = 0; c < 4; ++c)
#pragma unroll
      for (int gq = 0; gq < 4; ++gq) {
        const int d = 32 * c + 8 * gq + 4 * h;
        asm volatile("" ::: "memory");
        float4 gg = *(const float4*)(subg + d);
        Oa[c][4 * gq] *= rn * gg.x; Oa[c][4 * gq + 1] *= rn * gg.y; Oa[c][4 * gq + 2] *= rn * gg.z; Oa[c][4 * gq + 3] *= rn * gg.w;
      }
  }
  {
    u16* base = outp + (size_t)wrow0 * LDH;
    store_rows_bf16_lds(Oa, smem + w * 8704, lane, [&](int row, int c16) __attribute__((always_inline)) { return base + (size_t)row * LDH + c16 * 8; });
  }
  __syncthreads();
}

DI void conv_table_slice(const float* __restrict__ src, uint2* __restrict__ dst, float scale, int slice, int nslices) {
  const size_t groups = (size_t)16384 * 1024 / 16;
  const size_t gt = (size_t)lbid() * 512 + ltid(), NT = (size_t)lgdim() * 512;
  const size_t lo = groups * slice / nslices, hi = groups * (slice + 1) / nslices;
  for (size_t i = lo + gt; i < hi; i += NT) {
    const float4* sp = (const float4*)src + 4 * i;
    float4 a0 = sp[0], a1 = sp[1], a2 = sp[2], a3 = sp[3];
    unsigned w0 = 0, w1 = 0;
    w0 = __builtin_amdgcn_cvt_scalef32_pk_fp4_f32(w0, a0.x * scale, a0.y * scale, 1.0f, 0);
    w0 = __builtin_amdgcn_cvt_scalef32_pk_fp4_f32(w0, a0.z * scale, a0.w * scale, 1.0f, 1);
    w0 = __builtin_amdgcn_cvt_scalef32_pk_fp4_f32(w0, a1.x * scale, a1.y * scale, 1.0f, 2);
    w0 = __builtin_amdgcn_cvt_scalef32_pk_fp4_f32(w0, a1.z * scale, a1.w * scale, 1.0f, 3);
    w1 = __builtin_amdgcn_cvt_scalef32_pk_fp4_f32(w1, a2.x * scale, a2.y * scale, 1.0f, 0);
    w1 = __builtin_amdgcn_cvt_scalef32_pk_fp4_f32(w1, a2.z * scale, a2.w * scale, 1.0f, 1);
    w1 = __builtin_amdgcn_cvt_scalef32_pk_fp4_f32(w1, a3.x * scale, a3.y * scale, 1.0f, 2);
    w1 = __builtin_amdgcn_cvt_scalef32_pk_fp4_f32(w1, a3.z * scale, a3.w * scale, 1.0f, 3);
    dst[i] = make_uint2(w0, w1);
  }
}

DI void phase_attn(const Params& p, char* smem) {
  const int G = lgdim(), g = lbid();
  const u16* Qm = (const u16*)(p.ws + OFF_QM); const u16* Km = (const u16*)(p.ws + OFF_KM);
  const u16* Vm = (const u16*)(p.ws + OFF_VM); const u16* Qd = (const u16*)(p.ws + OFF_QD);
  const u16* Kd = (const u16*)(p.ws + OFF_KD); const u16* proj = (const u16*)(p.ws + OFF_PROJ);
  u16* mixed = (u16*)(p.ws + OFF_H);
  const float* lamp = (const float*)(p.ws + OFF_LAM);
  const int nrounds = (2048 + G - 1) / G;
  for (int k = 0; k * G < 2048; ++k) {
    conv_table_slice(p.in[23], (uint2*)(p.ws + OFF_U), U_SCALE, k, nrounds);
    conv_table_slice(p.in[24], (uint2*)(p.ws + OFF_V), V_SCALE, k, nrounds);
    const int idx = (k & 1) ? k * G + (G - 1 - g) : k * G + g;
    if (idx >= 2048) continue;
    const int level = idx >> 7, qblk = 15 - level, j = idx & 127, type = j & 1, bh = j >> 1;
    const int b = bh >> 2, hd = bh & 3;
    if (type == 0) {
      const size_t ho = (size_t)(b * 4 + hd) * S_;
      attn_item<192, 1>(Qm + ho * 192, nullptr, Km + ho * 192, nullptr, Vm + ho * 128, 128, qblk,
                        mixed + (size_t)b * S_ * LDH + hd * 128, lamp, nullptr, smem);
    } else {
      const size_t h0 = (size_t)(b * 8 + 2 * hd) * S_ * 64, h1 = h0 + (size_t)S_ * 64;
      attn_item<64, 2>(Qd + h0, Qd + h1, Kd + h0, Kd + h1, proj + (size_t)b * S_ * NPROJ + 1728 + hd * 128, NPROJ,
                       qblk, mixed + (size_t)b * S_ * LDH + 512 + hd * 128, lamp, p.in[18], smem);
    }
  }
}

template <int ST>
DI void ins1(float (&T)[16], float s) {
#pragma unroll
  for (int j = 15; j > ST; --j) T[j] = __builtin_amdgcn_fmed3f(T[j - 1], s, T[j]);
  T[ST] = fmaxf(T[ST], s);
}
DI void peer_scores_top16(const char* sk, const u16* __restrict__ pqrow, int lane, float (&T)[16]) {
  const int h = lane >> 5, r = lane & 31;
  bf16x8 bq[8];
#pragma unroll
  for (int s = 0; s < 8; ++s) bq[s] = *(const bf16x8*)(pqrow + 16 * s + 8 * h);
#pragma unroll
  for (int j = 0; j < 16; ++j) T[j] = NEG_INF;
#pragma unroll
  for (int c = 0; c < 4; ++c) {
    f32x16 acc;
#pragma unroll
    for (int i = 0; i < 16; ++i) acc[i] = 0.f;
#pragma unroll
    for (int s = 0; s < 8; ++s) {
      bf16x8 a = *(const bf16x8*)(sk + (32 * c + r) * 272 + (16 * s + 8 * h) * 2);
      acc = MFMA(a, bq[s], acc);
    }
#pragma unroll
    for (int i = 0; i < 16; ++i) {
      const unsigned code = (unsigned)(127 - 32 * c - (i & 3) - 8 * (i >> 2)) - 4u * (unsigned)h;
      ins1<0>(T, __uint_as_float((__float_as_uint(acc[i]) & 0xffffff80u) | code));
    }
  }
  float o[16];
#pragma unroll
  for (int j = 0; j < 16; ++j) o[j] = __shfl_xor(T[j], 32);
  ins1<0>(T, o[0]); ins1<1>(T, o[1]); ins1<2>(T, o[2]); ins1<3>(T, o[3]);
  ins1<4>(T, o[4]); ins1<5>(T, o[5]); ins1<6>(T, o[6]); ins1<7>(T, o[7]);
  ins1<8>(T, o[8]); ins1<9>(T, o[9]); ins1<10>(T, o[10]); ins1<11>(T, o[11]);
  ins1<12>(T, o[12]); ins1<13>(T, o[13]); ins1<14>(T, o[14]); ins1<15>(T, o[15]);
}

DI float gelu_exact(float x) { return 0.5f * x * (1.f + erff(x * 0.7071067811865476f)); }

DI void load_sk(char* smem, const u16* SK, int hp, int tid) {
#pragma unroll
  for (int i = 0; i < 4; ++i) {
    const int id = tid + 512 * i, row = id >> 4, c16 = id & 15;
    *(u32x4*)(smem + row * 272 + c16 * 16) = *(const u32x4*)(SK + (size_t)hp * 16384 + row * 128 + c16 * 8);
  }
}

DI void peer_route(const Params& p, char* smem, int t0) {
  const int tid = ltid(), lane = tid & 63, w = tid >> 6, h = lane >> 5, r = lane & 31;
  const u16* pq = (const u16*)(p.ws + OFF_PROJ);
  const u16* SK = (const u16*)(p.ws + OFF_SK);
  uint2* topk = (uint2*)(p.ws + OFF_TOPK);
    const int tq = t0 + 32 * w + r;
#pragma unroll 1
    for (int hd = 0; hd < 8; ++hd) {
      float TA[16], TB[16];
      __syncthreads();
      load_sk(smem, SK, hd * 2, tid);
      __syncthreads();
      peer_scores_top16(smem, pq + (size_t)tq * 2048 + (hd * 2) * 128, lane, TA);
      __syncthreads();
      load_sk(smem, SK, hd * 2 + 1, tid);
      __syncthreads();
      peer_scores_top16(smem, pq + (size_t)tq * 2048 + (hd * 2 + 1) * 128, lane, TB);
      float FK[16];
#pragma unroll
      for (int j = 0; j < 16; ++j) FK[j] = NEG_INF;
#pragma unroll
      for (int i = 0; i < 16; ++i)
#pragma unroll
        for (int j = 0; j < 16; ++j)
          if ((i + 1) * (j + 1) <= 16) {
            const float cv = __uint_as_float(__float_as_uint(TA[i]) & 0xffffff80u) + __uint_as_float(__float_as_uint(TB[j]) & 0xffffff80u);
            const float key = __uint_as_float((__float_as_uint(cv) & 0xffffff00u) | (unsigned)(255 - (16 * i + j)));
            const int st = (i + 1) * (j + 1) - 1;
#pragma unroll
            for (int q = 15; q >= 1; --q)
              if (q > st) FK[q] = __builtin_amdgcn_fmed3f(FK[q - 1], key, FK[q]);
            FK[st] = fmaxf(FK[st], key);
          }
      float FV[16]; int FI[16];
#pragma unroll
      for (int m = 0; m < 16; ++m) {
        const unsigned kb = __float_as_uint(FK[m]);
        const int code = 255 - (int)(kb & 255u), ci = code >> 4, cj = code & 15;
        FV[m] = __uint_as_float(kb & 0xffffff00u);
        float ra = TA[0], rb = TB[0];
#pragma unroll
        for (int q = 1; q < 16; ++q) { ra = (ci == q) ? TA[q] : ra; rb = (cj == q) ? TB[q] : rb; }
        FI[m] = (127 - (int)(__float_as_uint(ra) & 127u)) * 128 + (127 - (int)(__float_as_uint(rb) & 127u));
      }
      float e[16], sum = 0.f;
#pragma unroll
      for (int j = 0; j < 16; ++j) { e[j] = expf(FV[j] - FV[0]); sum += e[j]; }
      const float rs = 1.f / sum;
      if (h == 0) {
        u32x4* dst = (u32x4*)(topk + (size_t)tq * 128 + hd * 16);
#pragma unroll
        for (int q = 0; q < 8; ++q) {
          u32x4 o;
          o.x = (unsigned)FI[2 * q]; o.y = __float_as_uint(e[2 * q] * rs);
          o.z = (unsigned)FI[2 * q + 1]; o.w = __float_as_uint(e[2 * q + 1] * rs);
          dst[q] = o;
        }
      }
    }
}

DI void peer_gather(const Params& p, int t0) {
  const int tid = ltid(), lane = tid & 63, w = tid >> 6;
  const uint2* topk = (const uint2*)(p.ws + OFF_TOPK);
  const float* mod = (const float*)(p.ws + OFF_MOD);
  const unsigned char* U8 = (const unsigned char*)(p.ws + OFF_U);
  const unsigned char* V8 = (const unsigned char*)(p.ws + OFF_V);
#pragma unroll 1
  for (int ti = 0; ti < 32; ++ti) {
    const int t = t0 + 32 * w + ti, b = t >> 12;
    const float* mb = mod + b * 6144;
    float* orow = p.out + (size_t)t * 1024 + lane * 16;
    f32x2 xr[8];
#pragma unroll
    for (int q = 0; q < 4; ++q) {
      float4 a = ((const float4*)orow)[q];
      xr[2 * q] = f32x2{a.x, a.y}; xr[2 * q + 1] = f32x2{a.z, a.w};
    }
    float ss = 0.f;
#pragma unroll
    for (int i = 0; i < 8; ++i) ss += xr[i].x * xr[i].x + xr[i].y * xr[i].y;
    ss = wave_sum(ss);
    const float rinv = rsqrtf(ss * (1.f / 1024.f) + EPS);
    f32x2 hf[8];
#pragma unroll
    for (int q = 0; q < 4; ++q) {
      const int d0 = lane * 16 + 4 * q;
      float4 gg = *(const float4*)(p.in[20] + d0);
      float4 sc = *(const float4*)(mb + 4096 + d0);
      float4 sh = *(const float4*)(mb + 3072 + d0);
      hf[2 * q] = f32x2{xr[2 * q].x * rinv * gg.x * (1.f + sc.x) + sh.x, xr[2 * q].y * rinv * gg.y * (1.f + sc.y) + sh.y};
      hf[2 * q + 1] = f32x2{xr[2 * q + 1].x * rinv * gg.z * (1.f + sc.z) + sh.z, xr[2 * q + 1].y * rinv * gg.w * (1.f + sc.w) + sh.w};
    }
    const u32x4 tk = *(const u32x4*)(topk + (size_t)t * 128 + lane * 2);
    f32x2 y[8];
#pragma unroll
    for (int i = 0; i < 8; ++i) y[i] = f32x2{0.f, 0.f};
    uint2 ua[16], va[16], ub[16], vb[16];
    float gA, gB;
    auto issue = [&](int jj, uint2 (&uu)[16], uint2 (&vv)[16], float& gsel) __attribute__((always_inline)) {
      float gs = 0.f;
#pragma unroll
      for (int k = 0; k < 16; ++k) {
        const int l = 8 * jj + (k >> 1);
        const int e = __builtin_amdgcn_readlane((int)((k & 1) ? tk.z : tk.x), l);
        const float g = __uint_as_float(__builtin_amdgcn_readlane((int)((k & 1) ? tk.w : tk.y), l));
        gs = ((lane >> 2) == k) ? g : gs;
        uu[k] = *(const uint2*)(U8 + (size_t)e * 512 + lane * 8);
        vv[k] = *(const uint2*)(V8 + (size_t)e * 512 + lane * 8);
      }
      gsel = gs;
    };
    auto process = [&](const uint2 (&uu)[16], const uint2 (&vv)[16], float gsel) __attribute__((always_inline)) {
      float d[16];
#pragma unroll
      for (int k = 0; k < 16; ++k) {
        f32x2 a2 = f32x2{0.f, 0.f};
        a2 = __builtin_amdgcn_cvt_scalef32_pk_f32_fp4(uu[k].x, 1.0f, 0) * hf[0] + a2;
        a2 = __builtin_amdgcn_cvt_scalef32_pk_f32_fp4(uu[k].x, 1.0f, 1) * hf[1] + a2;
        a2 = __builtin_amdgcn_cvt_scalef32_pk_f32_fp4(uu[k].x, 1.0f, 2) * hf[2] + a2;
        a2 = __builtin_amdgcn_cvt_scalef32_pk_f32_fp4(uu[k].x, 1.0f, 3) * hf[3] + a2;
        a2 = __builtin_amdgcn_cvt_scalef32_pk_f32_fp4(uu[k].y, 1.0f, 0) * hf[4] + a2;
        a2 = __builtin_amdgcn_cvt_scalef32_pk_f32_fp4(uu[k].y, 1.0f, 1) * hf[5] + a2;
        a2 = __builtin_amdgcn_cvt_scalef32_pk_f32_fp4(uu[k].y, 1.0f, 2) * hf[6] + a2;
        a2 = __builtin_amdgcn_cvt_scalef32_pk_f32_fp4(uu[k].y, 1.0f, 3) * hf[7] + a2;
        d[k] = a2.x + a2.y;
      }
      const bool h32 = (lane & 32) != 0, h16 = (lane & 16) != 0, h8 = (lane & 8) != 0, h4 = (lane & 4) != 0;
      float r8[8], r4[4], r2[2];
#pragma unroll
      for (int i = 0; i < 8; ++i) r8[i] = (h32 ? d[8 + i] : d[i]) + __shfl_xor(h32 ? d[i] : d[8 + i], 32);
#pragma unroll
      for (int i = 0; i < 4; ++i) r4[i] = (h16 ? r8[4 + i] : r8[i]) + __shfl_xor(h16 ? r8[i] : r8[4 + i], 16);
#pragma unroll
      for (int i = 0; i < 2; ++i) r2[i] = (h8 ? r4[2 + i] : r4[i]) + __shfl_xor(h8 ? r4[i] : r4[2 + i], 8);
      float kk = (h4 ? r2[1] : r2[0]) + __shfl_xor(h4 ? r2[0] : r2[1], 4);
      kk += __shfl_xor(kk, 2); kk += __shfl_xor(kk, 1);
      const float coefv = gsel * gelu_exact(kk * (1.f / U_SCALE)) * (1.f / V_SCALE);
#pragma unroll
      for (int k = 0; k < 16; ++k) {
        const float cf = __uint_as_float(__builtin_amdgcn_readlane((int)__float_as_uint(coefv), 4 * k));
        const f32x2 cf2 = f32x2{cf, cf};
        y[0] = __builtin_amdgcn_cvt_scalef32_pk_f32_fp4(vv[k].x, 1.0f, 0) * cf2 + y[0];
        y[1] = __builtin_amdgcn_cvt_scalef32_pk_f32_fp4(vv[k].x, 1.0f, 1) * cf2 + y[1];
        y[2] = __builtin_amdgcn_cvt_scalef32_pk_f32_fp4(vv[k].x, 1.0f, 2) * cf2 + y[2];
        y[3] = __builtin_amdgcn_cvt_scalef32_pk_f32_fp4(vv[k].x, 1.0f, 3) * cf2 + y[3];
        y[4] = __builtin_amdgcn_cvt_scalef32_pk_f32_fp4(vv[k].y, 1.0f, 0) * cf2 + y[4];
        y[5] = __builtin_amdgcn_cvt_scalef32_pk_f32_fp4(vv[k].y, 1.0f, 1) * cf2 + y[5];
        y[6] = __builtin_amdgcn_cvt_scalef32_pk_f32_fp4(vv[k].y, 1.0f, 2) * cf2 + y[6];
        y[7] = __builtin_amdgcn_cvt_scalef32_pk_f32_fp4(vv[k].y, 1.0f, 3) * cf2 + y[7];
      }
    };
    issue(0, ua, va, gA);
#pragma unroll 1
    for (int jj = 0; jj < 8; jj += 2) {
      issue(jj + 1, ub, vb, gB);
      __builtin_amdgcn_sched_barrier(0);
      process(ua, va, gA);
      __builtin_amdgcn_sched_barrier(0);
      issue((jj + 2) & 7, ua, va, gA);
      __builtin_amdgcn_sched_barrier(0);
      process(ub, vb, gB);
      __builtin_amdgcn_sched_barrier(0);
    }
#pragma unroll
    for (int q = 0; q < 4; ++q) {
      float4 g2 = *(const float4*)(mb + 5120 + lane * 16 + 4 * q);
      float4 o;
      o.x = xr[2 * q].x + g2.x * y[2 * q].x; o.y = xr[2 * q].y + g2.y * y[2 * q].y;
      o.z = xr[2 * q + 1].x + g2.z * y[2 * q + 1].x; o.w = xr[2 * q + 1].y + g2.w * y[2 * q + 1].y;
      ((float4*)orow)[q] = o;
    }
  }
}

typedef const __attribute__((address_space(4))) Params* KParamsPtr;
__global__ void __launch_bounds__(512) mega(Params p_arg) {
  __shared__ __attribute__((aligned(16))) char smem[151552];
  for (int ph = p_arg.ph_begin; ph < p_arg.ph_end; ++ph) {
    KParamsPtr kp = (KParamsPtr)__builtin_amdgcn_kernarg_segment_ptr();
    asm volatile("" : "+s"(kp));
    Params p;
#pragma unroll
    for (int i = 0; i < 25; ++i) p.in[i] = kp->in[i];
    p.out = kp->out; p.ws = kp->ws; p.ph_begin = 0; p.ph_end = 0;
    const int G = lgdim();
    if (ph == 0) {
      phase0(p, smem);
    } else if (ph == 1) {
      rownorm_phase(p, p.in[0], p.in[4], 0, 1024, (u16*)(p.ws + OFF_H));
    } else if (ph == 2) {
      u16* proj = (u16*)(p.ws + OFF_PROJ);
      xcd_tiles(p.ws, 0, 9, [&](int tt, int ft2) __attribute__((always_inline)) {
        gemm_tile<1024, false>((const u16*)(p.ws + OFF_WIN), NPROJ, ft2 * 256, (const u16*)(p.ws + OFF_H), LDH,
                               (size_t)tt * 256, smem, [&](f32x16 (&acc)[4], float, int t, int h, int wf, char* wbase, int tg) __attribute__((always_inline)) {
                                 store_tile_bf16_lds(acc, wbase + tg * 8704, proj + (size_t)(t & ~31) * NPROJ + ft2 * 256 + wf * 128, NPROJ, ltid() & 63);
                               });
      });
    } else if (ph == 3) {
      phase_qkv(p, smem);
    } else if (ph == 4) {
      phase_attn(p, smem);
    } else if (ph == 5) {
      const float* mod = (const float*)(p.ws + OFF_MOD);
      xcd_tiles(p.ws, 3, 4, [&](int tt, int ft2) __attribute__((always_inline)) {
        gemm_tile<1024, false>((const u16*)(p.ws + OFF_WOUT), 1024, ft2 * 256, (const u16*)(p.ws + OFF_H), LDH,
                               (size_t)tt * 256, smem, [&](f32x16 (&acc)[4], float, int t, int h, int wf, char* wbase, int tg) __attribute__((always_inline)) {
                                 const int ft = ft2 * 2 + wf, lane = ltid() & 63, r = lane & 31;
#pragma unroll
                                 for (int c = 0; c < 4; ++c)
#pragma unroll
                                   for (int gq = 0; gq < 4; ++gq)
                                     *(float4*)(wbase + r * 528 + (32 * c + 8 * gq + 4 * h) * 4) =
                                         make_float4(acc[c][4 * gq], acc[c][4 * gq + 1], acc[c][4 * gq + 2], acc[c][4 * gq + 3]);
                                 const int tg0 = t & ~31, b = tg0 >> 12;
#pragma unroll
                                 for (int j = 0; j < 16; ++j) {
                                   const int idx = lane + 64 * j, row = idx >> 5, c16 = idx & 31;
                                   const float4 a = *(const float4*)(wbase + row * 528 + c16 * 16);
                                   const int n = ft * 128 + c16 * 4;
                                   const size_t off = (size_t)(tg0 + row) * 1024 + n;
                                   const float4 xv = *(const float4*)(p.in[0] + off);
                                   const float4 g1 = *(const float4*)(mod + b * 6144 + 2048 + n);
                                   float4 o;
                                   o.x = xv.x + g1.x * a.x; o.y = xv.y + g1.y * a.y; o.z = xv.z + g1.z * a.z; o.w = xv.w + g1.w * a.w;
                                   *(float4*)(p.out + off) = o;
                                 }
                               });
      });
    } else if (ph == 6) {
      rownorm_phase(p, p.out, p.in[20], 3072, 4096, (u16*)(p.ws + OFF_H2));
    } else if (ph == 7) {
      u16* pq = (u16*)(p.ws + OFF_PROJ);
      xcd_tiles(p.ws, 4, 8, [&](int tt, int ft2) __attribute__((always_inline)) {
        gemm_tile<1024, false>((const u16*)(p.ws + OFF_WPQ), 2048, ft2 * 256, (const u16*)(p.ws + OFF_H2), LDH,
                               (size_t)tt * 256, smem, [&](f32x16 (&acc)[4], float, int t, int h, int wf, char* wbase, int tg) __attribute__((always_inline)) {
                                 store_tile_bf16_lds(acc, wbase + tg * 8704, pq + (size_t)(t & ~31) * 2048 + ft2 * 256 + wf * 128, 2048, ltid() & 63);
                               });
      });
    } else {
      for (int tt = lbid(); tt < 256; tt += G) {
        peer_route(p, smem, tt * 256);
        __threadfence();
        __syncthreads();
        __threadfence();
        peer_gather(p, tt * 256);
      }
    }
#if COOP
    if (ph + 1 < p_arg.ph_end) cg::this_grid().sync();
#endif
  }
}

extern "C" void kernel_launch(void* const* d_in, const int* in_sizes, int n_in, void* d_out, int out_size,
                              void* d_ws, size_t ws_size, hipStream_t stream) {
  static int grid_blocks = 0;
  if (!grid_blocks) {
    int dev = 0, cus = 0, per_cu = 0;
    hipGetDevice(&dev);
    hipDeviceGetAttribute(&cus, hipDeviceAttributeMultiprocessorCount, dev);
    hipOccupancyMaxActiveBlocksPerMultiprocessor(&per_cu, mega, 512, 0);
    if (per_cu < 1) per_cu = 1;
    if (per_cu > 1) per_cu = 1;
    grid_blocks = cus * per_cu;
  }
  Params p{};
  for (int i = 0; i < 25; ++i) p.in[i] = (const float*)d_in[i];
  p.out = (float*)d_out;
  p.ws = (char*)d_ws;
#if COOP
  p.ph_begin = 0; p.ph_end = 9;
  void* args[] = {&p};
  hipError_t e = hipLaunchCooperativeKernel((void*)mega, dim3(grid_blocks), dim3(512), args, 0, stream);
  if (e != hipSuccess) fprintf(stderr, "cooperative launch failed: %s (grid %d)\n", hipGetErrorString(e), grid_blocks);
#else
  for (int ph = 0; ph < 9; ++ph) {
    p.ph_begin = ph; p.ph_end = ph + 1;
    hipLaunchKernelGGL(mega, dim3(grid_blocks), dim3(512), 0, stream, p);
  }
#endif
}
```

```cpp
#include <hip/hip_runtime.h>
#include <hip/hip_cooperative_groups.h>
#include <cstdio>
namespace cg = cooperative_groups;

typedef unsigned short u16;
typedef short bf16x8 __attribute__((ext_vector_type(8)));
typedef short s16x4 __attribute__((ext_vector_type(4)));
typedef float f32x16 __attribute__((ext_vector_type(16)));
typedef __bf16 bf2_t __attribute__((ext_vector_type(2)));
typedef unsigned u32x4 __attribute__((ext_vector_type(4)));
#define DI __device__ __forceinline__
#define LDSP(T, p) ((__attribute__((address_space(3))) T*)(p))
#define MFMA(a, b, c) __builtin_amdgcn_mfma_f32_32x32x16_bf16((a), (b), (c), 0, 0, 0)

#ifndef COOP
#define COOP 1
#endif

constexpr int S_ = 4096, T_ = 65536, NPROJ = 2304;
constexpr int LDH = 1088;
constexpr float EPS = 1e-6f;
constexpr float LOG2E = 1.4426950408889634f;
constexpr float NEG_INF = -__builtin_inff();
constexpr float U_SCALE = 64.f, V_SCALE = 5.656854f;
typedef float f32x2 __attribute__((ext_vector_type(2)));

constexpr size_t OFF_MOD = 0;
constexpr size_t OFF_LAM = 393216;
constexpr size_t OFF_CNT = 397312;
constexpr size_t OFF_ROPE = 524288;
constexpr size_t OFF_WIN = 1572864;
constexpr size_t OFF_WQ = 6291456;
constexpr size_t OFF_WKV = 6881280;
constexpr size_t OFF_WOUT = 7405568;
constexpr size_t OFF_WPQ = 9502720;
constexpr size_t OFF_SK = 13697024;
constexpr size_t OFF_U = 16777216;
constexpr size_t OFF_V = 50331648;
constexpr size_t OFF_H = 83886080;
constexpr size_t OFF_PROJ = 226492416;
constexpr size_t OFF_QM = 528482304;
constexpr size_t OFF_KM = 629145600;
constexpr size_t OFF_VM = 729808896;
constexpr size_t OFF_QD = 796917760;
constexpr size_t OFF_KD = 864026624;
constexpr size_t OFF_H2 = OFF_QM;
constexpr size_t OFF_TOPK = OFF_VM;

struct Params {
  const float* in[25];
  float* out;
  char* ws;
  int ph_begin, ph_end;
};

DI unsigned pk2(float a, float b) {
  bf2_t r; r[0] = (__bf16)a; r[1] = (__bf16)b; return __builtin_bit_cast(unsigned, r);
}
DI float bflo(unsigned u) { return __uint_as_float(u << 16); }
DI float bfhi(unsigned u) { return __uint_as_float(u & 0xffff0000u); }
DI float dot2bf(unsigned a, unsigned b, float c) {
  return __builtin_amdgcn_fdot2_f32_bf16(__builtin_bit_cast(bf2_t, a), __builtin_bit_cast(bf2_t, b), c, false);
}
DI int lbid() { int t = blockIdx.x; asm volatile("" : "+s"(t)); return t; }
DI int lgdim() { int t = gridDim.x; asm volatile("" : "+s"(t)); return t; }
DI int ltid() { int t = threadIdx.x; asm volatile("" : "+v"(t)); return t; }
DI float xsum32(float v) {
  const unsigned u = __float_as_uint(v);
  auto r = __builtin_amdgcn_permlane32_swap(u, u, false, false);
  return __uint_as_float(r[0]) + __uint_as_float(r[1]);
}
DI float xmax32(float v) {
  const unsigned u = __float_as_uint(v);
  auto r = __builtin_amdgcn_permlane32_swap(u, u, false, false);
  return fmaxf(__uint_as_float(r[0]), __uint_as_float(r[1]));
}
DI float swapsum32(float a, float b) {
  auto r = __builtin_amdgcn_permlane32_swap(__float_as_uint(a), __float_as_uint(b), false, false);
  return __uint_as_float(r[0]) + __uint_as_float(r[1]);
}
DI float swapsum16(float a, float b) {
  auto r = __builtin_amdgcn_permlane16_swap(__float_as_uint(a), __float_as_uint(b), false, false);
  return __uint_as_float(r[0]) + __uint_as_float(r[1]);
}
template <int CTRL>
DI float dppmov(float v) {
  return __uint_as_float((unsigned)__builtin_amdgcn_update_dpp(0, (int)__float_as_uint(v), CTRL, 0xF, 0xF, true));
}
DI float wave_sum(float v) {
  v += dppmov<0x128>(v); v += dppmov<0x124>(v); v += dppmov<0x122>(v); v += dppmov<0x121>(v);
  v = swapsum16(v, v);
  return xsum32(v);
}
DI s16x4 trread(const char* p) { return __builtin_amdgcn_ds_read_tr16_b64_v4i16(LDSP(s16x4, p)); }
DI unsigned xcc_id() { return (unsigned)__builtin_amdgcn_s_getreg((3 << 11) | 20) & 0x7u; }
template <class F>
DI void xcd_tiles(char* ws, int set, int nft, F body) {
  __shared__ int sh_item;
  unsigned* cnt = (unsigned*)(ws + OFF_CNT);
  const int x0 = (int)xcc_id();
  const int per = 32 * nft;
  for (int q = 0; q < 8; ++q) {
    const int x = (x0 + q) & 7;
    for (;;) {
      __syncthreads();
      if (threadIdx.x == 0) sh_item = (int)atomicAdd(cnt + (set * 8 + x) * 32, 1u);
      __syncthreads();
      const int it = sh_item;
      if (it >= per) break;
      body(32 * x + it / nft, it % nft);
    }
  }
}

constexpr int G_ARS = 576;
constexpr int G_ASZ = 64 * G_ARS, G_BSZ = 256 * 144, G_STAGE = G_ASZ + G_BSZ;

template <int K, bool SUMSQ, class Epi>
DI void gemm_tile(const u16* __restrict__ W, int ldw, int n0, const u16* __restrict__ X, int ldx, size_t t0,
                  char* smem, Epi epi) {
  constexpr int KT = K / 64;
  const int tid = ltid(), lane = tid & 63, w = tid >> 6, h = lane >> 5, r = lane & 31;
  const int wf = w & 1, wt = w >> 1;
  const int blk = (lane >> 4) & 1, q4 = (lane & 15) >> 2, p4 = lane & 3;
  u32x4 ra[4], rb[4];
  const unsigned aoff = (unsigned)((tid >> 5) * ldw + (tid & 31) * 8), boff = (unsigned)((tid >> 3) * ldx + (tid & 7) * 8);
  const unsigned asoff = (unsigned)((tid >> 5) * G_ARS + (tid & 31) * 16), bsoff = (unsigned)(G_ASZ + (tid >> 3) * 144 + (tid & 7) * 16);
  auto gload = [&](int kt) __attribute__((always_inline)) {
    const u16* wk = W + (size_t)kt * 64 * ldw + n0;
    const u16* xk = X + t0 * (size_t)ldx + kt * 64;
#pragma unroll
    for (int i = 0; i < 4; ++i) ra[i] = *(const u32x4*)(wk + (size_t)i * 16 * ldw + aoff);
#pragma unroll
    for (int i = 0; i < 4; ++i) rb[i] = *(const u32x4*)(xk + (size_t)i * 64 * ldx + boff);
  };
  auto sstore = [&](char* buf) __attribute__((always_inline)) {
#pragma unroll
    for (int i = 0; i < 4; ++i) *(u32x4*)(buf + asoff + i * 16 * G_ARS) = ra[i];
#pragma unroll
    for (int i = 0; i < 4; ++i) *(u32x4*)(buf + bsoff + i * 64 * 144) = rb[i];
  };
  f32x16 acc[2][4];
#pragma unroll
  for (int g = 0; g < 2; ++g)
#pragma unroll
    for (int c = 0; c < 4; ++c)
#pragma unroll
      for (int i = 0; i < 16; ++i) acc[g][c][i] = 0.f;
  float ss0 = 0.f, ss1 = 0.f;
  auto compute = [&](const char* buf) __attribute__((always_inline)) {
    u32x4 bfr[2][2];
    s16x4 alo[2][4], ahi[2][4];
    auto lfrag = [&](int s, int slot) __attribute__((always_inline)) {
      bfr[slot][0] = *(const u32x4*)(buf + G_ASZ + (64 * wt + r) * 144 + (16 * s + 8 * h) * 2);
      bfr[slot][1] = *(const u32x4*)(buf + G_ASZ + (64 * wt + 32 + r) * 144 + (16 * s + 8 * h) * 2);
#pragma unroll
      for (int c = 0; c < 4; ++c) {
        const char* ap = buf + (16 * s + 8 * h + q4) * G_ARS + (128 * wf + 32 * c + 16 * blk) * 2 + 8 * p4;
        alo[slot][c] = trread(ap); ahi[slot][c] = trread(ap + 4 * G_ARS);
      }
    };
    lfrag(0, 0);
#pragma unroll
    for (int s = 0; s < 4; ++s) {
      if (s < 3) lfrag(s + 1, (s + 1) & 1);
      __builtin_amdgcn_sched_barrier(0);
      const u32x4 b0r = bfr[s & 1][0], b1r = bfr[s & 1][1];
      if (SUMSQ) {
        ss0 = dot2bf(b0r.x, b0r.x, ss0); ss0 = dot2bf(b0r.y, b0r.y, ss0);
        ss0 = dot2bf(b0r.z, b0r.z, ss0); ss0 = dot2bf(b0r.w, b0r.w, ss0);
        ss1 = dot2bf(b1r.x, b1r.x, ss1); ss1 = dot2bf(b1r.y, b1r.y, ss1);
        ss1 = dot2bf(b1r.z, b1r.z, ss1); ss1 = dot2bf(b1r.w, b1r.w, ss1);
      }
      const bf16x8 b0 = __builtin_bit_cast(bf16x8, b0r), b1 = __builtin_bit_cast(bf16x8, b1r);
#pragma unroll
      for (int c = 0; c < 4; ++c) {
        const bf16x8 a = __builtin_shufflevector(alo[s & 1][c], ahi[s & 1][c], 0, 1, 2, 3, 4, 5, 6, 7);
        acc[0][c] = MFMA(a, b0, acc[0][c]);
        acc[1][c] = MFMA(a, b1, acc[1][c]);
      }
      __builtin_amdgcn_sched_barrier(0);
    }
  };
  gload(0);
  sstore(smem);
  if (KT > 1) gload(1);
  __syncthreads();
  for (int kt = 0; kt < KT; ++kt) {
    char* buf = smem + (kt & 1) * G_STAGE;
    if (kt + 1 < KT) {
      sstore(smem + ((kt + 1) & 1) * G_STAGE);
      if (kt + 2 < KT) gload(kt + 2);
    }
    __builtin_amdgcn_sched_barrier(0);
    compute(buf);
    __syncthreads();
  }
  if (SUMSQ) { ss0 = xsum32(ss0); ss1 = xsum32(ss1); }
  epi(acc[0], ss0, (int)t0 + 64 * wt + r, h, wf, smem + w * 17408, 0);
  epi(acc[1], ss1, (int)t0 + 64 * wt + 32 + r, h, wf, smem + w * 17408, 1);
}

DI void phase0(const Params& p, char* smem) {
  const int tid = ltid(), G = lgdim(), g = lbid();
  const size_t gt = (size_t)g * 512 + tid, NT = (size_t)G * 512;
  float* mod = (float*)(p.ws + OFF_MOD);
  for (int item = g; item < 96; item += G) {
    float* sc = (float*)smem;
    float* red = sc + 16384;
    for (int i = tid; i < 16384; i += 512) { float v = p.in[1][i]; sc[i] = v / (1.f + expf(-v)); }
    __syncthreads();
    const int col = tid & 63, kg = tid >> 6, n = item * 64 + col;
    float acc[16];
#pragma unroll
    for (int b = 0; b < 16; ++b) acc[b] = 0.f;
    const float* aw = p.in[2] + (size_t)(kg * 128) * 6144 + n;
#pragma unroll 4
    for (int k = 0; k < 128; ++k) {
      float wv = aw[(size_t)k * 6144];
#pragma unroll
      for (int b = 0; b < 16; ++b) acc[b] += sc[b * 1024 + kg * 128 + k] * wv;
    }
#pragma unroll
    for (int b = 0; b < 16; ++b) red[(kg * 16 + b) * 64 + col] = acc[b];
    __syncthreads();
    for (int o = tid; o < 1024; o += 512) {
      int b = o >> 6, cc = o & 63;
      float s = 0.f;
#pragma unroll
      for (int k2 = 0; k2 < 8; ++k2) s += red[(k2 * 16 + b) * 64 + cc];
      mod[b * 6144 + item * 64 + cc] = s + p.in[3][item * 64 + cc];
    }
    __syncthreads();
  }
  if (g == 0) {
    unsigned* cnt = (unsigned*)(p.ws + OFF_CNT);
    for (int i = tid; i < 8 * 8 * 32; i += 512) cnt[i] = 0u;
  }
  if (g == 0 && tid < 64) {
    float d1 = wave_sum(p.in[14][tid] * p.in[15][tid]);
    float d2 = wave_sum(p.in[16][tid] * p.in[17][tid]);
    if (tid == 0) *(float*)(p.ws + OFF_LAM) = expf(d1) - expf(d2) + 0.2f;
  }
  {
    float2* rope = (float2*)(p.ws + OFF_ROPE);
    for (size_t i = gt; i < 131072; i += NT) {
      int j = (int)(i & 31), sp = (int)(i >> 5);
      float inv = 1.0f / powf(10000.f, (float)j / 32.f);
      float ang = (float)sp * inv, sn, cs;
      sincosf(ang, &sn, &cs);
      rope[i] = make_float2(cs, sn);
    }
  }
  {
    u16* d = (u16*)(p.ws + OFF_WIN);
    for (size_t i = gt; i < (size_t)1024 * 2304; i += NT) {
      int k = (int)(i / 2304), n = (int)(i % 2304);
      float v = (n < 2240) ? p.in[5][(size_t)k * 2240 + n] : 0.f;
      d[i] = (u16)(pk2(v, 0.f) & 0xffff);
    }
  }
  {
    u16* d = (u16*)(p.ws + OFF_WQ);
    for (size_t i = gt; i < (size_t)384 * 768; i += NT) {
      int k = (int)(i / 768), n = (int)(i % 768);
      int src = (n < 512) ? (n >> 7) * 192 + (n & 127) : ((n - 512) >> 6) * 192 + 128 + ((n - 512) & 63);
      float v = p.in[7][(size_t)k * 768 + src] * p.in[6][k];
      d[i] = (u16)(pk2(v, 0.f) & 0xffff);
    }
  }
  {
    u16* d = (u16*)(p.ws + OFF_WKV);
    for (size_t i = gt; i < (size_t)256 * 1024; i += NT) {
      int k = (int)(i >> 10), n = (int)(i & 1023);
      int src = (n < 512) ? (n >> 7) * 256 + (n & 127) : ((n - 512) >> 7) * 256 + 128 + (n & 127);
      float v = p.in[9][(size_t)k * 1024 + src] * p.in[8][k];
      d[i] = (u16)(pk2(v, 0.f) & 0xffff);
    }
  }
  auto conv8 = [&](const float* src, u16* dst, size_t n8) __attribute__((always_inline)) {
    for (size_t i = gt; i < n8; i += NT) {
      float4 a = ((const float4*)src)[2 * i], b = ((const float4*)src)[2 * i + 1];
      uint4 o; o.x = pk2(a.x, a.y); o.y = pk2(a.z, a.w); o.z = pk2(b.x, b.y); o.w = pk2(b.z, b.w);
      ((uint4*)dst)[i] = o;
    }
  };
  conv8(p.in[19], (u16*)(p.ws + OFF_WOUT), (size_t)1024 * 1024 / 8);
  conv8(p.in[21], (u16*)(p.ws + OFF_WPQ), (size_t)1024 * 2048 / 8);
  conv8(p.in[22], (u16*)(p.ws + OFF_SK), (size_t)16 * 128 * 128 / 8);
}

DI void rownorm_phase(const Params& p, const float* src, const float* gain, int sh_off, int sc_off, u16* dst) {
  const int lane = ltid() & 63;
  const int gw = lbid() * 8 + (ltid() >> 6), NW = lgdim() * 8;
  const float* mod = (const float*)(p.ws + OFF_MOD);
  for (int t = gw; t < T_; t += NW) {
    const int b = t >> 12;
    const float* mb = mod + b * 6144;
#pragma unroll
    for (int c = 0; c < 2; ++c) {
    }
    float xv[16];
#pragma unroll
    for (int c = 0; c < 2; ++c) {
      const float4* sp = (const float4*)(src + (size_t)t * 1024 + c * 512 + lane * 8);
      float4 a = sp[0], bq = sp[1];
      xv[c * 8 + 0] = a.x; xv[c * 8 + 1] = a.y; xv[c * 8 + 2] = a.z; xv[c * 8 + 3] = a.w;
      xv[c * 8 + 4] = bq.x; xv[c * 8 + 5] = bq.y; xv[c * 8 + 6] = bq.z; xv[c * 8 + 7] = bq.w;
    }
    float ss = 0.f;
#pragma unroll
    for (int i = 0; i < 16; ++i) ss += xv[i] * xv[i];
    ss = wave_sum(ss);
    const float rinv = rsqrtf(ss * (1.f / 1024.f) + EPS);
#pragma unroll
    for (int c = 0; c < 2; ++c) {
      const int d0 = c * 512 + lane * 8;
      float o[8];
#pragma unroll
      for (int q = 0; q < 2; ++q) {
        float4 gg = *(const float4*)(gain + d0 + 4 * q);
        float4 sc = *(const float4*)(mb + sc_off + d0 + 4 * q);
        float4 sh = *(const float4*)(mb + sh_off + d0 + 4 * q);
        o[4 * q + 0] = xv[c * 8 + 4 * q + 0] * rinv * gg.x * (1.f + sc.x) + sh.x;
        o[4 * q + 1] = xv[c * 8 + 4 * q + 1] * rinv * gg.y * (1.f + sc.y) + sh.y;
        o[4 * q + 2] = xv[c * 8 + 4 * q + 2] * rinv * gg.z * (1.f + sc.z) + sh.z;
        o[4 * q + 3] = xv[c * 8 + 4 * q + 3] * rinv * gg.w * (1.f + sc.w) + sh.w;
      }
      uint4 ov; ov.x = pk2(o[0], o[1]); ov.y = pk2(o[2], o[3]); ov.z = pk2(o[4], o[5]); ov.w = pk2(o[6], o[7]);
      *(uint4*)(dst + (size_t)t * LDH + d0) = ov;
    }
  }
}

DI void store_tile_bf16_lds(f32x16 (&acc)[4], char* wsm, u16* dst0, size_t ld, int lane) {
  const int h = lane >> 5, r = lane & 31;
#pragma unroll
  for (int c = 0; c < 4; ++c)
#pragma unroll
    for (int gq = 0; gq < 4; ++gq) {
      uint2 v; v.x = pk2(acc[c][4 * gq], acc[c][4 * gq + 1]); v.y = pk2(acc[c][4 * gq + 2], acc[c][4 * gq + 3]);
      *(uint2*)(wsm + r * 272 + (32 * c + 8 * gq + 4 * h) * 2) = v;
    }
#pragma unroll
  for (int j = 0; j < 8; ++j) {
    const int idx = lane + 64 * j, row = idx >> 4, c16 = idx & 15;
    const u32x4 v = *(const u32x4*)(wsm + row * 272 + c16 * 16);
    *(u32x4*)(dst0 + (size_t)row * ld + c16 * 8) = v;
  }
}

template <class AddrFn>
DI void store_rows_bf16_lds(f32x16 (&acc)[4], char* wsm, int lane, AddrFn addr) {
  const int h = lane >> 5, r = lane & 31;
#pragma unroll
  for (int c = 0; c < 4; ++c)
#pragma unroll
    for (int gq = 0; gq < 4; ++gq) {
      uint2 v; v.x = pk2(acc[c][4 * gq], acc[c][4 * gq + 1]); v.y = pk2(acc[c][4 * gq + 2], acc[c][4 * gq + 3]);
      *(uint2*)(wsm + r * 272 + (32 * c + 8 * gq + 4 * h) * 2) = v;
    }
#pragma unroll
  for (int j = 0; j < 8; ++j) {
    const int idx = lane + 64 * j, row = idx >> 4, c16 = idx & 15;
    const u32x4 v = *(const u32x4*)(wsm + row * 272 + c16 * 16);
    *(u32x4*)addr(row, c16) = v;
  }
}

DI void phase_qkv(const Params& p, char* smem) {
  const int G = lgdim();
  const u16* proj = (const u16*)(p.ws + OFF_PROJ);
  const float2* rope = (const float2*)(p.ws + OFF_ROPE);
  u16* Qm = (u16*)(p.ws + OFF_QM); u16* Km = (u16*)(p.ws + OFF_KM); u16* Vm = (u16*)(p.ws + OFF_VM);
  u16* Qd = (u16*)(p.ws + OFF_QD); u16* Kd = (u16*)(p.ws + OFF_KD);
  const float QS = 0.07216878364870322f * LOG2E;
  xcd_tiles(p.ws, 1, 3, [&](int tt, int ft2) __attribute__((always_inline)) {
    const float* qg = p.in[10];
    gemm_tile<384, true>((const u16*)(p.ws + OFF_WQ), 768, ft2 * 256, proj, NPROJ, (size_t)tt * 256, smem,
      [&](f32x16 (&acc)[4], float ss, int t, int h, int wf, char* wbase, int tg) __attribute__((always_inline)) {
        const int ft = ft2 * 2 + wf;
        const float rinv = rsqrtf(ss * (1.f / 384.f) + EPS);
        const int lane = ltid() & 63, tg0 = t & ~31, b = tg0 >> 12, s0 = tg0 & 4095, s = t & 4095;
        char* wsm = wbase + tg * 8704;
        if (ft < 4) {
          float s2 = 0.f;
#pragma unroll
          for (int c = 0; c < 4; ++c)
#pragma unroll
            for (int k = 0; k < 16; ++k) { float v = acc[c][k] * rinv; s2 += v * v; }
          s2 = xsum32(s2);
          const float r2 = rsqrtf(s2 * (1.f / 128.f) + EPS) * rinv * QS;
#pragma unroll
          for (int c = 0; c < 4; ++c)
#pragma unroll
            for (int gq = 0; gq < 4; ++gq) {
              const int d = 32 * c + 8 * gq + 4 * h;
              float4 gg = *(const float4*)(qg + d);
              acc[c][4 * gq] *= r2 * gg.x; acc[c][4 * gq + 1] *= r2 * gg.y;
              acc[c][4 * gq + 2] *= r2 * gg.z; acc[c][4 * gq + 3] *= r2 * gg.w;
            }
          u16* base = Qm + ((size_t)(b * 4 + ft) * S_ + s0) * 192;
          store_rows_bf16_lds(acc, wsm, lane, [&](int row, int c16) __attribute__((always_inline)) { return base + (size_t)row * 192 + c16 * 8; });
        } else {
#pragma unroll
          for (int cp = 0; cp < 2; ++cp) {
            float s2 = 0.f;
#pragma unroll
            for (int k = 0; k < 16; ++k) {
              float v1 = acc[2 * cp][k] * rinv, v2 = acc[2 * cp + 1][k] * rinv;
              s2 += v1 * v1 + v2 * v2;
            }
            s2 = xsum32(s2);
            const float r2 = rsqrtf(s2 * (1.f / 64.f) + EPS) * rinv;
#pragma unroll
            for (int gq = 0; gq < 4; ++gq) {
              const int j = 8 * gq + 4 * h;
              float4 g1 = *(const float4*)(qg + 128 + j), g2 = *(const float4*)(qg + 160 + j);
              const float4* rp = (const float4*)(rope + s * 32 + j);
              float4 cs01 = rp[0], cs23 = rp[1];
              float x1, x2;
              x1 = acc[2 * cp][4 * gq + 0] * r2 * g1.x; x2 = acc[2 * cp + 1][4 * gq + 0] * r2 * g2.x;
              acc[2 * cp][4 * gq + 0] = (x1 * cs01.x - x2 * cs01.y) * QS; acc[2 * cp + 1][4 * gq + 0] = (x2 * cs01.x + x1 * cs01.y) * QS;
              x1 = acc[2 * cp][4 * gq + 1] * r2 * g1.y; x2 = acc[2 * cp + 1][4 * gq + 1] * r2 * g2.y;
              acc[2 * cp][4 * gq + 1] = (x1 * cs01.z - x2 * cs01.w) * QS; acc[2 * cp + 1][4 * gq + 1] = (x2 * cs01.z + x1 * cs01.w) * QS;
              x1 = acc[2 * cp][4 * gq + 2] * r2 * g1.z; x2 = acc[2 * cp + 1][4 * gq + 2] * r2 * g2.z;
              acc[2 * cp][4 * gq + 2] = (x1 * cs23.x - x2 * cs23.y) * QS; acc[2 * cp + 1][4 * gq + 2] = (x2 * cs23.x + x1 * cs23.y) * QS;
              x1 = acc[2 * cp][4 * gq + 3] * r2 * g1.w; x2 = acc[2 * cp + 1][4 * gq + 3] * r2 * g2.w;
              acc[2 * cp][4 * gq + 3] = (x1 * cs23.z - x2 * cs23.w) * QS; acc[2 * cp + 1][4 * gq + 3] = (x2 * cs23.z + x1 * cs23.w) * QS;
            }
          }
          u16* base = Qm + ((size_t)(b * 4 + (ft - 4) * 2) * S_ + s0) * 192 + 128;
          store_rows_bf16_lds(acc, wsm, lane, [&](int row, int c16) __attribute__((always_inline)) {
            return base + (size_t)(c16 >> 3) * S_ * 192 + (size_t)row * 192 + (c16 & 7) * 8; });
        }
      });
  });
  xcd_tiles(p.ws, 2, 4, [&](int tt, int ft2) __attribute__((always_inline)) {
    const float* kg = p.in[11];
    gemm_tile<256, true>((const u16*)(p.ws + OFF_WKV), 1024, ft2 * 256, proj + 384, NPROJ, (size_t)tt * 256, smem,
      [&](f32x16 (&acc)[4], float ss, int t, int h, int wf, char* wbase, int tg) __attribute__((always_inline)) {
        const int ft = ft2 * 2 + wf;
        const float rinv = rsqrtf(ss * (1.f / 256.f) + EPS);
        const int lane = ltid() & 63, tg0 = t & ~31, b = tg0 >> 12, s0 = tg0 & 4095;
        char* wsm = wbase + tg * 8704;
        if (ft < 4) {
          float s2 = 0.f;
#pragma unroll
          for (int c = 0; c < 4; ++c)
#pragma unroll
            for (int k = 0; k < 16; ++k) { float v = acc[c][k] * rinv; s2 += v * v; }
          s2 = xsum32(s2);
          const float r2 = rsqrtf(s2 * (1.f / 128.f) + EPS) * rinv;
#pragma unroll
          for (int c = 0; c < 4; ++c)
#pragma unroll
            for (int gq = 0; gq < 4; ++gq) {
              const int d = 32 * c + 8 * gq + 4 * h;
              float4 gg = *(const float4*)(kg + d);
              acc[c][4 * gq] *= r2 * gg.x; acc[c][4 * gq + 1] *= r2 * gg.y;
              acc[c][4 * gq + 2] *= r2 * gg.z; acc[c][4 * gq + 3] *= r2 * gg.w;
            }
          u16* base = Km + ((size_t)(b * 4 + ft) * S_ + s0) * 192;
          store_rows_bf16_lds(acc, wsm, lane, [&](int row, int c16) __attribute__((always_inline)) { return base + (size_t)row * 192 + c16 * 8; });
        } else {
#pragma unroll
          for (int c = 0; c < 4; ++c)
#pragma unroll
            for (int k = 0; k < 16; ++k) acc[c][k] *= rinv;
          u16* base = Vm + ((size_t)(b * 4 + (ft - 4)) * S_ + s0) * 128;
          store_rows_bf16_lds(acc, wsm, lane, [&](int row, int c16) __attribute__((always_inline)) { return base + (size_t)row * 128 + c16 * 8; });
        }
      });
  });
  {
    const size_t gt = (size_t)lbid() * 512 + ltid(), NT = (size_t)G * 512;
    for (size_t e = gt; e < (size_t)T_ * 17; e += NT) {
      const int t = (int)(e / 17), gi = (int)(e % 17);
      const int b = t >> 12, s = t & 4095;
      const u16* src; const float* gain; float scale; u16* dst; int ncopy = 1; size_t cstride = 0;
      if (gi == 0) {
        src = proj + (size_t)t * NPROJ + 640; gain = p.in[11] + 128; scale = 1.f;
        dst = Km + ((size_t)(b * 4) * S_ + s) * 192 + 128; ncopy = 4; cstride = (size_t)S_ * 192;
      } else if (gi < 9) {
        const int j = gi - 1;
        src = proj + (size_t)t * NPROJ + 704 + j * 64; gain = p.in[12]; scale = 0.125f * LOG2E;
        dst = Qd + ((size_t)(b * 8 + j) * S_ + s) * 64;
      } else {
        const int j = gi - 9;
        src = proj + (size_t)t * NPROJ + 1216 + j * 64; gain = p.in[13]; scale = 1.f;
        dst = Kd + ((size_t)(b * 8 + j) * S_ + s) * 64;
      }
      uint4 raw[8];
#pragma unroll
      for (int q = 0; q < 8; ++q) raw[q] = ((const uint4*)src)[q];
      float ss = 0.f;
#pragma unroll
      for (int q = 0; q < 8; ++q) {
        ss = dot2bf(raw[q].x, raw[q].x, ss); ss = dot2bf(raw[q].y, raw[q].y, ss);
        ss = dot2bf(raw[q].z, raw[q].z, ss); ss = dot2bf(raw[q].w, raw[q].w, ss);
      }
      const float rinv = rsqrtf(ss * (1.f / 64.f) + EPS);
      const float rs = rinv * scale;
#pragma unroll
      for (int q = 0; q < 4; ++q) {
        const unsigned lo[4] = {raw[q].x, raw[q].y, raw[q].z, raw[q].w};
        const unsigned hi[4] = {raw[q + 4].x, raw[q + 4].y, raw[q + 4].z, raw[q + 4].w};
        unsigned o1[4], o2[4];
#pragma unroll
        for (int e2 = 0; e2 < 4; ++e2) {
          const int k = 8 * q + 2 * e2;
          const float4 cs = *(const float4*)(rope + s * 32 + k);
          const float2 ga = *(const float2*)(gain + k), gb = *(const float2*)(gain + 32 + k);
          float x1a = bflo(lo[e2]) * rs * ga.x, x2a = bflo(hi[e2]) * rs * gb.x;
          float x1b = bfhi(lo[e2]) * rs * ga.y, x2b = bfhi(hi[e2]) * rs * gb.y;
          o1[e2] = pk2(x1a * cs.x - x2a * cs.y, x1b * cs.z - x2b * cs.w);
          o2[e2] = pk2(x2a * cs.x + x1a * cs.y, x2b * cs.z + x1b * cs.w);
        }
        uint4 v1 = make_uint4(o1[0], o1[1], o1[2], o1[3]), v2 = make_uint4(o2[0], o2[1], o2[2], o2[3]);
        for (int cpy = 0; cpy < ncopy; ++cpy) {
          ((uint4*)(dst + cpy * cstride))[q] = v1;
          ((uint4*)(dst + cpy * cstride))[q + 4] = v2;
        }
      }
    }
  }
}

template <int NS, int RSK, bool QLDS>
DI void qk_softmax32(const char* kbuf, const bf16x8 (&qf)[NS], const char* qlds, bool needmask, int keybase, int qrow, int h, int r,
                     float& mrun, float& lrun, f32x16 (&O)[4], bf16x8& pf0, bf16x8& pf1) {
  f32x16 sacc;
#pragma unroll
  for (int i = 0; i < 16; ++i) sacc[i] = 0.f;
#pragma unroll
  for (int s = 0; s < NS; ++s) {
    bf16x8 a = *(const bf16x8*)(kbuf + r * RSK + (16 * s + 8 * h) * 2);
    bf16x8 bq;
    if (QLDS) bq = *(const bf16x8*)(qlds + (16 * s + 8 * h) * 2); else bq = qf[s];
    sacc = MFMA(a, bq, sacc);
  }
  if (needmask) {
#pragma unroll
    for (int i = 0; i < 16; ++i) {
      const int key = keybase + 8 * (i >> 2) + 4 * h + (i & 3);
      if (key > qrow) sacc[i] = NEG_INF;
    }
  }
  float mx = sacc[0];
#pragma unroll
  for (int i = 1; i < 16; ++i) mx = fmaxf(mx, sacc[i]);
  mx = xmax32(mx);
  if (__builtin_amdgcn_ballot_w64(mx > mrun + 8.f) != 0ull) {
    const float mnew = fmaxf(mrun, mx);
    const float alpha = __builtin_amdgcn_exp2f(mrun - mnew);
    mrun = mnew;
    lrun *= alpha;
#pragma unroll
    for (int c = 0; c < 4; ++c)
#pragma unroll
      for (int i = 0; i < 16; ++i) O[c][i] *= alpha;
  }
  float rs = 0.f;
#pragma unroll
  for (int i = 0; i < 16; ++i) {
    float pv = __builtin_amdgcn_exp2f(sacc[i] - mrun);
    rs += pv; sacc[i] = pv;
  }
  lrun += rs;
  uint4 pa, pb;
  pa.x = pk2(sacc[0], sacc[1]); pa.y = pk2(sacc[2], sacc[3]); pa.z = pk2(sacc[4], sacc[5]); pa.w = pk2(sacc[6], sacc[7]);
  pb.x = pk2(sacc[8], sacc[9]); pb.y = pk2(sacc[10], sacc[11]); pb.z = pk2(sacc[12], sacc[13]); pb.w = pk2(sacc[14], sacc[15]);
  pf0 = __builtin_bit_cast(bf16x8, pa);
  pf1 = __builtin_bit_cast(bf16x8, pb);
}

template <int DQK, int NMAP>
DI void attn_item(const u16* __restrict__ qb0, const u16* __restrict__ qb1, const u16* __restrict__ kb0,
                  const u16* __restrict__ kb1, const u16* __restrict__ vb, int vstride, int qblk,
                  u16* __restrict__ outp, const float* __restrict__ lamp, const float* __restrict__ subg, char* smem) {
  constexpr int NS = DQK / 16;
  constexpr int RSK = DQK * 2 + 16;
  constexpr int KTILE = 64 * RSK;
  constexpr int VOFF = NMAP * KTILE;
  constexpr int STAGE = VOFF + 64 * 320;
  constexpr int CPR = DQK / 8;
  constexpr int KCH = NMAP * 64 * CPR / 512;
  int tid_ = ltid();
  asm volatile("" : "+v"(tid_));
  const int tid = tid_, lane = tid & 63, w = tid >> 6, h = lane >> 5, r = lane & 31;
  const int blk = (lane >> 4) & 1, q4 = (lane & 15) >> 2, p4 = lane & 3;
  const int q0 = qblk * 256, wrow0 = q0 + 32 * w, qrow = wrow0 + r;
  const int nt = 4 * (qblk + 1);

  constexpr bool QL = (NMAP == 2);
  bf16x8 qfa[NS];
  if (!QL) {
#pragma unroll
    for (int s = 0; s < NS; ++s) qfa[s] = *(const bf16x8*)(qb0 + (size_t)qrow * DQK + 16 * s + 8 * h);
  } else {
#pragma unroll
    for (int s = 0; s < NS; ++s) qfa[s] = bf16x8{0, 0, 0, 0, 0, 0, 0, 0};
#pragma unroll
    for (int i = 0; i < 8; ++i) {
      const int id = tid + 512 * i, mp = id >> 11, rem = id & 2047, row = rem >> 3, c16 = rem & 7;
      *(u32x4*)(smem + 2 * STAGE + mp * 36864 + row * 144 + c16 * 16) =
          *(const u32x4*)((mp ? qb1 : qb0) + (size_t)(q0 + row) * DQK + c16 * 8);
    }
  }
  const char* qla = smem + 2 * STAGE + (32 * w + r) * 144;
  const char* qlb = qla + 36864;
  f32x16 Oa[4], Ob[4];
  float ma = NEG_INF, la = 0.f, mb = NEG_INF, lb = 0.f;
#pragma unroll
  for (int c = 0; c < 4; ++c)
#pragma unroll
    for (int i = 0; i < 16; ++i) { Oa[c][i] = 0.f; if (NMAP == 2) Ob[c][i] = 0.f; }

  u32x4 rk[KCH], rv[2];
  unsigned koff[KCH], voff[2];
#pragma unroll
  for (int i = 0; i < KCH; ++i) {
    const int id = tid + 512 * i;
    if (NMAP == 1) koff[i] = (unsigned)((id / CPR) * DQK + (id % CPR) * 8);
    else koff[i] = (unsigned)((((id & 511) >> 3)) * DQK + (id & 7) * 8);
  }
#pragma unroll
  for (int i = 0; i < 2; ++i) {
    const int id = tid + 512 * i;
    voff[i] = (unsigned)((id >> 4) * vstride + (id & 15) * 8);
  }
  auto gload = [&](int t) __attribute__((always_inline)) {
    const u16* k0t = kb0 + (size_t)t * 64 * DQK;
    const u16* k1t = (NMAP == 2) ? kb1 + (size_t)t * 64 * DQK : k0t;
    const u16* vt = vb + (size_t)t * 64 * vstride;
#pragma unroll
    for (int i = 0; i < KCH; ++i) rk[i] = *(const u32x4*)(((NMAP == 2 && i) ? k1t : k0t) + koff[i]);
#pragma unroll
    for (int i = 0; i < 2; ++i) rv[i] = *(const u32x4*)(vt + voff[i]);
  };
  auto sstore = [&](char* buf) __attribute__((always_inline)) {
#pragma unroll
    for (int i = 0; i < KCH; ++i) {
      const int id = tid + 512 * i;
      if (NMAP == 1) {
        const int row = id / CPR, c16 = id % CPR;
        *(u32x4*)(buf + row * RSK + c16 * 16) = rk[i];
      } else {
        const int rem = id & 511, row = rem >> 3, c16 = rem & 7;
        *(u32x4*)(buf + i * KTILE + row * RSK + c16 * 16) = rk[i];
      }
    }
#pragma unroll
    for (int i = 0; i < 2; ++i) {
      const int id = tid + 512 * i, row = id >> 4, c16 = id & 15;
      *(u32x4*)(buf + VOFF + row * 320 + c16 * 16) = rv[i];
    }
  };

  gload(0);
  sstore(smem);
  gload(1);
  __syncthreads();
  for (int t = 0; t < nt; ++t) {
    char* buf = smem + (t & 1) * STAGE;
    if (t + 1 < nt) {
      sstore(smem + ((t + 1) & 1) * STAGE);
      if (t + 2 < nt) gload(t + 2);
    }
    const int key0 = t * 64;
#pragma unroll
    for (int sub = 0; sub < 2; ++sub) {
      const int ko = sub * 32;
      if (key0 + ko <= wrow0 + 31) {
        const bool needmask = (key0 + ko + 31 > wrow0);
        bf16x8 pa0, pa1, pb0, pb1;
        qk_softmax32<NS, RSK, QL>(buf + ko * RSK, qfa, qla, needmask, key0 + ko, qrow, h, r, ma, la, Oa, pa0, pa1);
        if (NMAP == 2)
          qk_softmax32<NS, RSK, QL>(buf + KTILE + ko * RSK, qfa, qlb, needmask, key0 + ko, qrow, h, r, mb, lb, Ob, pb0, pb1);
#pragma unroll
        for (int ks = 0; ks < 2; ++ks)
#pragma unroll
          for (int c = 0; c < 4; ++c) {
            const char* ap = buf + VOFF + (ko + 16 * ks + 4 * h + q4) * 320 + (32 * c + 16 * blk) * 2 + 8 * p4;
            s16x4 lo = trread(ap), hi = trread(ap + 8 * 320);
            bf16x8 a = __builtin_shufflevector(lo, hi, 0, 1, 2, 3, 4, 5, 6, 7);
            Oa[c] = MFMA(a, ks ? pa1 : pa0, Oa[c]);
            if (NMAP == 2) Ob[c] = MFMA(a, ks ? pb1 : pb0, Ob[c]);
          }
      }
    }
    __syncthreads();
  }
  const float inva = 1.f / xsum32(la);
  if (NMAP == 1) {
#pragma unroll
    for (int c = 0; c < 4; ++c)
#pragma unroll
      for (int i = 0; i < 16; ++i) Oa[c][i] *= inva;
  } else {
    const float li = *lamp / xsum32(lb);
    float s2 = 0.f;
#pragma unroll
    for (int c = 0; c < 4; ++c)
#pragma unroll
      for (int i = 0; i < 16; ++i) {
        float v = Oa[c][i] * inva - li * Ob[c][i];
        Oa[c][i] = v; s2 += v * v;
      }
    s2 = xsum32(s2);
    const float rn = rsqrtf(s2 * (1.f / 128.f) + EPS) * 0.8f;
#pragma unroll
    for (int c = 0; c < 4; ++c)
#pragma unroll
      for (int gq = 0; gq < 4; ++gq) {
        const int d = 32 * c + 8 * gq + 4 * h;
        asm volatile("" ::: "memory");
        float4 gg = *(const float4*)(subg + d);
        Oa[c][4 * gq] *= rn * gg.x; Oa[c][4 * gq + 1] *= rn * gg.y; Oa[c][4 * gq + 2] *= rn * gg.z; Oa[c][4 * gq + 3] *= rn * gg.w;
      }
  }
  {
    u16* base = outp + (size_t)wrow0 * LDH;
    store_rows_bf16_lds(Oa, smem + w * 8704, lane, [&](int row, int c16) __attribute__((always_inline)) { return base + (size_t)row * LDH + c16 * 8; });
  }
  __syncthreads();
}

DI void conv_table_slice(const float* __restrict__ src, uint2* __restrict__ dst, float scale, int slice, int nslices) {
  const size_t groups = (size_t)16384 * 1024 / 16;
  const size_t gt = (size_t)lbid() * 512 + ltid(), NT = (size_t)lgdim() * 512;
  const size_t lo = groups * slice / nslices, hi = groups * (slice + 1) / nslices;
  for (size_t i = lo + gt; i < hi; i += NT) {
    const float4* sp = (const float4*)src + 4 * i;
    float4 a0 = sp[0], a1 = sp[1], a2 = sp[2], a3 = sp[3];
    unsigned w0 = 0, w1 = 0;
    w0 = __builtin_amdgcn_cvt_scalef32_pk_fp4_f32(w0, a0.x * scale, a0.y * scale, 1.0f, 0);
    w0 = __builtin_amdgcn_cvt_scalef32_pk_fp4_f32(w0, a0.z * scale, a0.w * scale, 1.0f, 1);
    w0 = __builtin_amdgcn_cvt_scalef32_pk_fp4_f32(w0, a1.x * scale, a1.y * scale, 1.0f, 2);
    w0 = __builtin_amdgcn_cvt_scalef32_pk_fp4_f32(w0, a1.z * scale, a1.w * scale, 1.0f, 3);
    w1 = __builtin_amdgcn_cvt_scalef32_pk_fp4_f32(w1, a2.x * scale, a2.y * scale, 1.0f, 0);
    w1 = __builtin_amdgcn_cvt_scalef32_pk_fp4_f32(w1, a2.z * scale, a2.w * scale, 1.0f, 1);
    w1 = __builtin_amdgcn_cvt_scalef32_pk_fp4_f32(w1, a3.x * scale, a3.y * scale, 1.0f, 2);
    w1 = __builtin_amdgcn_cvt_scalef32_pk_fp4_f32(w1, a3.z * scale, a3.w * scale, 1.0f, 3);
    dst[i] = make_uint2(w0, w1);
  }
}

DI void phase_attn(const Params& p, char* smem) {
  const int G = lgdim(), g = lbid();
  const u16* Qm = (const u16*)(p.ws + OFF_QM); const u16* Km = (const u16*)(p.ws + OFF_KM);
  const u16* Vm = (const u16*)(p.ws + OFF_VM); const u16* Qd = (const u16*)(p.ws + OFF_QD);
  const u16* Kd = (const u16*)(p.ws + OFF_KD); const u16* proj = (const u16*)(p.ws + OFF_PROJ);
  u16* mixed = (u16*)(p.ws + OFF_H);
  const float* lamp = (const float*)(p.ws + OFF_LAM);
  const int nrounds = (2048 + G - 1) / G;
  for (int k = 0; k * G < 2048; ++k) {
    conv_table_slice(p.in[23], (uint2*)(p.ws + OFF_U), U_SCALE, k, nrounds);
    conv_table_slice(p.in[24], (uint2*)(p.ws + OFF_V), V_SCALE, k, nrounds);
    const int idx = (k & 1) ? k * G + (G - 1 - g) : k * G + g;
    if (idx >= 2048) continue;
    const int level = idx >> 7, qblk = 15 - level, j = idx & 127, type = j & 1, bh = j >> 1;
    const int b = bh >> 2, hd = bh & 3;
    if (type == 0) {
      const size_t ho = (size_t)(b * 4 + hd) * S_;
      attn_item<192, 1>(Qm + ho * 192, nullptr, Km + ho * 192, nullptr, Vm + ho * 128, 128, qblk,
                        mixed + (size_t)b * S_ * LDH + hd * 128, lamp, nullptr, smem);
    } else {
      const size_t h0 = (size_t)(b * 8 + 2 * hd) * S_ * 64, h1 = h0 + (size_t)S_ * 64;
      attn_item<64, 2>(Qd + h0, Qd + h1, Kd + h0, Kd + h1, proj + (size_t)b * S_ * NPROJ + 1728 + hd * 128, NPROJ,
                       qblk, mixed + (size_t)b * S_ * LDH + 512 + hd * 128, lamp, p.in[18], smem);
    }
  }
}

template <int ST>
DI void ins1(float (&T)[16], float s) {
#pragma unroll
  for (int j = 15; j > ST; --j) T[j] = __builtin_amdgcn_fmed3f(T[j - 1], s, T[j]);
  T[ST] = fmaxf(T[ST], s);
}
DI void peer_scores_top16(const char* sk, const u16* __restrict__ pqrow, int lane, float (&T)[16]) {
  const int h = lane >> 5, r = lane & 31;
  bf16x8 bq[8];
#pragma unroll
  for (int s = 0; s < 8; ++s) bq[s] = *(const bf16x8*)(pqrow + 16 * s + 8 * h);
#pragma unroll
  for (int j = 0; j < 16; ++j) T[j] = NEG_INF;
#pragma unroll
  for (int c = 0; c < 4; ++c) {
    f32x16 acc;
#pragma unroll
    for (int i = 0; i < 16; ++i) acc[i] = 0.f;
#pragma unroll
    for (int s = 0; s < 8; ++s) {
      bf16x8 a = *(const bf16x8*)(sk + (32 * c + r) * 272 + (16 * s + 8 * h) * 2);
      acc = MFMA(a, bq[s], acc);
    }
#pragma unroll
    for (int i = 0; i < 16; ++i) {
      const unsigned code = (unsigned)(127 - 32 * c - (i & 3) - 8 * (i >> 2)) - 4u * (unsigned)h;
      ins1<0>(T, __uint_as_float((__float_as_uint(acc[i]) & 0xffffff80u) | code));
    }
  }
  float o[16];
#pragma unroll
  for (int j = 0; j < 16; ++j) {
    auto rr = __builtin_amdgcn_permlane32_swap(__float_as_uint(T[j]), __float_as_uint(T[j]), false, false);
    o[j] = __uint_as_float(h ? rr[0] : rr[1]);
  }
  ins1<0>(T, o[0]); ins1<1>(T, o[1]); ins1<2>(T, o[2]); ins1<3>(T, o[3]);
  ins1<4>(T, o[4]); ins1<5>(T, o[5]); ins1<6>(T, o[6]); ins1<7>(T, o[7]);
  ins1<8>(T, o[8]); ins1<9>(T, o[9]); ins1<10>(T, o[10]); ins1<11>(T, o[11]);
  ins1<12>(T, o[12]); ins1<13>(T, o[13]); ins1<14>(T, o[14]); ins1<15>(T, o[15]);
}

DI float gelu_exact(float x) { return 0.5f * x * (1.f + erff(x * 0.7071067811865476f)); }

DI void load_sk(char* smem, const u16* SK, int hp, int tid) {
#pragma unroll
  for (int i = 0; i < 4; ++i) {
    const int id = tid + 512 * i, row = id >> 4, c16 = id & 15;
    *(u32x4*)(smem + row * 272 + c16 * 16) = *(const u32x4*)(SK + (size_t)hp * 16384 + row * 128 + c16 * 8);
  }
}

DI void peer_route(const Params& p, char* smem, int t0) {
  const int tid = ltid(), lane = tid & 63, w = tid >> 6, h = lane >> 5, r = lane & 31;
  const u16* pq = (const u16*)(p.ws + OFF_PROJ);
  const u16* SK = (const u16*)(p.ws + OFF_SK);
  uint2* topk = (uint2*)(p.ws + OFF_TOPK);
    const int tq = t0 + 32 * w + r;
#pragma unroll 1
    for (int hd = 0; hd < 8; ++hd) {
      float TA[16], TB[16];
      __syncthreads();
      load_sk(smem, SK, hd * 2, tid);
      __syncthreads();
      peer_scores_top16(smem, pq + (size_t)tq * 2048 + (hd * 2) * 128, lane, TA);
      __syncthreads();
      load_sk(smem, SK, hd * 2 + 1, tid);
      __syncthreads();
      peer_scores_top16(smem, pq + (size_t)tq * 2048 + (hd * 2 + 1) * 128, lane, TB);
      float FK[16];
#pragma unroll
      for (int j = 0; j < 16; ++j) FK[j] = NEG_INF;
#pragma unroll
      for (int i = 0; i < 16; ++i)
#pragma unroll
        for (int j = 0; j < 16; ++j)
          if ((i + 1) * (j + 1) <= 16) {
            const float cv = __uint_as_float(__float_as_uint(TA[i]) & 0xffffff80u) + __uint_as_float(__float_as_uint(TB[j]) & 0xffffff80u);
            const float key = __uint_as_float((__float_as_uint(cv) & 0xffffff00u) | (unsigned)(255 - (16 * i + j)));
            const int st = (i + 1) * (j + 1) - 1;
#pragma unroll
            for (int q = 15; q >= 1; --q)
              if (q > st) FK[q] = __builtin_amdgcn_fmed3f(FK[q - 1], key, FK[q]);
            FK[st] = fmaxf(FK[st], key);
          }
      float FV[16]; int FI[16];
#pragma unroll
      for (int m = 0; m < 16; ++m) {
        const unsigned kb = __float_as_uint(FK[m]);
        const int code = 255 - (int)(kb & 255u), ci = code >> 4, cj = code & 15;
        FV[m] = __uint_as_float(kb & 0xffffff00u);
        float ra = TA[0], rb = TB[0];
#pragma unroll
        for (int q = 1; q < 16; ++q) { ra = (ci == q) ? TA[q] : ra; rb = (cj == q) ? TB[q] : rb; }
        FI[m] = (127 - (int)(__float_as_uint(ra) & 127u)) * 128 + (127 - (int)(__float_as_uint(rb) & 127u));
      }
      float e[16], sum = 0.f;
#pragma unroll
      for (int j = 0; j < 16; ++j) { e[j] = expf(FV[j] - FV[0]); sum += e[j]; }
      const float rs = 1.f / sum;
      if (h == 0) {
        u32x4* dst = (u32x4*)(topk + (size_t)tq * 128 + hd * 16);
#pragma unroll
        for (int q = 0; q < 8; ++q) {
          u32x4 o;
          o.x = (unsigned)FI[2 * q]; o.y = __float_as_uint(e[2 * q] * rs);
          o.z = (unsigned)FI[2 * q + 1]; o.w = __float_as_uint(e[2 * q + 1] * rs);
          dst[q] = o;
        }
      }
    }
}

DI void peer_gather(const Params& p, int t0) {
  const int tid = ltid(), lane = tid & 63, w = tid >> 6;
  const uint2* topk = (const uint2*)(p.ws + OFF_TOPK);
  const float* mod = (const float*)(p.ws + OFF_MOD);
  const unsigned char* U8 = (const unsigned char*)(p.ws + OFF_U);
  const unsigned char* V8 = (const unsigned char*)(p.ws + OFF_V);
#pragma unroll 1
  for (int ti = 0; ti < 32; ++ti) {
    const int t = t0 + 32 * w + ti, b = t >> 12;
    const float* mb = mod + b * 6144;
    float* orow = p.out + (size_t)t * 1024 + lane * 16;
    f32x2 xr[8];
#pragma unroll
    for (int q = 0; q < 4; ++q) {
      float4 a = ((const float4*)orow)[q];
      xr[2 * q] = f32x2{a.x, a.y}; xr[2 * q + 1] = f32x2{a.z, a.w};
    }
    float ss = 0.f;
#pragma unroll
    for (int i = 0; i < 8; ++i) ss += xr[i].x * xr[i].x + xr[i].y * xr[i].y;
    ss = wave_sum(ss);
    const float rinv = rsqrtf(ss * (1.f / 1024.f) + EPS);
    f32x2 hf[8];
#pragma unroll
    for (int q = 0; q < 4; ++q) {
      const int d0 = lane * 16 + 4 * q;
      float4 gg = *(const float4*)(p.in[20] + d0);
      float4 sc = *(const float4*)(mb + 4096 + d0);
      float4 sh = *(const float4*)(mb + 3072 + d0);
      hf[2 * q] = f32x2{xr[2 * q].x * rinv * gg.x * (1.f + sc.x) + sh.x, xr[2 * q].y * rinv * gg.y * (1.f + sc.y) + sh.y};
      hf[2 * q + 1] = f32x2{xr[2 * q + 1].x * rinv * gg.z * (1.f + sc.z) + sh.z, xr[2 * q + 1].y * rinv * gg.w * (1.f + sc.w) + sh.w};
    }
    const u32x4 tk = *(const u32x4*)(topk + (size_t)t * 128 + lane * 2);
    f32x2 y[8];
#pragma unroll
    for (int i = 0; i < 8; ++i) y[i] = f32x2{0.f, 0.f};
    uint2 ua[16], va[16], ub[16], vb[16];
    float gA, gB;
    auto issue = [&](int jj, uint2 (&uu)[16], uint2 (&vv)[16], float& gsel) __attribute__((always_inline)) {
      float gs = 0.f;
#pragma unroll
      for (int k = 0; k < 16; ++k) {
        const int l = 8 * jj + (k >> 1);
        const int e = __builtin_amdgcn_readlane((int)((k & 1) ? tk.z : tk.x), l);
        const float g = __uint_as_float(__builtin_amdgcn_readlane((int)((k & 1) ? tk.w : tk.y), l));
        gs = ((lane >> 2) == k) ? g : gs;
        uu[k] = *(const uint2*)(U8 + (size_t)e * 512 + lane * 8);
        vv[k] = *(const uint2*)(V8 + (size_t)e * 512 + lane * 8);
      }
      gsel = gs;
    };
    auto process = [&](const uint2 (&uu)[16], const uint2 (&vv)[16], float gsel) __attribute__((always_inline)) {
      float d[16];
#pragma unroll
      for (int k = 0; k < 16; ++k) {
        f32x2 a2 = f32x2{0.f, 0.f};
        a2 = __builtin_amdgcn_cvt_scalef32_pk_f32_fp4(uu[k].x, 1.0f, 0) * hf[0] + a2;
        a2 = __builtin_amdgcn_cvt_scalef32_pk_f32_fp4(uu[k].x, 1.0f, 1) * hf[1] + a2;
        a2 = __builtin_amdgcn_cvt_scalef32_pk_f32_fp4(uu[k].x, 1.0f, 2) * hf[2] + a2;
        a2 = __builtin_amdgcn_cvt_scalef32_pk_f32_fp4(uu[k].x, 1.0f, 3) * hf[3] + a2;
        a2 = __builtin_amdgcn_cvt_scalef32_pk_f32_fp4(uu[k].y, 1.0f, 0) * hf[4] + a2;
        a2 = __builtin_amdgcn_cvt_scalef32_pk_f32_fp4(uu[k].y, 1.0f, 1) * hf[5] + a2;
        a2 = __builtin_amdgcn_cvt_scalef32_pk_f32_fp4(uu[k].y, 1.0f, 2) * hf[6] + a2;
        a2 = __builtin_amdgcn_cvt_scalef32_pk_f32_fp4(uu[k].y, 1.0f, 3) * hf[7] + a2;
        d[k] = a2.x + a2.y;
      }
      const bool h32 = (lane & 32) != 0, h16 = (lane & 16) != 0, h8 = (lane & 8) != 0, h4 = (lane & 4) != 0;
      float r8[8], r4[4], r2[2];
#pragma unroll
      for (int i = 0; i < 8; ++i) r8[i] = swapsum32(d[i], d[8 + i]);
#pragma unroll
      for (int i = 0; i < 4; ++i) r4[i] = swapsum16(r8[i], r8[4 + i]);
#pragma unroll
      for (int i = 0; i < 2; ++i) r2[i] = (h8 ? r4[2 + i] : r4[i]) + dppmov<0x128>(h8 ? r4[i] : r4[2 + i]);
      float kk = (h4 ? r2[1] : r2[0]) + dppmov<0x141>(h4 ? r2[0] : r2[1]);
      kk += dppmov<0x4E>(kk); kk += dppmov<0xB1>(kk);
      const float coefv = gsel * gelu_exact(kk * (1.f / U_SCALE)) * (1.f / V_SCALE);
#pragma unroll
      for (int k = 0; k < 16; ++k) {
        const float cf = __uint_as_float(__builtin_amdgcn_readlane((int)__float_as_uint(coefv), 4 * k));
        const f32x2 cf2 = f32x2{cf, cf};
        y[0] = __builtin_amdgcn_cvt_scalef32_pk_f32_fp4(vv[k].x, 1.0f, 0) * cf2 + y[0];
        y[1] = __builtin_amdgcn_cvt_scalef32_pk_f32_fp4(vv[k].x, 1.0f, 1) * cf2 + y[1];
        y[2] = __builtin_amdgcn_cvt_scalef32_pk_f32_fp4(vv[k].x, 1.0f, 2) * cf2 + y[2];
        y[3] = __builtin_amdgcn_cvt_scalef32_pk_f32_fp4(vv[k].x, 1.0f, 3) * cf2 + y[3];
        y[4] = __builtin_amdgcn_cvt_scalef32_pk_f32_fp4(vv[k].y, 1.0f, 0) * cf2 + y[4];
        y[5] = __builtin_amdgcn_cvt_scalef32_pk_f32_fp4(vv[k].y, 1.0f, 1) * cf2 + y[5];
        y[6] = __builtin_amdgcn_cvt_scalef32_pk_f32_fp4(vv[k].y, 1.0f, 2) * cf2 + y[6];
        y[7] = __builtin_amdgcn_cvt_scalef32_pk_f32_fp4(vv[k].y, 1.0f, 3) * cf2 + y[7];
      }
    };
    issue(0, ua, va, gA);
#pragma unroll 1
    for (int jj = 0; jj < 8; jj += 2) {
      issue(jj + 1, ub, vb, gB);
      __builtin_amdgcn_sched_barrier(0);
      process(ua, va, gA);
      __builtin_amdgcn_sched_barrier(0);
      issue((jj + 2) & 7, ua, va, gA);
      __builtin_amdgcn_sched_barrier(0);
      process(ub, vb, gB);
      __builtin_amdgcn_sched_barrier(0);
    }
#pragma unroll
    for (int q = 0; q < 4; ++q) {
      float4 g2 = *(const float4*)(mb + 5120 + lane * 16 + 4 * q);
      float4 o;
      o.x = xr[2 * q].x + g2.x * y[2 * q].x; o.y = xr[2 * q].y + g2.y * y[2 * q].y;
      o.z = xr[2 * q + 1].x + g2.z * y[2 * q + 1].x; o.w = xr[2 * q + 1].y + g2.w * y[2 * q + 1].y;
      ((float4*)orow)[q] = o;
    }
  }
}

typedef const __attribute__((address_space(4))) Params* KParamsPtr;
__global__ void __launch_bounds__(512) mega(Params p_arg) {
  __shared__ __attribute__((aligned(16))) char smem[151552];
  for (int ph = p_arg.ph_begin; ph < p_arg.ph_end; ++ph) {
    KParamsPtr kp = (KParamsPtr)__builtin_amdgcn_kernarg_segment_ptr();
    asm volatile("" : "+s"(kp));
    Params p;
#pragma unroll
    for (int i = 0; i < 25; ++i) p.in[i] = kp->in[i];
    p.out = kp->out; p.ws = kp->ws; p.ph_begin = 0; p.ph_end = 0;
    const int G = lgdim();
    if (ph == 0) {
      phase0(p, smem);
    } else if (ph == 1) {
      rownorm_phase(p, p.in[0], p.in[4], 0, 1024, (u16*)(p.ws + OFF_H));
    } else if (ph == 2) {
      u16* proj = (u16*)(p.ws + OFF_PROJ);
      xcd_tiles(p.ws, 0, 9, [&](int tt, int ft2) __attribute__((always_inline)) {
        gemm_tile<1024, false>((const u16*)(p.ws + OFF_WIN), NPROJ, ft2 * 256, (const u16*)(p.ws + OFF_H), LDH,
                               (size_t)tt * 256, smem, [&](f32x16 (&acc)[4], float, int t, int h, int wf, char* wbase, int tg) __attribute__((always_inline)) {
                                 store_tile_bf16_lds(acc, wbase + tg * 8704, proj + (size_t)(t & ~31) * NPROJ + ft2 * 256 + wf * 128, NPROJ, ltid() & 63);
                               });
      });
    } else if (ph == 3) {
      phase_qkv(p, smem);
    } else if (ph == 4) {
      phase_attn(p, smem);
    } else if (ph == 5) {
      const float* mod = (const float*)(p.ws + OFF_MOD);
      xcd_tiles(p.ws, 3, 4, [&](int tt, int ft2) __attribute__((always_inline)) {
        gemm_tile<1024, false>((const u16*)(p.ws + OFF_WOUT), 1024, ft2 * 256, (const u16*)(p.ws + OFF_H), LDH,
                               (size_t)tt * 256, smem, [&](f32x16 (&acc)[4], float, int t, int h, int wf, char* wbase, int tg) __attribute__((always_inline)) {
                                 const int ft = ft2 * 2 + wf, lane = ltid() & 63, r = lane & 31;
#pragma unroll
                                 for (int c = 0; c < 4; ++c)
#pragma unroll
                                   for (int gq = 0; gq < 4; ++gq)
                                     *(float4*)(wbase + r * 528 + (32 * c + 8 * gq + 4 * h) * 4) =
                                         make_float4(acc[c][4 * gq], acc[c][4 * gq + 1], acc[c][4 * gq + 2], acc[c][4 * gq + 3]);
                                 const int tg0 = t & ~31, b = tg0 >> 12;
#pragma unroll
                                 for (int j = 0; j < 16; ++j) {
                                   const int idx = lane + 64 * j, row = idx >> 5, c16 = idx & 31;
                                   const float4 a = *(const float4*)(wbase + row * 528 + c16 * 16);
                                   const int n = ft * 128 + c16 * 4;
                                   const size_t off = (size_t)(tg0 + row) * 1024 + n;
                                   const float4 xv = *(const float4*)(p.in[0] + off);
                                   const float4 g1 = *(const float4*)(mod + b * 6144 + 2048 + n);
                                   float4 o;
                                   o.x = xv.x + g1.x * a.x; o.y = xv.y + g1.y * a.y; o.z = xv.z + g1.z * a.z; o.w = xv.w + g1.w * a.w;
                                   *(float4*)(p.out + off) = o;
                                 }
                               });
      });
    } else if (ph == 6) {
      rownorm_phase(p, p.out, p.in[20], 3072, 4096, (u16*)(p.ws + OFF_H2));
    } else if (ph == 7) {
      u16* pq = (u16*)(p.ws + OFF_PROJ);
      xcd_tiles(p.ws, 4, 8, [&](int tt, int ft2) __attribute__((always_inline)) {
        gemm_tile<1024, false>((const u16*)(p.ws + OFF_WPQ), 2048, ft2 * 256, (const u16*)(p.ws + OFF_H2), LDH,
                               (size_t)tt * 256, smem, [&](f32x16 (&acc)[4], float, int t, int h, int wf, char* wbase, int tg) __attribute__((always_inline)) {
                                 store_tile_bf16_lds(acc, wbase + tg * 8704, pq + (size_t)(t & ~31) * 2048 + ft2 * 256 + wf * 128, 2048, ltid() & 63);
                               });
      });
    } else {
      for (int tt = lbid(); tt < 256; tt += G) {
        peer_route(p, smem, tt * 256);
        __threadfence();
        __syncthreads();
        __threadfence();
        peer_gather(p, tt * 256);
      }
    }
#if COOP
    if (ph + 1 < p_arg.ph_end) cg::this_grid().sync();
#endif
  }
}

extern "C" void kernel_launch(void* const* d_in, const int* in_sizes, int n_in, void* d_out, int out_size,
                              void* d_ws, size_t ws_size, hipStream_t stream) {
  static int grid_blocks = 0;
  if (!grid_blocks) {
    int dev = 0, cus = 0, per_cu = 0;
    hipGetDevice(&dev);
    hipDeviceGetAttribute(&cus, hipDeviceAttributeMultiprocessorCount, dev);
    hipOccupancyMaxActiveBlocksPerMultiprocessor(&per_cu, mega, 512, 0);
    if (per_cu < 1) per_cu = 1;
    if (per_cu > 1) per_cu = 1;
    grid_blocks = cus * per_cu;
  }
  Params p{};
  for (int i = 0; i < 25; ++i) p.in[i] = (const float*)d_in[i];
  p.out = (float*)d_out;
  p.ws = (char*)d_ws;
#if COOP
  p.ph_begin = 0; p.ph_end = 9;
  void* args[] = {&p};
  hipError_t e = hipLaunchCooperativeKernel((void*)mega, dim3(grid_blocks), dim3(512), args, 0, stream);
  if (e != hipSuccess) fprintf(stderr, "cooperative launch failed: %s (grid %d)\n", hipGetErrorString(e), grid_blocks);
#else
  for (int ph = 0; ph < 9; ++ph) {
    p.ph_begin = ph; p.ph_end = ph + 1;
    hipLaunchKernelGGL(mega, dim3(grid_blocks), dim3(512), 0, stream, p);
  }
#endif
}
```

```cpp
#include <hip/hip_runtime.h>
#include <hip/hip_cooperative_groups.h>
#include <cstdio>
namespace cg = cooperative_groups;

typedef unsigned short u16;
typedef short bf16x8 __attribute__((ext_vector_type(8)));
typedef short s16x4 __attribute__((ext_vector_type(4)));
typedef float f32x16 __attribute__((ext_vector_type(16)));
typedef __bf16 bf2_t __attribute__((ext_vector_type(2)));
typedef unsigned u32x4 __attribute__((ext_vector_type(4)));
#define DI __device__ __forceinline__
#define LDSP(T, p) ((__attribute__((address_space(3))) T*)(p))
#define MFMA(a, b, c) __builtin_amdgcn_mfma_f32_32x32x16_bf16((a), (b), (c), 0, 0, 0)

#ifndef COOP
#define COOP 1
#endif

constexpr int S_ = 4096, T_ = 65536, NPROJ = 2304;
constexpr int LDH = 1088;
constexpr float EPS = 1e-6f;
constexpr float LOG2E = 1.4426950408889634f;
constexpr float NEG_INF = -__builtin_inff();
constexpr float U_SCALE = 64.f, V_SCALE = 5.656854f;
typedef float f32x2 __attribute__((ext_vector_type(2)));

constexpr size_t OFF_MOD = 0;
constexpr size_t OFF_LAM = 393216;
constexpr size_t OFF_CNT = 397312;
constexpr size_t OFF_ROPE = 524288;
constexpr size_t OFF_WIN = 1572864;
constexpr size_t OFF_WQ = 6291456;
constexpr size_t OFF_WKV = 6881280;
constexpr size_t OFF_WOUT = 7405568;
constexpr size_t OFF_WPQ = 9502720;
constexpr size_t OFF_SK = 13697024;
constexpr size_t OFF_U = 16777216;
constexpr size_t OFF_V = 50331648;
constexpr size_t OFF_H = 83886080;
constexpr size_t OFF_PROJ = 226492416;
constexpr size_t OFF_QM = 528482304;
constexpr size_t OFF_KM = 629145600;
constexpr size_t OFF_VM = 729808896;
constexpr size_t OFF_QD = 796917760;
constexpr size_t OFF_KD = 864026624;
constexpr size_t OFF_H2 = OFF_QM;
constexpr size_t OFF_TOPK = OFF_VM;

struct Params {
  const float* in[25];
  float* out;
  char* ws;
  int ph_begin, ph_end;
};

DI unsigned pk2(float a, float b) {
  bf2_t r; r[0] = (__bf16)a; r[1] = (__bf16)b; return __builtin_bit_cast(unsigned, r);
}
DI float bflo(unsigned u) { return __uint_as_float(u << 16); }
DI float bfhi(unsigned u) { return __uint_as_float(u & 0xffff0000u); }
DI float dot2bf(unsigned a, unsigned b, float c) {
  return __builtin_amdgcn_fdot2_f32_bf16(__builtin_bit_cast(bf2_t, a), __builtin_bit_cast(bf2_t, b), c, false);
}
DI int lbid() { int t = blockIdx.x; asm volatile("" : "+s"(t)); return t; }
DI int lgdim() { int t = gridDim.x; asm volatile("" : "+s"(t)); return t; }
DI int ltid() { int t = threadIdx.x; asm volatile("" : "+v"(t)); return t; }
DI float xsum32(float v) {
  const unsigned u = __float_as_uint(v);
  auto r = __builtin_amdgcn_permlane32_swap(u, u, false, false);
  return __uint_as_float(r[0]) + __uint_as_float(r[1]);
}
DI float xmax32(float v) {
  const unsigned u = __float_as_uint(v);
  auto r = __builtin_amdgcn_permlane32_swap(u, u, false, false);
  return fmaxf(__uint_as_float(r[0]), __uint_as_float(r[1]));
}
DI float swapsum32(float a, float b) {
  auto r = __builtin_amdgcn_permlane32_swap(__float_as_uint(a), __float_as_uint(b), false, false);
  return __uint_as_float(r[0]) + __uint_as_float(r[1]);
}
DI float swapsum16(float a, float b) {
  auto r = __builtin_amdgcn_permlane16_swap(__float_as_uint(a), __float_as_uint(b), false, false);
  return __uint_as_float(r[0]) + __uint_as_float(r[1]);
}
template <int CTRL>
DI float dppmov(float v) {
  return __uint_as_float((unsigned)__builtin_amdgcn_update_dpp(0, (int)__float_as_uint(v), CTRL, 0xF, 0xF, true));
}
DI float wave_sum(float v) {
  v += dppmov<0x128>(v); v += dppmov<0x124>(v); v += dppmov<0x122>(v); v += dppmov<0x121>(v);
  v = swapsum16(v, v);
  return xsum32(v);
}
DI s16x4 trread(const char* p) { return __builtin_amdgcn_ds_read_tr16_b64_v4i16(LDSP(s16x4, p)); }
DI unsigned xcc_id() { return (unsigned)__builtin_amdgcn_s_getreg((3 << 11) | 20) & 0x7u; }
template <class F>
DI void xcd_tiles(char* ws, int set, int nft, F body) {
  __shared__ int sh_item;
  unsigned* cnt = (unsigned*)(ws + OFF_CNT);
  const int x0 = (int)xcc_id();
  const int per = 32 * nft;
  for (int q = 0; q < 8; ++q) {
    const int x = (x0 + q) & 7;
    for (;;) {
      __syncthreads();
      if (threadIdx.x == 0) sh_item = (int)atomicAdd(cnt + (set * 8 + x) * 32, 1u);
      __syncthreads();
      const int it = sh_item;
      if (it >= per) break;
      body(32 * x + it / nft, it % nft);
    }
  }
}

constexpr int G_ARS = 576;
constexpr int G_ASZ = 64 * G_ARS, G_BSZ = 256 * 144, G_STAGE = G_ASZ + G_BSZ;

template <int K, bool SUMSQ, class Epi>
DI void gemm_tile(const u16* __restrict__ W, int ldw, int n0, const u16* __restrict__ X, int ldx, size_t t0,
                  char* smem, Epi epi) {
  constexpr int KT = K / 64;
  const int tid = ltid(), lane = tid & 63, w = tid >> 6, h = lane >> 5, r = lane & 31;
  const int wf = w & 1, wt = w >> 1;
  const int blk = (lane >> 4) & 1, q4 = (lane & 15) >> 2, p4 = lane & 3;
  u32x4 ra[4], rb[4];
  const unsigned aoff = (unsigned)((tid >> 5) * ldw + (tid & 31) * 8), boff = (unsigned)((tid >> 3) * ldx + (tid & 7) * 8);
  const unsigned asoff = (unsigned)((tid >> 5) * G_ARS + (tid & 31) * 16), bsoff = (unsigned)(G_ASZ + (tid >> 3) * 144 + (tid & 7) * 16);
  auto gload = [&](int kt) __attribute__((always_inline)) {
    const u16* wk = W + (size_t)kt * 64 * ldw + n0;
    const u16* xk = X + t0 * (size_t)ldx + kt * 64;
#pragma unroll
    for (int i = 0; i < 4; ++i) ra[i] = *(const u32x4*)(wk + (size_t)i * 16 * ldw + aoff);
#pragma unroll
    for (int i = 0; i < 4; ++i) rb[i] = *(const u32x4*)(xk + (size_t)i * 64 * ldx + boff);
  };
  auto sstore = [&](char* buf) __attribute__((always_inline)) {
#pragma unroll
    for (int i = 0; i < 4; ++i) *(u32x4*)(buf + asoff + i * 16 * G_ARS) = ra[i];
#pragma unroll
    for (int i = 0; i < 4; ++i) *(u32x4*)(buf + bsoff + i * 64 * 144) = rb[i];
  };
  auto stage_step = [&](int s, char* nbuf, int ktl, bool dowrite, bool doload) __attribute__((always_inline)) {
    const u16* wk = W + (size_t)ktl * 64 * ldw + n0;
    const u16* xk = X + t0 * (size_t)ldx + ktl * 64;
    if (s < 2) {
#pragma unroll
      for (int i = 2 * s; i < 2 * s + 2; ++i) {
        if (dowrite) *(u32x4*)(nbuf + asoff + i * 16 * G_ARS) = ra[i];
        if (doload) ra[i] = *(const u32x4*)(wk + (size_t)i * 16 * ldw + aoff);
      }
    } else {
#pragma unroll
      for (int i = 2 * s - 4; i < 2 * s - 2; ++i) {
        if (dowrite) *(u32x4*)(nbuf + bsoff + i * 64 * 144) = rb[i];
        if (doload) rb[i] = *(const u32x4*)(xk + (size_t)i * 64 * ldx + boff);
      }
    }
  };
  f32x16 acc[2][4];
#pragma unroll
  for (int g = 0; g < 2; ++g)
#pragma unroll
    for (int c = 0; c < 4; ++c)
#pragma unroll
      for (int i = 0; i < 16; ++i) acc[g][c][i] = 0.f;
  float ss0 = 0.f, ss1 = 0.f;
  auto compute = [&](const char* buf, char* nbuf, int ktl, bool dowrite, bool doload) __attribute__((always_inline)) {
    u32x4 bfr[2][2];
    s16x4 alo[2][4], ahi[2][4];
    auto lfrag = [&](int s, int slot) __attribute__((always_inline)) {
      bfr[slot][0] = *(const u32x4*)(buf + G_ASZ + (64 * wt + r) * 144 + (16 * s + 8 * h) * 2);
      bfr[slot][1] = *(const u32x4*)(buf + G_ASZ + (64 * wt + 32 + r) * 144 + (16 * s + 8 * h) * 2);
#pragma unroll
      for (int c = 0; c < 4; ++c) {
        const char* ap = buf + (16 * s + 8 * h + q4) * G_ARS + (128 * wf + 32 * c + 16 * blk) * 2 + 8 * p4;
        alo[slot][c] = trread(ap); ahi[slot][c] = trread(ap + 4 * G_ARS);
      }
    };
    lfrag(0, 0);
#pragma unroll
    for (int s = 0; s < 4; ++s) {
      if (s < 3) lfrag(s + 1, (s + 1) & 1);
      __builtin_amdgcn_sched_barrier(0);
      const u32x4 b0r = bfr[s & 1][0], b1r = bfr[s & 1][1];
      if (SUMSQ) {
        ss0 = dot2bf(b0r.x, b0r.x, ss0); ss0 = dot2bf(b0r.y, b0r.y, ss0);
        ss0 = dot2bf(b0r.z, b0r.z, ss0); ss0 = dot2bf(b0r.w, b0r.w, ss0);
        ss1 = dot2bf(b1r.x, b1r.x, ss1); ss1 = dot2bf(b1r.y, b1r.y, ss1);
        ss1 = dot2bf(b1r.z, b1r.z, ss1); ss1 = dot2bf(b1r.w, b1r.w, ss1);
      }
      const bf16x8 b0 = __builtin_bit_cast(bf16x8, b0r), b1 = __builtin_bit_cast(bf16x8, b1r);
#pragma unroll
      for (int c = 0; c < 4; ++c) {
        const bf16x8 a = __builtin_shufflevector(alo[s & 1][c], ahi[s & 1][c], 0, 1, 2, 3, 4, 5, 6, 7);
        acc[0][c] = MFMA(a, b0, acc[0][c]);
        acc[1][c] = MFMA(a, b1, acc[1][c]);
      }
      __builtin_amdgcn_sched_barrier(0);
      stage_step(s, nbuf, ktl, dowrite, doload);
      __builtin_amdgcn_sched_barrier(0);
    }
  };
  gload(0);
  sstore(smem);
  if (KT > 1) gload(1);
  __syncthreads();
  for (int kt = 0; kt < KT; ++kt) {
    char* buf = smem + (kt & 1) * G_STAGE;
    compute(buf, smem + ((kt + 1) & 1) * G_STAGE, kt + 2, kt + 1 < KT, kt + 2 < KT);
    __syncthreads();
  }
  if (SUMSQ) { ss0 = xsum32(ss0); ss1 = xsum32(ss1); }
  epi(acc[0], ss0, (int)t0 + 64 * wt + r, h, wf, smem + w * 17408, 0);
  epi(acc[1], ss1, (int)t0 + 64 * wt + 32 + r, h, wf, smem + w * 17408, 1);
}

DI void phase0(const Params& p, char* smem) {
  const int tid = ltid(), G = lgdim(), g = lbid();
  const size_t gt = (size_t)g * 512 + tid, NT = (size_t)G * 512;
  float* mod = (float*)(p.ws + OFF_MOD);
  for (int item = g; item < 96; item += G) {
    float* sc = (float*)smem;
    float* red = sc + 16384;
    for (int i = tid; i < 16384; i += 512) { float v = p.in[1][i]; sc[i] = v / (1.f + expf(-v)); }
    __syncthreads();
    const int col = tid & 63, kg = tid >> 6, n = item * 64 + col;
    float acc[16];
#pragma unroll
    for (int b = 0; b < 16; ++b) acc[b] = 0.f;
    const float* aw = p.in[2] + (size_t)(kg * 128) * 6144 + n;
#pragma unroll 4
    for (int k = 0; k < 128; ++k) {
      float wv = aw[(size_t)k * 6144];
#pragma unroll
      for (int b = 0; b < 16; ++b) acc[b] += sc[b * 1024 + kg * 128 + k] * wv;
    }
#pragma unroll
    for (int b = 0; b < 16; ++b) red[(kg * 16 + b) * 64 + col] = acc[b];
    __syncthreads();
    for (int o = tid; o < 1024; o += 512) {
      int b = o >> 6, cc = o & 63;
      float s = 0.f;
#pragma unroll
      for (int k2 = 0; k2 < 8; ++k2) s += red[(k2 * 16 + b) * 64 + cc];
      mod[b * 6144 + item * 64 + cc] = s + p.in[3][item * 64 + cc];
    }
    __syncthreads();
  }
  if (g == 0) {
    unsigned* cnt = (unsigned*)(p.ws + OFF_CNT);
    for (int i = tid; i < 8 * 8 * 32; i += 512) cnt[i] = 0u;
  }
  if (g == 0 && tid < 64) {
    float d1 = wave_sum(p.in[14][tid] * p.in[15][tid]);
    float d2 = wave_sum(p.in[16][tid] * p.in[17][tid]);
    if (tid == 0) *(float*)(p.ws + OFF_LAM) = expf(d1) - expf(d2) + 0.2f;
  }
  {
    float2* rope = (float2*)(p.ws + OFF_ROPE);
    for (size_t i = gt; i < 131072; i += NT) {
      int j = (int)(i & 31), sp = (int)(i >> 5);
      float inv = 1.0f / powf(10000.f, (float)j / 32.f);
      float ang = (float)sp * inv, sn, cs;
      sincosf(ang, &sn, &cs);
      rope[i] = make_float2(cs, sn);
    }
  }
  {
    u16* d = (u16*)(p.ws + OFF_WIN);
    for (size_t i = gt; i < (size_t)1024 * 2304; i += NT) {
      int k = (int)(i / 2304), n = (int)(i % 2304);
      float v = (n < 2240) ? p.in[5][(size_t)k * 2240 + n] : 0.f;
      d[i] = (u16)(pk2(v, 0.f) & 0xffff);
    }
  }
  {
    u16* d = (u16*)(p.ws + OFF_WQ);
    for (size_t i = gt; i < (size_t)384 * 768; i += NT) {
      int k = (int)(i / 768), n = (int)(i % 768);
      int src = (n < 512) ? (n >> 7) * 192 + (n & 127) : ((n - 512) >> 6) * 192 + 128 + ((n - 512) & 63);
      float v = p.in[7][(size_t)k * 768 + src] * p.in[6][k];
      d[i] = (u16)(pk2(v, 0.f) & 0xffff);
    }
  }
  {
    u16* d = (u16*)(p.ws + OFF_WKV);
    for (size_t i = gt; i < (size_t)256 * 1024; i += NT) {
      int k = (int)(i >> 10), n = (int)(i & 1023);
      int src = (n < 512) ? (n >> 7) * 256 + (n & 127) : ((n - 512) >> 7) * 256 + 128 + (n & 127);
      float v = p.in[9][(size_t)k * 1024 + src] * p.in[8][k];
      d[i] = (u16)(pk2(v, 0.f) & 0xffff);
    }
  }
  auto conv8 = [&](const float* src, u16* dst, size_t n8) __attribute__((always_inline)) {
    for (size_t i = gt; i < n8; i += NT) {
      float4 a = ((const float4*)src)[2 * i], b = ((const float4*)src)[2 * i + 1];
      uint4 o; o.x = pk2(a.x, a.y); o.y = pk2(a.z, a.w); o.z = pk2(b.x, b.y); o.w = pk2(b.z, b.w);
      ((uint4*)dst)[i] = o;
    }
  };
  conv8(p.in[19], (u16*)(p.ws + OFF_WOUT), (size_t)1024 * 1024 / 8);
  conv8(p.in[21], (u16*)(p.ws + OFF_WPQ), (size_t)1024 * 2048 / 8);
  conv8(p.in[22], (u16*)(p.ws + OFF_SK), (size_t)16 * 128 * 128 / 8);
}

DI void rownorm_phase(const Params& p, const float* src, const float* gain, int sh_off, int sc_off, u16* dst) {
  const int lane = ltid() & 63;
  const int gw = lbid() * 8 + (ltid() >> 6), NW = lgdim() * 8;
  const float* mod = (const float*)(p.ws + OFF_MOD);
  for (int t = gw; t < T_; t += NW) {
    const int b = t >> 12;
    const float* mb = mod + b * 6144;
#pragma unroll
    for (int c = 0; c < 2; ++c) {
    }
    float xv[16];
#pragma unroll
    for (int c = 0; c < 2; ++c) {
      const float4* sp = (const float4*)(src + (size_t)t * 1024 + c * 512 + lane * 8);
      float4 a = sp[0], bq = sp[1];
      xv[c * 8 + 0] = a.x; xv[c * 8 + 1] = a.y; xv[c * 8 + 2] = a.z; xv[c * 8 + 3] = a.w;
      xv[c * 8 + 4] = bq.x; xv[c * 8 + 5] = bq.y; xv[c * 8 + 6] = bq.z; xv[c * 8 + 7] = bq.w;
    }
    float ss = 0.f;
#pragma unroll
    for (int i = 0; i < 16; ++i) ss += xv[i] * xv[i];
    ss = wave_sum(ss);
    const float rinv = rsqrtf(ss * (1.f / 1024.f) + EPS);
#pragma unroll
    for (int c = 0; c < 2; ++c) {
      const int d0 = c * 512 + lane * 8;
      float o[8];
#pragma unroll
      for (int q = 0; q < 2; ++q) {
        float4 gg = *(const float4*)(gain + d0 + 4 * q);
        float4 sc = *(const float4*)(mb + sc_off + d0 + 4 * q);
        float4 sh = *(const float4*)(mb + sh_off + d0 + 4 * q);
        o[4 * q + 0] = xv[c * 8 + 4 * q + 0] * rinv * gg.x * (1.f + sc.x) + sh.x;
        o[4 * q + 1] = xv[c * 8 + 4 * q + 1] * rinv * gg.y * (1.f + sc.y) + sh.y;
        o[4 * q + 2] = xv[c * 8 + 4 * q + 2] * rinv * gg.z * (1.f + sc.z) + sh.z;
        o[4 * q + 3] = xv[c * 8 + 4 * q + 3] * rinv * gg.w * (1.f + sc.w) + sh.w;
      }
      uint4 ov; ov.x = pk2(o[0], o[1]); ov.y = pk2(o[2], o[3]); ov.z = pk2(o[4], o[5]); ov.w = pk2(o[6], o[7]);
      *(uint4*)(dst + (size_t)t * LDH + d0) = ov;
    }
  }
}

DI void store_tile_bf16_lds(f32x16 (&acc)[4], char* wsm, u16* dst0, size_t ld, int lane) {
  const int h = lane >> 5, r = lane & 31;
#pragma unroll
  for (int c = 0; c < 4; ++c)
#pragma unroll
    for (int gq = 0; gq < 4; ++gq) {
      uint2 v; v.x = pk2(acc[c][4 * gq], acc[c][4 * gq + 1]); v.y = pk2(acc[c][4 * gq + 2], acc[c][4 * gq + 3]);
      *(uint2*)(wsm + r * 272 + (32 * c + 8 * gq + 4 * h) * 2) = v;
    }
#pragma unroll
  for (int j = 0; j < 8; ++j) {
    const int idx = lane + 64 * j, row = idx >> 4, c16 = idx & 15;
    const u32x4 v = *(const u32x4*)(wsm + row * 272 + c16 * 16);
    *(u32x4*)(dst0 + (size_t)row * ld + c16 * 8) = v;
  }
}

template <class AddrFn>
DI void store_rows_bf16_lds(f32x16 (&acc)[4], char* wsm, int lane, AddrFn addr) {
  const int h = lane >> 5, r = lane & 31;
#pragma unroll
  for (int c = 0; c < 4; ++c)
#pragma unroll
    for (int gq = 0; gq < 4; ++gq) {
      uint2 v; v.x = pk2(acc[c][4 * gq], acc[c][4 * gq + 1]); v.y = pk2(acc[c][4 * gq + 2], acc[c][4 * gq + 3]);
      *(uint2*)(wsm + r * 272 + (32 * c + 8 * gq + 4 * h) * 2) = v;
    }
#pragma unroll
  for (int j = 0; j < 8; ++j) {
    const int idx = lane + 64 * j, row = idx >> 4, c16 = idx & 15;
    const u32x4 v = *(const u32x4*)(wsm + row * 272 + c16 * 16);
    *(u32x4*)addr(row, c16) = v;
  }
}

DI void phase_qkv(const Params& p, char* smem) {
  const int G = lgdim();
  const u16* proj = (const u16*)(p.ws + OFF_PROJ);
  const float2* rope = (const float2*)(p.ws + OFF_ROPE);
  u16* Qm = (u16*)(p.ws + OFF_QM); u16* Km = (u16*)(p.ws + OFF_KM); u16* Vm = (u16*)(p.ws + OFF_VM);
  u16* Qd = (u16*)(p.ws + OFF_QD); u16* Kd = (u16*)(p.ws + OFF_KD);
  const float QS = 0.07216878364870322f * LOG2E;
  xcd_tiles(p.ws, 1, 3, [&](int tt, int ft2) __attribute__((always_inline)) {
    const float* qg = p.in[10];
    gemm_tile<384, true>((const u16*)(p.ws + OFF_WQ), 768, ft2 * 256, proj, NPROJ, (size_t)tt * 256, smem,
      [&](f32x16 (&acc)[4], float ss, int t, int h, int wf, char* wbase, int tg) __attribute__((always_inline)) {
        const int ft = ft2 * 2 + wf;
        const float rinv = rsqrtf(ss * (1.f / 384.f) + EPS);
        const int lane = ltid() & 63, tg0 = t & ~31, b = tg0 >> 12, s0 = tg0 & 4095, s = t & 4095;
        char* wsm = wbase + tg * 8704;
        if (ft < 4) {
          float s2 = 0.f;
#pragma unroll
          for (int c = 0; c < 4; ++c)
#pragma unroll
            for (int k = 0; k < 16; ++k) { float v = acc[c][k] * rinv; s2 += v * v; }
          s2 = xsum32(s2);
          const float r2 = rsqrtf(s2 * (1.f / 128.f) + EPS) * rinv * QS;
#pragma unroll
          for (int c = 0; c < 4; ++c)
#pragma unroll
            for (int gq = 0; gq < 4; ++gq) {
              const int d = 32 * c + 8 * gq + 4 * h;
              float4 gg = *(const float4*)(qg + d);
              acc[c][4 * gq] *= r2 * gg.x; acc[c][4 * gq + 1] *= r2 * gg.y;
              acc[c][4 * gq + 2] *= r2 * gg.z; acc[c][4 * gq + 3] *= r2 * gg.w;
            }
          u16* base = Qm + ((size_t)(b * 4 + ft) * S_ + s0) * 192;
          store_rows_bf16_lds(acc, wsm, lane, [&](int row, int c16) __attribute__((always_inline)) { return base + (size_t)row * 192 + c16 * 8; });
        } else {
#pragma unroll
          for (int cp = 0; cp < 2; ++cp) {
            float s2 = 0.f;
#pragma unroll
            for (int k = 0; k < 16; ++k) {
              float v1 = acc[2 * cp][k] * rinv, v2 = acc[2 * cp + 1][k] * rinv;
              s2 += v1 * v1 + v2 * v2;
            }
            s2 = xsum32(s2);
            const float r2 = rsqrtf(s2 * (1.f / 64.f) + EPS) * rinv;
#pragma unroll
            for (int gq = 0; gq < 4; ++gq) {
              const int j = 8 * gq + 4 * h;
              float4 g1 = *(const float4*)(qg + 128 + j), g2 = *(const float4*)(qg + 160 + j);
              const float4* rp = (const float4*)(rope + s * 32 + j);
              float4 cs01 = rp[0], cs23 = rp[1];
              float x1, x2;
              x1 = acc[2 * cp][4 * gq + 0] * r2 * g1.x; x2 = acc[2 * cp + 1][4 * gq + 0] * r2 * g2.x;
              acc[2 * cp][4 * gq + 0] = (x1 * cs01.x - x2 * cs01.y) * QS; acc[2 * cp + 1][4 * gq + 0] = (x2 * cs01.x + x1 * cs01.y) * QS;
              x1 = acc[2 * cp][4 * gq + 1] * r2 * g1.y; x2 = acc[2 * cp + 1][4 * gq + 1] * r2 * g2.y;
              acc[2 * cp][4 * gq + 1] = (x1 * cs01.z - x2 * cs01.w) * QS; acc[2 * cp + 1][4 * gq + 1] = (x2 * cs01.z + x1 * cs01.w) * QS;
              x1 = acc[2 * cp][4 * gq + 2] * r2 * g1.z; x2 = acc[2 * cp + 1][4 * gq + 2] * r2 * g2.z;
              acc[2 * cp][4 * gq + 2] = (x1 * cs23.x - x2 * cs23.y) * QS; acc[2 * cp + 1][4 * gq + 2] = (x2 * cs23.x + x1 * cs23.y) * QS;
              x1 = acc[2 * cp][4 * gq + 3] * r2 * g1.w; x2 = acc[2 * cp + 1][4 * gq + 3] * r2 * g2.w;
              acc[2 * cp][4 * gq + 3] = (x1 * cs23.z - x2 * cs23.w) * QS; acc[2 * cp + 1][4 * gq + 3] = (x2 * cs23.z + x1 * cs23.w) * QS;
            }
          }
          u16* base = Qm + ((size_t)(b * 4 + (ft - 4) * 2) * S_ + s0) * 192 + 128;
          store_rows_bf16_lds(acc, wsm, lane, [&](int row, int c16) __attribute__((always_inline)) {
            return base + (size_t)(c16 >> 3) * S_ * 192 + (size_t)row * 192 + (c16 & 7) * 8; });
        }
      });
  });
  xcd_tiles(p.ws, 2, 4, [&](int tt, int ft2) __attribute__((always_inline)) {
    const float* kg = p.in[11];
    gemm_tile<256, true>((const u16*)(p.ws + OFF_WKV), 1024, ft2 * 256, proj + 384, NPROJ, (size_t)tt * 256, smem,
      [&](f32x16 (&acc)[4], float ss, int t, int h, int wf, char* wbase, int tg) __attribute__((always_inline)) {
        const int ft = ft2 * 2 + wf;
        const float rinv = rsqrtf(ss * (1.f / 256.f) + EPS);
        const int lane = ltid() & 63, tg0 = t & ~31, b = tg0 >> 12, s0 = tg0 & 4095;
        char* wsm = wbase + tg * 8704;
        if (ft < 4) {
          float s2 = 0.f;
#pragma unroll
          for (int c = 0; c < 4; ++c)
#pragma unroll
            for (int k = 0; k < 16; ++k) { float v = acc[c][k] * rinv; s2 += v * v; }
          s2 = xsum32(s2);
          const float r2 = rsqrtf(s2 * (1.f / 128.f) + EPS) * rinv;
#pragma unroll
          for (int c = 0; c < 4; ++c)
#pragma unroll
            for (int gq = 0; gq < 4; ++gq) {
              const int d = 32 * c + 8 * gq + 4 * h;
              float4 gg = *(const float4*)(kg + d);
              acc[c][4 * gq] *= r2 * gg.x; acc[c][4 * gq + 1] *= r2 * gg.y;
              acc[c][4 * gq + 2] *= r2 * gg.z; acc[c][4 * gq + 3] *= r2 * gg.w;
            }
          u16* base = Km + ((size_t)(b * 4 + ft) * S_ + s0) * 192;
          store_rows_bf16_lds(acc, wsm, lane, [&](int row, int c16) __attribute__((always_inline)) { return base + (size_t)row * 192 + c16 * 8; });
        } else {
#pragma unroll
          for (int c = 0; c < 4; ++c)
#pragma unroll
            for (int k = 0; k < 16; ++k) acc[c][k] *= rinv;
          u16* base = Vm + ((size_t)(b * 4 + (ft - 4)) * S_ + s0) * 128;
          store_rows_bf16_lds(acc, wsm, lane, [&](int row, int c16) __attribute__((always_inline)) { return base + (size_t)row * 128 + c16 * 8; });
        }
      });
  });
  {
    const size_t gt = (size_t)lbid() * 512 + ltid(), NT = (size_t)G * 512;
    for (size_t e = gt; e < (size_t)T_ * 17; e += NT) {
      const int t = (int)(e / 17), gi = (int)(e % 17);
      const int b = t >> 12, s = t & 4095;
      const u16* src; const float* gain; float scale; u16* dst; int ncopy = 1; size_t cstride = 0;
      if (gi == 0) {
        src = proj + (size_t)t * NPROJ + 640; gain = p.in[11] + 128; scale = 1.f;
        dst = Km + ((size_t)(b * 4) * S_ + s) * 192 + 128; ncopy = 4; cstride = (size_t)S_ * 192;
      } else if (gi < 9) {
        const int j = gi - 1;
        src = proj + (size_t)t * NPROJ + 704 + j * 64; gain = p.in[12]; scale = 0.125f * LOG2E;
        dst = Qd + ((size_t)(b * 8 + j) * S_ + s) * 64;
      } else {
        const int j = gi - 9;
        src = proj + (size_t)t * NPROJ + 1216 + j * 64; gain = p.in[13]; scale = 1.f;
        dst = Kd + ((size_t)(b * 8 + j) * S_ + s) * 64;
      }
      uint4 raw[8];
#pragma unroll
      for (int q = 0; q < 8; ++q) raw[q] = ((const uint4*)src)[q];
      float ss = 0.f;
#pragma unroll
      for (int q = 0; q < 8; ++q) {
        ss = dot2bf(raw[q].x, raw[q].x, ss); ss = dot2bf(raw[q].y, raw[q].y, ss);
        ss = dot2bf(raw[q].z, raw[q].z, ss); ss = dot2bf(raw[q].w, raw[q].w, ss);
      }
      const float rinv = rsqrtf(ss * (1.f / 64.f) + EPS);
      const float rs = rinv * scale;
#pragma unroll
      for (int q = 0; q < 4; ++q) {
        const unsigned lo[4] = {raw[q].x, raw[q].y, raw[q].z, raw[q].w};
        const unsigned hi[4] = {raw[q + 4].x, raw[q + 4].y, raw[q + 4].z, raw[q + 4].w};
        unsigned o1[4], o2[4];
#pragma unroll
        for (int e2 = 0; e2 < 4; ++e2) {
          const int k = 8 * q + 2 * e2;
          const float4 cs = *(const float4*)(rope + s * 32 + k);
          const float2 ga = *(const float2*)(gain + k), gb = *(const float2*)(gain + 32 + k);
          float x1a = bflo(lo[e2]) * rs * ga.x, x2a = bflo(hi[e2]) * rs * gb.x;
          float x1b = bfhi(lo[e2]) * rs * ga.y, x2b = bfhi(hi[e2]) * rs * gb.y;
          o1[e2] = pk2(x1a * cs.x - x2a * cs.y, x1b * cs.z - x2b * cs.w);
          o2[e2] = pk2(x2a * cs.x + x1a * cs.y, x2b * cs.z + x1b * cs.w);
        }
        uint4 v1 = make_uint4(o1[0], o1[1], o1[2], o1[3]), v2 = make_uint4(o2[0], o2[1], o2[2], o2[3]);
        for (int cpy = 0; cpy < ncopy; ++cpy) {
          ((uint4*)(dst + cpy * cstride))[q] = v1;
          ((uint4*)(dst + cpy * cstride))[q + 4] = v2;
        }
      }
    }
  }
}

template <int NS, int RSK, bool QLDS>
DI void qk_softmax32(const char* kbuf, const bf16x8 (&qf)[NS], const char* qlds, bool needmask, int keybase, int qrow, int h, int r,
                     float& mrun, float& lrun, f32x16 (&O)[4], bf16x8& pf0, bf16x8& pf1) {
  f32x16 sacc;
#pragma unroll
  for (int i = 0; i < 16; ++i) sacc[i] = 0.f;
#pragma unroll
  for (int s = 0; s < NS; ++s) {
    bf16x8 a = *(const bf16x8*)(kbuf + r * RSK + (16 * s + 8 * h) * 2);
    bf16x8 bq;
    if (QLDS) bq = *(const bf16x8*)(qlds + (16 * s + 8 * h) * 2); else bq = qf[s];
    sacc = MFMA(a, bq, sacc);
  }
  if (needmask) {
#pragma unroll
    for (int i = 0; i < 16; ++i) {
      const int key = keybase + 8 * (i >> 2) + 4 * h + (i & 3);
      if (key > qrow) sacc[i] = NEG_INF;
    }
  }
  float mx = sacc[0];
#pragma unroll
  for (int i = 1; i < 16; ++i) mx = fmaxf(mx, sacc[i]);
  mx = xmax32(mx);
  if (__builtin_amdgcn_ballot_w64(mx > mrun + 8.f) != 0ull) {
    const float mnew = fmaxf(mrun, mx);
    const float alpha = __builtin_amdgcn_exp2f(mrun - mnew);
    mrun = mnew;
    lrun *= alpha;
#pragma unroll
    for (int c = 0; c < 4; ++c)
#pragma unroll
      for (int i = 0; i < 16; ++i) O[c][i] *= alpha;
  }
  float rs = 0.f;
#pragma unroll
  for (int i = 0; i < 16; ++i) {
    float pv = __builtin_amdgcn_exp2f(sacc[i] - mrun);
    rs += pv; sacc[i] = pv;
  }
  lrun += rs;
  uint4 pa, pb;
  pa.x = pk2(sacc[0], sacc[1]); pa.y = pk2(sacc[2], sacc[3]); pa.z = pk2(sacc[4], sacc[5]); pa.w = pk2(sacc[6], sacc[7]);
  pb.x = pk2(sacc[8], sacc[9]); pb.y = pk2(sacc[10], sacc[11]); pb.z = pk2(sacc[12], sacc[13]); pb.w = pk2(sacc[14], sacc[15]);
  pf0 = __builtin_bit_cast(bf16x8, pa);
  pf1 = __builtin_bit_cast(bf16x8, pb);
}

template <int DQK, int NMAP>
DI void attn_item(const u16* __restrict__ qb0, const u16* __restrict__ qb1, const u16* __restrict__ kb0,
                  const u16* __restrict__ kb1, const u16* __restrict__ vb, int vstride, int qblk,
                  u16* __restrict__ outp, const float* __restrict__ lamp, const float* __restrict__ subg, char* smem) {
  constexpr int NS = DQK / 16;
  constexpr int RSK = DQK * 2 + 16;
  constexpr int KTILE = 64 * RSK;
  constexpr int VOFF = NMAP * KTILE;
  constexpr int STAGE = VOFF + 64 * 320;
  constexpr int CPR = DQK / 8;
  constexpr int KCH = NMAP * 64 * CPR / 512;
  int tid_ = ltid();
  asm volatile("" : "+v"(tid_));
  const int tid = tid_, lane = tid & 63, w = tid >> 6, h = lane >> 5, r = lane & 31;
  const int blk = (lane >> 4) & 1, q4 = (lane & 15) >> 2, p4 = lane & 3;
  const int q0 = qblk * 256, wrow0 = q0 + 32 * w, qrow = wrow0 + r;
  const int nt = 4 * (qblk + 1);

  constexpr bool QL = (NMAP == 2);
  bf16x8 qfa[NS];
  if (!QL) {
#pragma unroll
    for (int s = 0; s < NS; ++s) qfa[s] = *(const bf16x8*)(qb0 + (size_t)qrow * DQK + 16 * s + 8 * h);
  } else {
#pragma unroll
    for (int s = 0; s < NS; ++s) qfa[s] = bf16x8{0, 0, 0, 0, 0, 0, 0, 0};
#pragma unroll
    for (int i = 0; i < 8; ++i) {
      const int id = tid + 512 * i, mp = id >> 11, rem = id & 2047, row = rem >> 3, c16 = rem & 7;
      *(u32x4*)(smem + 2 * STAGE + mp * 36864 + row * 144 + c16 * 16) =
          *(const u32x4*)((mp ? qb1 : qb0) + (size_t)(q0 + row) * DQK + c16 * 8);
    }
  }
  const char* qla = smem + 2 * STAGE + (32 * w + r) * 144;
  const char* qlb = qla + 36864;
  f32x16 Oa[4], Ob[4];
  float ma = NEG_INF, la = 0.f, mb = NEG_INF, lb = 0.f;
#pragma unroll
  for (int c = 0; c < 4; ++c)
#pragma unroll
    for (int i = 0; i < 16; ++i) { Oa[c][i] = 0.f; if (NMAP == 2) Ob[c][i] = 0.f; }

  u32x4 rk[KCH], rv[2];
  unsigned koff[KCH], voff[2];
#pragma unroll
  for (int i = 0; i < KCH; ++i) {
    const int id = tid + 512 * i;
    if (NMAP == 1) koff[i] = (unsigned)((id / CPR) * DQK + (id % CPR) * 8);
    else koff[i] = (unsigned)((((id & 511) >> 3)) * DQK + (id & 7) * 8);
  }
#pragma unroll
  for (int i = 0; i < 2; ++i) {
    const int id = tid + 512 * i;
    voff[i] = (unsigned)((id >> 4) * vstride + (id & 15) * 8);
  }
  auto gload = [&](int t) __attribute__((always_inline)) {
    const u16* k0t = kb0 + (size_t)t * 64 * DQK;
    const u16* k1t = (NMAP == 2) ? kb1 + (size_t)t * 64 * DQK : k0t;
    const u16* vt = vb + (size_t)t * 64 * vstride;
#pragma unroll
    for (int i = 0; i < KCH; ++i) rk[i] = *(const u32x4*)(((NMAP == 2 && i) ? k1t : k0t) + koff[i]);
#pragma unroll
    for (int i = 0; i < 2; ++i) rv[i] = *(const u32x4*)(vt + voff[i]);
  };
  auto sstore = [&](char* buf) __attribute__((always_inline)) {
#pragma unroll
    for (int i = 0; i < KCH; ++i) {
      const int id = tid + 512 * i;
      if (NMAP == 1) {
        const int row = id / CPR, c16 = id % CPR;
        *(u32x4*)(buf + row * RSK + c16 * 16) = rk[i];
      } else {
        const int rem = id & 511, row = rem >> 3, c16 = rem & 7;
        *(u32x4*)(buf + i * KTILE + row * RSK + c16 * 16) = rk[i];
      }
    }
#pragma unroll
    for (int i = 0; i < 2; ++i) {
      const int id = tid + 512 * i, row = id >> 4, c16 = id & 15;
      *(u32x4*)(buf + VOFF + row * 320 + c16 * 16) = rv[i];
    }
  };

  gload(0);
  sstore(smem);
  gload(1);
  __syncthreads();
  for (int t = 0; t < nt; ++t) {
    char* buf = smem + (t & 1) * STAGE;
    if (t + 1 < nt) {
      sstore(smem + ((t + 1) & 1) * STAGE);
      if (t + 2 < nt) gload(t + 2);
    }
    const int key0 = t * 64;
#pragma unroll
    for (int sub = 0; sub < 2; ++sub) {
      const int ko = sub * 32;
      if (key0 + ko <= wrow0 + 31) {
        const bool needmask = (key0 + ko + 31 > wrow0);
        bf16x8 pa0, pa1, pb0, pb1;
        qk_softmax32<NS, RSK, QL>(buf + ko * RSK, qfa, qla, needmask, key0 + ko, qrow, h, r, ma, la, Oa, pa0, pa1);
        if (NMAP == 2)
          qk_softmax32<NS, RSK, QL>(buf + KTILE + ko * RSK, qfa, qlb, needmask, key0 + ko, qrow, h, r, mb, lb, Ob, pb0, pb1);
#pragma unroll
        for (int ks = 0; ks < 2; ++ks)
#pragma unroll
          for (int c = 0; c < 4; ++c) {
            const char* ap = buf + VOFF + (ko + 16 * ks + 4 * h + q4) * 320 + (32 * c + 16 * blk) * 2 + 8 * p4;
            s16x4 lo = trread(ap), hi = trread(ap + 8 * 320);
            bf16x8 a = __builtin_shufflevector(lo, hi, 0, 1, 2, 3, 4, 5, 6, 7);
            Oa[c] = MFMA(a, ks ? pa1 : pa0, Oa[c]);
            if (NMAP == 2) Ob[c] = MFMA(a, ks ? pb1 : pb0, Ob[c]);
          }
      }
    }
    __syncthreads();
  }
  const float inva = 1.f / xsum32(la);
  if (NMAP == 1) {
#pragma unroll
    for (int c = 0; c < 4; ++c)
#pragma unroll
      for (int i = 0; i < 16; ++i) Oa[c][i] *= inva;
  } else {
    const float li = *lamp / xsum32(lb);
    float s2 = 0.f;
#pragma unroll
    for (int c = 0; c < 4; ++c)
#pragma unroll
      for (int i = 0; i < 16; ++i) {
        float v = Oa[c][i] * inva - li * Ob[c][i];
        Oa[c][i] = v; s2 += v * v;
      }
    s2 = xsum32(s2);
    const float rn = rsqrtf(s2 * (1.f / 128.f) + EPS) * 0.8f;
#pragma unroll
    for (int c = 0; c < 4; ++c)
#pragma unroll
      for (int gq = 0; gq < 4; ++gq) {
        const int d = 32 * c + 8 * gq + 4 * h;
        asm volatile("" ::: "memory");
        float4 gg = *(const float4*)(subg + d);
        Oa[c][4 * gq] *= rn * gg.x; Oa[c][4 * gq + 1] *= rn * gg.y; Oa[c][4 * gq + 2] *= rn * gg.z; Oa[c][4 * gq + 3] *= rn * gg.w;
      }
  }
  {
    u16* base = outp + (size_t)wrow0 * LDH;
    store_rows_bf16_lds(Oa, smem + w * 8704, lane, [&](int row, int c16) __attribute__((always_inline)) { return base + (size_t)row * LDH + c16 * 8; });
  }
  __syncthreads();
}

DI void conv_table_slice(const float* __restrict__ src, uint2* __restrict__ dst, float scale, int slice, int nslices) {
  const size_t groups = (size_t)16384 * 1024 / 16;
  const size_t gt = (size_t)lbid() * 512 + ltid(), NT = (size_t)lgdim() * 512;
  const size_t lo = groups * slice / nslices, hi = groups * (slice + 1) / nslices;
  for (size_t i = lo + gt; i < hi; i += NT) {
    const float4* sp = (const float4*)src + 4 * i;
    float4 a0 = sp[0], a1 = sp[1], a2 = sp[2], a3 = sp[3];
    unsigned w0 = 0, w1 = 0;
    w0 = __builtin_amdgcn_cvt_scalef32_pk_fp4_f32(w0, a0.x * scale, a0.y * scale, 1.0f, 0);
    w0 = __builtin_amdgcn_cvt_scalef32_pk_fp4_f32(w0, a0.z * scale, a0.w * scale, 1.0f, 1);
    w0 = __builtin_amdgcn_cvt_scalef32_pk_fp4_f32(w0, a1.x * scale, a1.y * scale, 1.0f, 2);
    w0 = __builtin_amdgcn_cvt_scalef32_pk_fp4_f32(w0, a1.z * scale, a1.w * scale, 1.0f, 3);
    w1 = __builtin_amdgcn_cvt_scalef32_pk_fp4_f32(w1, a2.x * scale, a2.y * scale, 1.0f, 0);
    w1 = __builtin_amdgcn_cvt_scalef32_pk_fp4_f32(w1, a2.z * scale, a2.w * scale, 1.0f, 1);
    w1 = __builtin_amdgcn_cvt_scalef32_pk_fp4_f32(w1, a3.x * scale, a3.y * scale, 1.0f, 2);
    w1 = __builtin_amdgcn_cvt_scalef32_pk_fp4_f32(w1, a3.z * scale, a3.w * scale, 1.0f, 3);
    dst[i] = make_uint2(w0, w1);
  }
}

DI void phase_attn(const Params& p, char* smem) {
  const int G = lgdim(), g = lbid();
  const u16* Qm = (const u16*)(p.ws + OFF_QM); const u16* Km = (const u16*)(p.ws + OFF_KM);
  const u16* Vm = (const u16*)(p.ws + OFF_VM); const u16* Qd = (const u16*)(p.ws + OFF_QD);
  const u16* Kd = (const u16*)(p.ws + OFF_KD); const u16* proj = (const u16*)(p.ws + OFF_PROJ);
  u16* mixed = (u16*)(p.ws + OFF_H);
  const float* lamp = (const float*)(p.ws + OFF_LAM);
  const int nrounds = (2048 + G - 1) / G;
  for (int k = 0; k * G < 2048; ++k) {
    conv_table_slice(p.in[23], (uint2*)(p.ws + OFF_U), U_SCALE, k, nrounds);
    conv_table_slice(p.in[24], (uint2*)(p.ws + OFF_V), V_SCALE, k, nrounds);
    const int idx = (k & 1) ? k * G + (G - 1 - g) : k * G + g;
    if (idx >= 2048) continue;
    const int level = idx >> 7, qblk = 15 - level, j = idx & 127, type = j & 1, bh = j >> 1;
    const int b = bh >> 2, hd = bh & 3;
    if (type == 0) {
      const size_t ho = (size_t)(b * 4 + hd) * S_;
      attn_item<192, 1>(Qm + ho * 192, nullptr, Km + ho * 192, nullptr, Vm + ho * 128, 128, qblk,
                        mixed + (size_t)b * S_ * LDH + hd * 128, lamp, nullptr, smem);
    } else {
      const size_t h0 = (size_t)(b * 8 + 2 * hd) * S_ * 64, h1 = h0 + (size_t)S_ * 64;
      attn_item<64, 2>(Qd + h0, Qd + h1, Kd + h0, Kd + h1, proj + (size_t)b * S_ * NPROJ + 1728 + hd * 128, NPROJ,
                       qblk, mixed + (size_t)b * S_ * LDH + 512 + hd * 128, lamp, p.in[18], smem);
    }
  }
}

template <int ST>
DI void ins1(float (&T)[16], float s) {
#pragma unroll
  for (int j = 15; j > ST; --j) T[j] = __builtin_amdgcn_fmed3f(T[j - 1], s, T[j]);
  T[ST] = fmaxf(T[ST], s);
}
DI void peer_scores_top16(const char* sk, const u16* __restrict__ pqrow, int lane, float (&T)[16]) {
  const int h = lane >> 5, r = lane & 31;
  bf16x8 bq[8];
#pragma unroll
  for (int s = 0; s < 8; ++s) bq[s] = *(const bf16x8*)(pqrow + 16 * s + 8 * h);
#pragma unroll
  for (int j = 0; j < 16; ++j) T[j] = NEG_INF;
#pragma unroll
  for (int c = 0; c < 4; ++c) {
    f32x16 acc;
#pragma unroll
    for (int i = 0; i < 16; ++i) acc[i] = 0.f;
#pragma unroll
    for (int s = 0; s < 8; ++s) {
      bf16x8 a = *(const bf16x8*)(sk + (32 * c + r) * 272 + (16 * s + 8 * h) * 2);
      acc = MFMA(a, bq[s], acc);
    }
#pragma unroll
    for (int i = 0; i < 16; ++i) {
      const unsigned code = (unsigned)(127 - 32 * c - (i & 3) - 8 * (i >> 2)) - 4u * (unsigned)h;
      ins1<0>(T, __uint_as_float((__float_as_uint(acc[i]) & 0xffffff80u) | code));
    }
  }
  float o[16];
#pragma unroll
  for (int j = 0; j < 16; ++j) {
    auto rr = __builtin_amdgcn_permlane32_swap(__float_as_uint(T[j]), __float_as_uint(T[j]), false, false);
    o[j] = __uint_as_float(h ? rr[0] : rr[1]);
  }
  ins1<0>(T, o[0]); ins1<1>(T, o[1]); ins1<2>(T, o[2]); ins1<3>(T, o[3]);
  ins1<4>(T, o[4]); ins1<5>(T, o[5]); ins1<6>(T, o[6]); ins1<7>(T, o[7]);
  ins1<8>(T, o[8]); ins1<9>(T, o[9]); ins1<10>(T, o[10]); ins1<11>(T, o[11]);
  ins1<12>(T, o[12]); ins1<13>(T, o[13]); ins1<14>(T, o[14]); ins1<15>(T, o[15]);
}

DI float gelu_exact(float x) { return 0.5f * x * (1.f + erff(x * 0.7071067811865476f)); }

DI void load_sk(char* smem, const u16* SK, int hp, int tid) {
#pragma unroll
  for (int i = 0; i < 4; ++i) {
    const int id = tid + 512 * i, row = id >> 4, c16 = id & 15;
    *(u32x4*)(smem + row * 272 + c16 * 16) = *(const u32x4*)(SK + (size_t)hp * 16384 + row * 128 + c16 * 8);
  }
}

DI void peer_route(const Params& p, char* smem, int t0) {
  const int tid = ltid(), lane = tid & 63, w = tid >> 6, h = lane >> 5, r = lane & 31;
  const u16* pq = (const u16*)(p.ws + OFF_PROJ);
  const u16* SK = (const u16*)(p.ws + OFF_SK);
  uint2* topk = (uint2*)(p.ws + OFF_TOPK);
    const int tq = t0 + 32 * w + r;
#pragma unroll 1
    for (int hd = 0; hd < 8; ++hd) {
      float TA[16], TB[16];
      __syncthreads();
      load_sk(smem, SK, hd * 2, tid);
      __syncthreads();
      peer_scores_top16(smem, pq + (size_t)tq * 2048 + (hd * 2) * 128, lane, TA);
      __syncthreads();
      load_sk(smem, SK, hd * 2 + 1, tid);
      __syncthreads();
      peer_scores_top16(smem, pq + (size_t)tq * 2048 + (hd * 2 + 1) * 128, lane, TB);
      float FK[16];
#pragma unroll
      for (int j = 0; j < 16; ++j) FK[j] = NEG_INF;
#pragma unroll
      for (int i = 0; i < 16; ++i)
#pragma unroll
        for (int j = 0; j < 16; ++j)
          if ((i + 1) * (j + 1) <= 16) {
            const float cv = __uint_as_float(__float_as_uint(TA[i]) & 0xffffff80u) + __uint_as_float(__float_as_uint(TB[j]) & 0xffffff80u);
            const float key = __uint_as_float((__float_as_uint(cv) & 0xffffff00u) | (unsigned)(255 - (16 * i + j)));
            const int st = (i + 1) * (j + 1) - 1;
#pragma unroll
            for (int q = 15; q >= 1; --q)
              if (q > st) FK[q] = __builtin_amdgcn_fmed3f(FK[q - 1], key, FK[q]);
            FK[st] = fmaxf(FK[st], key);
          }
      float FV[16]; int FI[16];
#pragma unroll
      for (int m = 0; m < 16; ++m) {
        const unsigned kb = __float_as_uint(FK[m]);
        const int code = 255 - (int)(kb & 255u), ci = code >> 4, cj = code & 15;
        FV[m] = __uint_as_float(kb & 0xffffff00u);
        float ra = TA[0], rb = TB[0];
#pragma unroll
        for (int q = 1; q < 16; ++q) { ra = (ci == q) ? TA[q] : ra; rb = (cj == q) ? TB[q] : rb; }
        FI[m] = (127 - (int)(__float_as_uint(ra) & 127u)) * 128 + (127 - (int)(__float_as_uint(rb) & 127u));
      }
      float e[16], sum = 0.f;
#pragma unroll
      for (int j = 0; j < 16; ++j) { e[j] = expf(FV[j] - FV[0]); sum += e[j]; }
      const float rs = 1.f / sum;
      if (h == 0) {
        u32x4* dst = (u32x4*)(topk + (size_t)tq * 128 + hd * 16);
#pragma unroll
        for (int q = 0; q < 8; ++q) {
          u32x4 o;
          o.x = (unsigned)FI[2 * q]; o.y = __float_as_uint(e[2 * q] * rs);
          o.z = (unsigned)FI[2 * q + 1]; o.w = __float_as_uint(e[2 * q + 1] * rs);
          dst[q] = o;
        }
      }
    }
}

DI void peer_gather(const Params& p, int t0) {
  const int tid = ltid(), lane = tid & 63, w = tid >> 6;
  const uint2* topk = (const uint2*)(p.ws + OFF_TOPK);
  const float* mod = (const float*)(p.ws + OFF_MOD);
  const unsigned char* U8 = (const unsigned char*)(p.ws + OFF_U);
  const unsigned char* V8 = (const unsigned char*)(p.ws + OFF_V);
#pragma unroll 1
  for (int ti = 0; ti < 32; ++ti) {
    const int t = t0 + 32 * w + ti, b = t >> 12;
    const float* mb = mod + b * 6144;
    float* orow = p.out + (size_t)t * 1024 + lane * 16;
    f32x2 xr[8];
#pragma unroll
    for (int q = 0; q < 4; ++q) {
      float4 a = ((const float4*)orow)[q];
      xr[2 * q] = f32x2{a.x, a.y}; xr[2 * q + 1] = f32x2{a.z, a.w};
    }
    float ss = 0.f;
#pragma unroll
    for (int i = 0; i < 8; ++i) ss += xr[i].x * xr[i].x + xr[i].y * xr[i].y;
    ss = wave_sum(ss);
    const float rinv = rsqrtf(ss * (1.f / 1024.f) + EPS);
    f32x2 hf[8];
#pragma unroll
    for (int q = 0; q < 4; ++q) {
      const int d0 = lane * 16 + 4 * q;
      float4 gg = *(const float4*)(p.in[20] + d0);
      float4 sc = *(const float4*)(mb + 4096 + d0);
      float4 sh = *(const float4*)(mb + 3072 + d0);
      hf[2 * q] = f32x2{xr[2 * q].x * rinv * gg.x * (1.f + sc.x) + sh.x, xr[2 * q].y * rinv * gg.y * (1.f + sc.y) + sh.y};
      hf[2 * q + 1] = f32x2{xr[2 * q + 1].x * rinv * gg.z * (1.f + sc.z) + sh.z, xr[2 * q + 1].y * rinv * gg.w * (1.f + sc.w) + sh.w};
    }
    const u32x4 tk = *(const u32x4*)(topk + (size_t)t * 128 + lane * 2);
    f32x2 y[8];
#pragma unroll
    for (int i = 0; i < 8; ++i) y[i] = f32x2{0.f, 0.f};
    uint2 ua[16], va[16], ub[16], vb[16];
    float gA, gB;
    auto issue = [&](int jj, uint2 (&uu)[16], uint2 (&vv)[16], float& gsel) __attribute__((always_inline)) {
      float gs = 0.f;
#pragma unroll
      for (int k = 0; k < 16; ++k) {
        const int l = 8 * jj + (k >> 1);
        const int e = __builtin_amdgcn_readlane((int)((k & 1) ? tk.z : tk.x), l);
        const float g = __uint_as_float(__builtin_amdgcn_readlane((int)((k & 1) ? tk.w : tk.y), l));
        gs = ((lane >> 2) == k) ? g : gs;
        uu[k] = *(const uint2*)(U8 + (size_t)e * 512 + lane * 8);
        vv[k] = *(const uint2*)(V8 + (size_t)e * 512 + lane * 8);
      }
      gsel = gs;
    };
    auto process = [&](const uint2 (&uu)[16], const uint2 (&vv)[16], float gsel) __attribute__((always_inline)) {
      float d[16];
#pragma unroll
      for (int k = 0; k < 16; ++k) {
        f32x2 a2 = f32x2{0.f, 0.f};
        a2 = __builtin_amdgcn_cvt_scalef32_pk_f32_fp4(uu[k].x, 1.0f, 0) * hf[0] + a2;
        a2 = __builtin_amdgcn_cvt_scalef32_pk_f32_fp4(uu[k].x, 1.0f, 1) * hf[1] + a2;
        a2 = __builtin_amdgcn_cvt_scalef32_pk_f32_fp4(uu[k].x, 1.0f, 2) * hf[2] + a2;
        a2 = __builtin_amdgcn_cvt_scalef32_pk_f32_fp4(uu[k].x, 1.0f, 3) * hf[3] + a2;
        a2 = __builtin_amdgcn_cvt_scalef32_pk_f32_fp4(uu[k].y, 1.0f, 0) * hf[4] + a2;
        a2 = __builtin_amdgcn_cvt_scalef32_pk_f32_fp4(uu[k].y, 1.0f, 1) * hf[5] + a2;
        a2 = __builtin_amdgcn_cvt_scalef32_pk_f32_fp4(uu[k].y, 1.0f, 2) * hf[6] + a2;
        a2 = __builtin_amdgcn_cvt_scalef32_pk_f32_fp4(uu[k].y, 1.0f, 3) * hf[7] + a2;
        d[k] = a2.x + a2.y;
      }
      const bool h32 = (lane & 32) != 0, h16 = (lane & 16) != 0, h8 = (lane & 8) != 0, h4 = (lane & 4) != 0;
      float r8[8], r4[4], r2[2];
#pragma unroll
      for (int i = 0; i < 8; ++i) r8[i] = swapsum32(d[i], d[8 + i]);
#pragma unroll
      for (int i = 0; i < 4; ++i) r4[i] = swapsum16(r8[i], r8[4 + i]);
#pragma unroll
      for (int i = 0; i < 2; ++i) r2[i] = (h8 ? r4[2 + i] : r4[i]) + dppmov<0x128>(h8 ? r4[i] : r4[2 + i]);
      float kk = (h4 ? r2[1] : r2[0]) + dppmov<0x141>(h4 ? r2[0] : r2[1]);
      kk += dppmov<0x4E>(kk); kk += dppmov<0xB1>(kk);
      const float coefv = gsel * gelu_exact(kk * (1.f / U_SCALE)) * (1.f / V_SCALE);
#pragma unroll
      for (int k = 0; k < 16; ++k) {
        const float cf = __uint_as_float(__builtin_amdgcn_readlane((int)__float_as_uint(coefv), 4 * k));
        const f32x2 cf2 = f32x2{cf, cf};
        y[0] = __builtin_amdgcn_cvt_scalef32_pk_f32_fp4(vv[k].x, 1.0f, 0) * cf2 + y[0];
        y[1] = __builtin_amdgcn_cvt_scalef32_pk_f32_fp4(vv[k].x, 1.0f, 1) * cf2 + y[1];
        y[2] = __builtin_amdgcn_cvt_scalef32_pk_f32_fp4(vv[k].x, 1.0f, 2) * cf2 + y[2];
        y[3] = __builtin_amdgcn_cvt_scalef32_pk_f32_fp4(vv[k].x, 1.0f, 3) * cf2 + y[3];
        y[4] = __builtin_amdgcn_cvt_scalef32_pk_f32_fp4(vv[k].y, 1.0f, 0) * cf2 + y[4];
        y[5] = __builtin_amdgcn_cvt_scalef32_pk_f32_fp4(vv[k].y, 1.0f, 1) * cf2 + y[5];
        y[6] = __builtin_amdgcn_cvt_scalef32_pk_f32_fp4(vv[k].y, 1.0f, 2) * cf2 + y[6];
        y[7] = __builtin_amdgcn_cvt_scalef32_pk_f32_fp4(vv[k].y, 1.0f, 3) * cf2 + y[7];
      }
    };
    issue(0, ua, va, gA);
#pragma unroll 1
    for (int jj = 0; jj < 8; jj += 2) {
      issue(jj + 1, ub, vb, gB);
      __builtin_amdgcn_sched_barrier(0);
      process(ua, va, gA);
      __builtin_amdgcn_sched_barrier(0);
      issue((jj + 2) & 7, ua, va, gA);
      __builtin_amdgcn_sched_barrier(0);
      process(ub, vb, gB);
      __builtin_amdgcn_sched_barrier(0);
    }
#pragma unroll
    for (int q = 0; q < 4; ++q) {
      float4 g2 = *(const float4*)(mb + 5120 + lane * 16 + 4 * q);
      float4 o;
      o.x = xr[2 * q].x + g2.x * y[2 * q].x; o.y = xr[2 * q].y + g2.y * y[2 * q].y;
      o.z = xr[2 * q + 1].x + g2.z * y[2 * q + 1].x; o.w = xr[2 * q + 1].y + g2.w * y[2 * q + 1].y;
      ((float4*)orow)[q] = o;
    }
  }
}

typedef const __attribute__((address_space(4))) Params* KParamsPtr;
__global__ void __launch_bounds__(512) mega(Params p_arg) {
  __shared__ __attribute__((aligned(16))) char smem[151552];
  for (int ph = p_arg.ph_begin; ph < p_arg.ph_end; ++ph) {
    KParamsPtr kp = (KParamsPtr)__builtin_amdgcn_kernarg_segment_ptr();
    asm volatile("" : "+s"(kp));
    Params p;
#pragma unroll
    for (int i = 0; i < 25; ++i) p.in[i] = kp->in[i];
    p.out = kp->out; p.ws = kp->ws; p.ph_begin = 0; p.ph_end = 0;
    const int G = lgdim();
    if (ph == 0) {
      phase0(p, smem);
    } else if (ph == 1) {
      rownorm_phase(p, p.in[0], p.in[4], 0, 1024, (u16*)(p.ws + OFF_H));
    } else if (ph == 2) {
      u16* proj = (u16*)(p.ws + OFF_PROJ);
      xcd_tiles(p.ws, 0, 9, [&](int tt, int ft2) __attribute__((always_inline)) {
        gemm_tile<1024, false>((const u16*)(p.ws + OFF_WIN), NPROJ, ft2 * 256, (const u16*)(p.ws + OFF_H), LDH,
                               (size_t)tt * 256, smem, [&](f32x16 (&acc)[4], float, int t, int h, int wf, char* wbase, int tg) __attribute__((always_inline)) {
                                 store_tile_bf16_lds(acc, wbase + tg * 8704, proj + (size_t)(t & ~31) * NPROJ + ft2 * 256 + wf * 128, NPROJ, ltid() & 63);
                               });
      });
    } else if (ph == 3) {
      phase_qkv(p, smem);
    } else if (ph == 4) {
      phase_attn(p, smem);
    } else if (ph == 5) {
      const float* mod = (const float*)(p.ws + OFF_MOD);
      xcd_tiles(p.ws, 3, 4, [&](int tt, int ft2) __attribute__((always_inline)) {
        gemm_tile<1024, false>((const u16*)(p.ws + OFF_WOUT), 1024, ft2 * 256, (const u16*)(p.ws + OFF_H), LDH,
                               (size_t)tt * 256, smem, [&](f32x16 (&acc)[4], float, int t, int h, int wf, char* wbase, int tg) __attribute__((always_inline)) {
                                 const int ft = ft2 * 2 + wf, lane = ltid() & 63, r = lane & 31;
#pragma unroll
                                 for (int c = 0; c < 4; ++c)
#pragma unroll
                                   for (int gq = 0; gq < 4; ++gq)
                                     *(float4*)(wbase + r * 528 + (32 * c + 8 * gq + 4 * h) * 4) =
                                         make_float4(acc[c][4 * gq], acc[c][4 * gq + 1], acc[c][4 * gq + 2], acc[c][4 * gq + 3]);
                                 const int tg0 = t & ~31, b = tg0 >> 12;
#pragma unroll
                                 for (int j = 0; j < 16; ++j) {
                                   const int idx = lane + 64 * j, row = idx >> 5, c16 = idx & 31;
                                   const float4 a = *(const float4*)(wbase + row * 528 + c16 * 16);
                                   const int n = ft * 128 + c16 * 4;
                                   const size_t off = (size_t)(tg0 + row) * 1024 + n;
                                   const float4 xv = *(const float4*)(p.in[0] + off);
                                   const float4 g1 = *(const float4*)(mod + b * 6144 + 2048 + n);
                                   float4 o;
                                   o.x = xv.x + g1.x * a.x; o.y = xv.y + g1.y * a.y; o.z = xv.z + g1.z * a.z; o.w = xv.w + g1.w * a.w;
                                   *(float4*)(p.out + off) = o;
                                 }
                               });
      });
    } else if (ph == 6) {
      rownorm_phase(p, p.out, p.in[20], 3072, 4096, (u16*)(p.ws + OFF_H2));
    } else if (ph == 7) {
      u16* pq = (u16*)(p.ws + OFF_PROJ);
      xcd_tiles(p.ws, 4, 8, [&](int tt, int ft2) __attribute__((always_inline)) {
        gemm_tile<1024, false>((const u16*)(p.ws + OFF_WPQ), 2048, ft2 * 256, (const u16*)(p.ws + OFF_H2), LDH,
                               (size_t)tt * 256, smem, [&](f32x16 (&acc)[4], float, int t, int h, int wf, char* wbase, int tg) __attribute__((always_inline)) {
                                 store_tile_bf16_lds(acc, wbase + tg * 8704, pq + (size_t)(t & ~31) * 2048 + ft2 * 256 + wf * 128, 2048, ltid() & 63);
                               });
      });
    } else {
      for (int tt = lbid(); tt < 256; tt += G) {
        peer_route(p, smem, tt * 256);
        __threadfence();
        __syncthreads();
        __threadfence();
        peer_gather(p, tt * 256);
      }
    }
#if COOP
    if (ph + 1 < p_arg.ph_end) cg::this_grid().sync();
#endif
  }
}

extern "C" void kernel_launch(void* const* d_in, const int* in_sizes, int n_in, void* d_out, int out_size,
                              void* d_ws, size_t ws_size, hipStream_t stream) {
  static int grid_blocks = 0;
  if (!grid_blocks) {
    int dev = 0, cus = 0, per_cu = 0;
    hipGetDevice(&dev);
    hipDeviceGetAttribute(&cus, hipDeviceAttributeMultiprocessorCount, dev);
    hipOccupancyMaxActiveBlocksPerMultiprocessor(&per_cu, mega, 512, 0);
    if (per_cu < 1) per_cu = 1;
    if (per_cu > 1) per_cu = 1;
    grid_blocks = cus * per_cu;
  }
  Params p{};
  for (int i = 0; i < 25; ++i) p.in[i] = (const float*)d_in[i];
  p.out = (float*)d_out;
  p.ws = (char*)d_ws;
#if COOP
  p.ph_begin = 0; p.ph_end = 9;
  void* args[] = {&p};
  hipError_t e = hipLaunchCooperativeKernel((void*)mega, dim3(grid_blocks), dim3(512), args, 0, stream);
  if (e != hipSuccess) fprintf(stderr, "cooperative launch failed: %s (grid %d)\n", hipGetErrorString(e), grid_blocks);
#else
  for (int ph = 0; ph < 9; ++ph) {
    p.ph_begin = ph; p.ph_end = ph + 1;
    hipLaunchKernelGGL(mega, dim3(grid_blocks), dim3(512), 0, stream, p);
  }
#endif
}
```

```cpp
#include <hip/hip_runtime.h>
#include <hip/hip_cooperative_groups.h>
#include <cstdio>
namespace cg = cooperative_groups;

typedef unsigned short u16;
typedef short bf16x8 __attribute__((ext_vector_type(8)));
typedef short s16x4 __attribute__((ext_vector_type(4)));
typedef float f32x16 __attribute__((ext_vector_type(16)));
typedef __bf16 bf2_t __attribute__((ext_vector_type(2)));
typedef unsigned u32x4 __attribute__((ext_vector_type(4)));
#define DI __device__ __forceinline__
#define LDSP(T, p) ((__attribute__((address_space(3))) T*)(p))
#define MFMA(a, b, c) __builtin_amdgcn_mfma_f32_32x32x16_bf16((a), (b), (c), 0, 0, 0)

#ifndef COOP
#define COOP 1
#endif

constexpr int S_ = 4096, T_ = 65536, NPROJ = 2304;
constexpr int LDH = 1088;
constexpr float EPS = 1e-6f;
constexpr float LOG2E = 1.4426950408889634f;
constexpr float NEG_INF = -__builtin_inff();
constexpr float U_SCALE = 64.f, V_SCALE = 5.656854f;
typedef float f32x2 __attribute__((ext_vector_type(2)));

constexpr size_t OFF_MOD = 0;
constexpr size_t OFF_LAM = 393216;
constexpr size_t OFF_CNT = 397312;
constexpr size_t OFF_ROPE = 524288;
constexpr size_t OFF_WIN = 1572864;
constexpr size_t OFF_WQ = 6291456;
constexpr size_t OFF_WKV = 6881280;
constexpr size_t OFF_WOUT = 7405568;
constexpr size_t OFF_WPQ = 9502720;
constexpr size_t OFF_SK = 13697024;
constexpr size_t OFF_U = 16777216;
constexpr size_t OFF_V = 50331648;
constexpr size_t OFF_H = 83886080;
constexpr size_t OFF_PROJ = 226492416;
constexpr size_t OFF_QM = 528482304;
constexpr size_t OFF_KM = 629145600;
constexpr size_t OFF_VM = 729808896;
constexpr size_t OFF_QD = 796917760;
constexpr size_t OFF_KD = 864026624;
constexpr size_t OFF_H2 = OFF_QM;
constexpr size_t OFF_TOPK = OFF_VM;

struct Params {
  const float* in[25];
  float* out;
  char* ws;
  int ph_begin, ph_end;
};

DI unsigned pk2(float a, float b) {
  bf2_t r; r[0] = (__bf16)a; r[1] = (__bf16)b; return __builtin_bit_cast(unsigned, r);
}
DI float bflo(unsigned u) { return __uint_as_float(u << 16); }
DI float bfhi(unsigned u) { return __uint_as_float(u & 0xffff0000u); }
DI float dot2bf(unsigned a, unsigned b, float c) {
  return __builtin_amdgcn_fdot2_f32_bf16(__builtin_bit_cast(bf2_t, a), __builtin_bit_cast(bf2_t, b), c, false);
}
DI int lbid() { int t = blockIdx.x; asm volatile("" : "+s"(t)); return t; }
DI int lgdim() { int t = gridDim.x; asm volatile("" : "+s"(t)); return t; }
DI int ltid() { int t = threadIdx.x; asm volatile("" : "+v"(t)); return t; }
DI float xsum32(float v) {
  const unsigned u = __float_as_uint(v);
  auto r = __builtin_amdgcn_permlane32_swap(u, u, false, false);
  return __uint_as_float(r[0]) + __uint_as_float(r[1]);
}
DI float xmax32(float v) {
  const unsigned u = __float_as_uint(v);
  auto r = __builtin_amdgcn_permlane32_swap(u, u, false, false);
  return fmaxf(__uint_as_float(r[0]), __uint_as_float(r[1]));
}
DI float swapsum32(float a, float b) {
  auto r = __builtin_amdgcn_permlane32_swap(__float_as_uint(a), __float_as_uint(b), false, false);
  return __uint_as_float(r[0]) + __uint_as_float(r[1]);
}
DI float swapsum16(float a, float b) {
  auto r = __builtin_amdgcn_permlane16_swap(__float_as_uint(a), __float_as_uint(b), false, false);
  return __uint_as_float(r[0]) + __uint_as_float(r[1]);
}
template <int CTRL>
DI float dppmov(float v) {
  return __uint_as_float((unsigned)__builtin_amdgcn_update_dpp(0, (int)__float_as_uint(v), CTRL, 0xF, 0xF, true));
}
DI float wave_sum(float v) {
  v += dppmov<0x128>(v); v += dppmov<0x124>(v); v += dppmov<0x122>(v); v += dppmov<0x121>(v);
  v = swapsum16(v, v);
  return xsum32(v);
}
DI s16x4 trread(const char* p) { return __builtin_amdgcn_ds_read_tr16_b64_v4i16(LDSP(s16x4, p)); }
DI unsigned xcc_id() { return (unsigned)__builtin_amdgcn_s_getreg((3 << 11) | 20) & 0x7u; }
template <class F>
DI void xcd_tiles(char* ws, int set, int nft, F body) {
  __shared__ int sh_item;
  unsigned* cnt = (unsigned*)(ws + OFF_CNT);
  const int x0 = (int)xcc_id();
  const int per = 32 * nft;
  for (int q = 0; q < 8; ++q) {
    const int x = (x0 + q) & 7;
    for (;;) {
      __syncthreads();
      if (threadIdx.x == 0) sh_item = (int)atomicAdd(cnt + (set * 8 + x) * 32, 1u);
      __syncthreads();
      const int it = sh_item;
      if (it >= per) break;
      body(32 * x + it / nft, it % nft);
    }
  }
}

constexpr int G_ARS = 576;
constexpr int G_ASZ = 64 * G_ARS, G_BSZ = 256 * 144, G_STAGE = G_ASZ + G_BSZ;

template <int K, bool SUMSQ, class Epi>
DI void gemm_tile(const u16* __restrict__ W, int ldw, int n0, const u16* __restrict__ X, int ldx, size_t t0,
                  char* smem, Epi epi) {
  constexpr int KT = K / 64;
  const int tid = ltid(), lane = tid & 63, w = tid >> 6, h = lane >> 5, r = lane & 31;
  const int wf = w & 1, wt = w >> 1;
  const int blk = (lane >> 4) & 1, q4 = (lane & 15) >> 2, p4 = lane & 3;
  u32x4 ra[4], rb[4];
  const unsigned aoff = (unsigned)((tid >> 5) * ldw + (tid & 31) * 8), boff = (unsigned)((tid >> 3) * ldx + (tid & 7) * 8);
  const unsigned asoff = (unsigned)((tid >> 5) * G_ARS + (tid & 31) * 16), bsoff = (unsigned)(G_ASZ + (tid >> 3) * 144 + (tid & 7) * 16);
  auto gload = [&](int kt) __attribute__((always_inline)) {
    const u16* wk = W + (size_t)kt * 64 * ldw + n0;
    const u16* xk = X + t0 * (size_t)ldx + kt * 64;
#pragma unroll
    for (int i = 0; i < 4; ++i) ra[i] = *(const u32x4*)(wk + (size_t)i * 16 * ldw + aoff);
#pragma unroll
    for (int i = 0; i < 4; ++i) rb[i] = *(const u32x4*)(xk + (size_t)i * 64 * ldx + boff);
  };
  auto sstore = [&](char* buf) __attribute__((always_inline)) {
#pragma unroll
    for (int i = 0; i < 4; ++i) *(u32x4*)(buf + asoff + i * 16 * G_ARS) = ra[i];
#pragma unroll
    for (int i = 0; i < 4; ++i) *(u32x4*)(buf + bsoff + i * 64 * 144) = rb[i];
  };
  auto stage_step = [&](int s, char* nbuf, int ktl, bool dowrite, bool doload) __attribute__((always_inline)) {
    const u16* wk = W + (size_t)ktl * 64 * ldw + n0;
    const u16* xk = X + t0 * (size_t)ldx + ktl * 64;
    if (s < 2) {
#pragma unroll
      for (int i = 2 * s; i < 2 * s + 2; ++i) {
        if (dowrite) *(u32x4*)(nbuf + asoff + i * 16 * G_ARS) = ra[i];
        if (doload) ra[i] = *(const u32x4*)(wk + (size_t)i * 16 * ldw + aoff);
      }
    } else {
#pragma unroll
      for (int i = 2 * s - 4; i < 2 * s - 2; ++i) {
        if (dowrite) *(u32x4*)(nbuf + bsoff + i * 64 * 144) = rb[i];
        if (doload) rb[i] = *(const u32x4*)(xk + (size_t)i * 64 * ldx + boff);
      }
    }
  };
  f32x16 acc[2][4];
#pragma unroll
  for (int g = 0; g < 2; ++g)
#pragma unroll
    for (int c = 0; c < 4; ++c)
#pragma unroll
      for (int i = 0; i < 16; ++i) acc[g][c][i] = 0.f;
  float ss0 = 0.f, ss1 = 0.f;
  auto compute = [&](const char* buf, char* nbuf, int ktl, bool dowrite, bool doload) __attribute__((always_inline)) {
    u32x4 bfr[2][2];
    s16x4 alo[2][4], ahi[2][4];
    auto lfrag = [&](int s, int slot) __attribute__((always_inline)) {
      bfr[slot][0] = *(const u32x4*)(buf + G_ASZ + (64 * wt + r) * 144 + (16 * s + 8 * h) * 2);
      bfr[slot][1] = *(const u32x4*)(buf + G_ASZ + (64 * wt + 32 + r) * 144 + (16 * s + 8 * h) * 2);
#pragma unroll
      for (int c = 0; c < 4; ++c) {
        const char* ap = buf + (16 * s + 8 * h + q4) * G_ARS + (128 * wf + 32 * c + 16 * blk) * 2 + 8 * p4;
        alo[slot][c] = trread(ap); ahi[slot][c] = trread(ap + 4 * G_ARS);
      }
    };
    lfrag(0, 0);
#pragma unroll
    for (int s = 0; s < 4; ++s) {
      if (s < 3) lfrag(s + 1, (s + 1) & 1);
      __builtin_amdgcn_sched_barrier(0);
      const u32x4 b0r = bfr[s & 1][0], b1r = bfr[s & 1][1];
      if (SUMSQ) {
        ss0 = dot2bf(b0r.x, b0r.x, ss0); ss0 = dot2bf(b0r.y, b0r.y, ss0);
        ss0 = dot2bf(b0r.z, b0r.z, ss0); ss0 = dot2bf(b0r.w, b0r.w, ss0);
        ss1 = dot2bf(b1r.x, b1r.x, ss1); ss1 = dot2bf(b1r.y, b1r.y, ss1);
        ss1 = dot2bf(b1r.z, b1r.z, ss1); ss1 = dot2bf(b1r.w, b1r.w, ss1);
      }
      const bf16x8 b0 = __builtin_bit_cast(bf16x8, b0r), b1 = __builtin_bit_cast(bf16x8, b1r);
#pragma unroll
      for (int c = 0; c < 4; ++c) {
        const bf16x8 a = __builtin_shufflevector(alo[s & 1][c], ahi[s & 1][c], 0, 1, 2, 3, 4, 5, 6, 7);
        acc[0][c] = MFMA(a, b0, acc[0][c]);
        acc[1][c] = MFMA(a, b1, acc[1][c]);
      }
      __builtin_amdgcn_sched_barrier(0);
      stage_step(s, nbuf, ktl, dowrite, doload);
      __builtin_amdgcn_sched_barrier(0);
    }
  };
  gload(0);
  sstore(smem);
  if (KT > 1) gload(1);
  __syncthreads();
  for (int kt = 0; kt < KT; ++kt) {
    char* buf = smem + (kt & 1) * G_STAGE;
    compute(buf, smem + ((kt + 1) & 1) * G_STAGE, kt + 2, kt + 1 < KT, kt + 2 < KT);
    __syncthreads();
  }
  if (SUMSQ) { ss0 = xsum32(ss0); ss1 = xsum32(ss1); }
  epi(acc[0], ss0, (int)t0 + 64 * wt + r, h, wf, smem + w * 17408, 0);
  epi(acc[1], ss1, (int)t0 + 64 * wt + 32 + r, h, wf, smem + w * 17408, 1);
}

DI void phase0(const Params& p, char* smem) {
  const int tid = ltid(), G = lgdim(), g = lbid();
  const size_t gt = (size_t)g * 512 + tid, NT = (size_t)G * 512;
  float* mod = (float*)(p.ws + OFF_MOD);
  for (int item = g; item < 192; item += G) {
    float* sc = (float*)smem;
    float* red = sc + 16384;
    for (int i = tid; i < 16384; i += 512) { float v = p.in[1][i]; sc[i] = v / (1.f + expf(-v)); }
    __syncthreads();
    const int col = tid & 31, kg = tid >> 5, n = item * 32 + col;
    float acc[16];
#pragma unroll
    for (int b = 0; b < 16; ++b) acc[b] = 0.f;
    const float* aw = p.in[2] + (size_t)(kg * 64) * 6144 + n;
#pragma unroll 1
    for (int k0 = 0; k0 < 64; k0 += 16) {
      float wv[16];
#pragma unroll
      for (int j = 0; j < 16; ++j) wv[j] = aw[(size_t)(k0 + j) * 6144];
#pragma unroll
      for (int j = 0; j < 16; ++j)
#pragma unroll
        for (int b = 0; b < 16; ++b) acc[b] += sc[b * 1024 + kg * 64 + k0 + j] * wv[j];
    }
#pragma unroll
    for (int b = 0; b < 16; ++b) red[(kg * 16 + b) * 32 + col] = acc[b];
    __syncthreads();
    {
      const int b = tid >> 5, cc = tid & 31;
      float sum = 0.f;
#pragma unroll
      for (int k2 = 0; k2 < 16; ++k2) sum += red[(k2 * 16 + b) * 32 + cc];
      mod[b * 6144 + item * 32 + cc] = sum + p.in[3][item * 32 + cc];
    }
    __syncthreads();
  }
  if (g == 0) {
    unsigned* cnt = (unsigned*)(p.ws + OFF_CNT);
    for (int i = tid; i < 8 * 8 * 32; i += 512) cnt[i] = 0u;
  }
  if (g == 0 && tid < 64) {
    float d1 = wave_sum(p.in[14][tid] * p.in[15][tid]);
    float d2 = wave_sum(p.in[16][tid] * p.in[17][tid]);
    if (tid == 0) *(float*)(p.ws + OFF_LAM) = expf(d1) - expf(d2) + 0.2f;
  }
  {
    float2* rope = (float2*)(p.ws + OFF_ROPE);
    for (size_t i = gt; i < 131072; i += NT) {
      int j = (int)(i & 31), sp = (int)(i >> 5);
      float inv = 1.0f / powf(10000.f, (float)j / 32.f);
      float ang = (float)sp * inv, sn, cs;
      sincosf(ang, &sn, &cs);
      rope[i] = make_float2(cs, sn);
    }
  }
  {
    u16* d = (u16*)(p.ws + OFF_WIN);
    for (size_t i = gt; i < (size_t)1024 * 2304; i += NT) {
      int k = (int)(i / 2304), n = (int)(i % 2304);
      float v = (n < 2240) ? p.in[5][(size_t)k * 2240 + n] : 0.f;
      d[i] = (u16)(pk2(v, 0.f) & 0xffff);
    }
  }
  {
    u16* d = (u16*)(p.ws + OFF_WQ);
    for (size_t i = gt; i < (size_t)384 * 768; i += NT) {
      int k = (int)(i / 768), n = (int)(i % 768);
      int src = (n < 512) ? (n >> 7) * 192 + (n & 127) : ((n - 512) >> 6) * 192 + 128 + ((n - 512) & 63);
      float v = p.in[7][(size_t)k * 768 + src] * p.in[6][k];
      d[i] = (u16)(pk2(v, 0.f) & 0xffff);
    }
  }
  {
    u16* d = (u16*)(p.ws + OFF_WKV);
    for (size_t i = gt; i < (size_t)256 * 1024; i += NT) {
      int k = (int)(i >> 10), n = (int)(i & 1023);
      int src = (n < 512) ? (n >> 7) * 256 + (n & 127) : ((n - 512) >> 7) * 256 + 128 + (n & 127);
      float v = p.in[9][(size_t)k * 1024 + src] * p.in[8][k];
      d[i] = (u16)(pk2(v, 0.f) & 0xffff);
    }
  }
  auto conv8 = [&](const float* src, u16* dst, size_t n8) __attribute__((always_inline)) {
    for (size_t i = gt; i < n8; i += NT) {
      float4 a = ((const float4*)src)[2 * i], b = ((const float4*)src)[2 * i + 1];
      uint4 o; o.x = pk2(a.x, a.y); o.y = pk2(a.z, a.w); o.z = pk2(b.x, b.y); o.w = pk2(b.z, b.w);
      ((uint4*)dst)[i] = o;
    }
  };
  conv8(p.in[19], (u16*)(p.ws + OFF_WOUT), (size_t)1024 * 1024 / 8);
  conv8(p.in[21], (u16*)(p.ws + OFF_WPQ), (size_t)1024 * 2048 / 8);
  conv8(p.in[22], (u16*)(p.ws + OFF_SK), (size_t)16 * 128 * 128 / 8);
}

DI void rownorm_phase(const Params& p, const float* src, const float* gain, int sh_off, int sc_off, u16* dst) {
  const int lane = ltid() & 63;
  const int gw = lbid() * 8 + (ltid() >> 6), NW = lgdim() * 8;
  const float* mod = (const float*)(p.ws + OFF_MOD);
  for (int t = gw; t < T_; t += NW) {
    const int b = t >> 12;
    const float* mb = mod + b * 6144;
#pragma unroll
    for (int c = 0; c < 2; ++c) {
    }
    float xv[16];
#pragma unroll
    for (int c = 0; c < 2; ++c) {
      const float4* sp = (const float4*)(src + (size_t)t * 1024 + c * 512 + lane * 8);
      float4 a = sp[0], bq = sp[1];
      xv[c * 8 + 0] = a.x; xv[c * 8 + 1] = a.y; xv[c * 8 + 2] = a.z; xv[c * 8 + 3] = a.w;
      xv[c * 8 + 4] = bq.x; xv[c * 8 + 5] = bq.y; xv[c * 8 + 6] = bq.z; xv[c * 8 + 7] = bq.w;
    }
    float ss = 0.f;
#pragma unroll
    for (int i = 0; i < 16; ++i) ss += xv[i] * xv[i];
    ss = wave_sum(ss);
    const float rinv = rsqrtf(ss * (1.f / 1024.f) + EPS);
#pragma unroll
    for (int c = 0; c < 2; ++c) {
      const int d0 = c * 512 + lane * 8;
      float o[8];
#pragma unroll
      for (int q = 0; q < 2; ++q) {
        float4 gg = *(const float4*)(gain + d0 + 4 * q);
        float4 sc = *(const float4*)(mb + sc_off + d0 + 4 * q);
        float4 sh = *(const float4*)(mb + sh_off + d0 + 4 * q);
        o[4 * q + 0] = xv[c * 8 + 4 * q + 0] * rinv * gg.x * (1.f + sc.x) + sh.x;
        o[4 * q + 1] = xv[c * 8 + 4 * q + 1] * rinv * gg.y * (1.f + sc.y) + sh.y;
        o[4 * q + 2] = xv[c * 8 + 4 * q + 2] * rinv * gg.z * (1.f + sc.z) + sh.z;
        o[4 * q + 3] = xv[c * 8 + 4 * q + 3] * rinv * gg.w * (1.f + sc.w) + sh.w;
      }
      uint4 ov; ov.x = pk2(o[0], o[1]); ov.y = pk2(o[2], o[3]); ov.z = pk2(o[4], o[5]); ov.w = pk2(o[6], o[7]);
      *(uint4*)(dst + (size_t)t * LDH + d0) = ov;
    }
  }
}

DI void store_tile_bf16_lds(f32x16 (&acc)[4], char* wsm, u16* dst0, size_t ld, int lane) {
  const int h = lane >> 5, r = lane & 31;
#pragma unroll
  for (int c = 0; c < 4; ++c)
#pragma unroll
    for (int gq = 0; gq < 4; ++gq) {
      uint2 v; v.x = pk2(acc[c][4 * gq], acc[c][4 * gq + 1]); v.y = pk2(acc[c][4 * gq + 2], acc[c][4 * gq + 3]);
      *(uint2*)(wsm + r * 272 + (32 * c + 8 * gq + 4 * h) * 2) = v;
    }
#pragma unroll
  for (int j = 0; j < 8; ++j) {
    const int idx = lane + 64 * j, row = idx >> 4, c16 = idx & 15;
    const u32x4 v = *(const u32x4*)(wsm + row * 272 + c16 * 16);
    *(u32x4*)(dst0 + (size_t)row * ld + c16 * 8) = v;
  }
}

template <class AddrFn>
DI void store_rows_bf16_lds(f32x16 (&acc)[4], char* wsm, int lane, AddrFn addr) {
  const int h = lane >> 5, r = lane & 31;
#pragma unroll
  for (int c = 0; c < 4; ++c)
#pragma unroll
    for (int gq = 0; gq < 4; ++gq) {
      uint2 v; v.x = pk2(acc[c][4 * gq], acc[c][4 * gq + 1]); v.y = pk2(acc[c][4 * gq + 2], acc[c][4 * gq + 3]);
      *(uint2*)(wsm + r * 272 + (32 * c + 8 * gq + 4 * h) * 2) = v;
    }
#pragma unroll
  for (int j = 0; j < 8; ++j) {
    const int idx = lane + 64 * j, row = idx >> 4, c16 = idx & 15;
    const u32x4 v = *(const u32x4*)(wsm + row * 272 + c16 * 16);
    *(u32x4*)addr(row, c16) = v;
  }
}

DI void phase_qkv(const Params& p, char* smem) {
  const int G = lgdim();
  const u16* proj = (const u16*)(p.ws + OFF_PROJ);
  const float2* rope = (const float2*)(p.ws + OFF_ROPE);
  u16* Qm = (u16*)(p.ws + OFF_QM); u16* Km = (u16*)(p.ws + OFF_KM); u16* Vm = (u16*)(p.ws + OFF_VM);
  u16* Qd = (u16*)(p.ws + OFF_QD); u16* Kd = (u16*)(p.ws + OFF_KD);
  const float QS = 0.07216878364870322f * LOG2E;
  xcd_tiles(p.ws, 1, 3, [&](int tt, int ft2) __attribute__((always_inline)) {
    const float* qg = p.in[10];
    gemm_tile<384, true>((const u16*)(p.ws + OFF_WQ), 768, ft2 * 256, proj, NPROJ, (size_t)tt * 256, smem,
      [&](f32x16 (&acc)[4], float ss, int t, int h, int wf, char* wbase, int tg) __attribute__((always_inline)) {
        const int ft = ft2 * 2 + wf;
        const float rinv = rsqrtf(ss * (1.f / 384.f) + EPS);
        const int lane = ltid() & 63, tg0 = t & ~31, b = tg0 >> 12, s0 = tg0 & 4095, s = t & 4095;
        char* wsm = wbase + tg * 8704;
        if (ft < 4) {
          float s2 = 0.f;
#pragma unroll
          for (int c = 0; c < 4; ++c)
#pragma unroll
            for (int k = 0; k < 16; ++k) { float v = acc[c][k] * rinv; s2 += v * v; }
          s2 = xsum32(s2);
          const float r2 = rsqrtf(s2 * (1.f / 128.f) + EPS) * rinv * QS;
#pragma unroll
          for (int c = 0; c < 4; ++c)
#pragma unroll
            for (int gq = 0; gq < 4; ++gq) {
              const int d = 32 * c + 8 * gq + 4 * h;
              float4 gg = *(const float4*)(qg + d);
              acc[c][4 * gq] *= r2 * gg.x; acc[c][4 * gq + 1] *= r2 * gg.y;
              acc[c][4 * gq + 2] *= r2 * gg.z; acc[c][4 * gq + 3] *= r2 * gg.w;
            }
          u16* base = Qm + ((size_t)(b * 4 + ft) * S_ + s0) * 192;
          store_rows_bf16_lds(acc, wsm, lane, [&](int row, int c16) __attribute__((always_inline)) { return base + (size_t)row * 192 + c16 * 8; });
        } else {
#pragma unroll
          for (int cp = 0; cp < 2; ++cp) {
            float s2 = 0.f;
#pragma unroll
            for (int k = 0; k < 16; ++k) {
              float v1 = acc[2 * cp][k] * rinv, v2 = acc[2 * cp + 1][k] * rinv;
              s2 += v1 * v1 + v2 * v2;
            }
            s2 = xsum32(s2);
            const float r2 = rsqrtf(s2 * (1.f / 64.f) + EPS) * rinv;
#pragma unroll
            for (int gq = 0; gq < 4; ++gq) {
              const int j = 8 * gq + 4 * h;
              float4 g1 = *(const float4*)(qg + 128 + j), g2 = *(const float4*)(qg + 160 + j);
              const float4* rp = (const float4*)(rope + s * 32 + j);
              float4 cs01 = rp[0], cs23 = rp[1];
              float x1, x2;
              x1 = acc[2 * cp][4 * gq + 0] * r2 * g1.x; x2 = acc[2 * cp + 1][4 * gq + 0] * r2 * g2.x;
              acc[2 * cp][4 * gq + 0] = (x1 * cs01.x - x2 * cs01.y) * QS; acc[2 * cp + 1][4 * gq + 0] = (x2 * cs01.x + x1 * cs01.y) * QS;
              x1 = acc[2 * cp][4 * gq + 1] * r2 * g1.y; x2 = acc[2 * cp + 1][4 * gq + 1] * r2 * g2.y;
              acc[2 * cp][4 * gq + 1] = (x1 * cs01.z - x2 * cs01.w) * QS; acc[2 * cp + 1][4 * gq + 1] = (x2 * cs01.z + x1 * cs01.w) * QS;
              x1 = acc[2 * cp][4 * gq + 2] * r2 * g1.z; x2 = acc[2 * cp + 1][4 * gq + 2] * r2 * g2.z;
              acc[2 * cp][4 * gq + 2] = (x1 * cs23.x - x2 * cs23.y) * QS; acc[2 * cp + 1][4 * gq + 2] = (x2 * cs23.x + x1 * cs23.y) * QS;
              x1 = acc[2 * cp][4 * gq + 3] * r2 * g1.w; x2 = acc[2 * cp + 1][4 * gq + 3] * r2 * g2.w;
              acc[2 * cp][4 * gq + 3] = (x1 * cs23.z - x2 * cs23.w) * QS; acc[2 * cp + 1][4 * gq + 3] = (x2 * cs23.z + x1 * cs23.w) * QS;
            }
          }
          u16* base = Qm + ((size_t)(b * 4 + (ft - 4) * 2) * S_ + s0) * 192 + 128;
          store_rows_bf16_lds(acc, wsm, lane, [&](int row, int c16) __attribute__((always_inline)) {
            return base + (size_t)(c16 >> 3) * S_ * 192 + (size_t)row * 192 + (c16 & 7) * 8; });
        }
      });
  });
  xcd_tiles(p.ws, 2, 4, [&](int tt, int ft2) __attribute__((always_inline)) {
    const float* kg = p.in[11];
    gemm_tile<256, true>((const u16*)(p.ws + OFF_WKV), 1024, ft2 * 256, proj + 384, NPROJ, (size_t)tt * 256, smem,
      [&](f32x16 (&acc)[4], float ss, int t, int h, int wf, char* wbase, int tg) __attribute__((always_inline)) {
        const int ft = ft2 * 2 + wf;
        const float rinv = rsqrtf(ss * (1.f / 256.f) + EPS);
        const int lane = ltid() & 63, tg0 = t & ~31, b = tg0 >> 12, s0 = tg0 & 4095;
        char* wsm = wbase + tg * 8704;
        if (ft < 4) {
          float s2 = 0.f;
#pragma unroll
          for (int c = 0; c < 4; ++c)
#pragma unroll
            for (int k = 0; k < 16; ++k) { float v = acc[c][k] * rinv; s2 += v * v; }
          s2 = xsum32(s2);
          const float r2 = rsqrtf(s2 * (1.f / 128.f) + EPS) * rinv;
#pragma unroll
          for (int c = 0; c < 4; ++c)
#pragma unroll
            for (int gq = 0; gq < 4; ++gq) {
              const int d = 32 * c + 8 * gq + 4 * h;
              float4 gg = *(const float4*)(kg + d);
              acc[c][4 * gq] *= r2 * gg.x; acc[c][4 * gq + 1] *= r2 * gg.y;
              acc[c][4 * gq + 2] *= r2 * gg.z; acc[c][4 * gq + 3] *= r2 * gg.w;
            }
          u16* base = Km + ((size_t)(b * 4 + ft) * S_ + s0) * 192;
          store_rows_bf16_lds(acc, wsm, lane, [&](int row, int c16) __attribute__((always_inline)) { return base + (size_t)row * 192 + c16 * 8; });
        } else {
#pragma unroll
          for (int c = 0; c < 4; ++c)
#pragma unroll
            for (int k = 0; k < 16; ++k) acc[c][k] *= rinv;
          u16* base = Vm + ((size_t)(b * 4 + (ft - 4)) * S_ + s0) * 128;
          store_rows_bf16_lds(acc, wsm, lane, [&](int row, int c16) __attribute__((always_inline)) { return base + (size_t)row * 128 + c16 * 8; });
        }
      });
  });
  {
    const size_t gt = (size_t)lbid() * 512 + ltid(), NT = (size_t)G * 512;
    for (size_t e = gt; e < (size_t)T_ * 17; e += NT) {
      const int t = (int)(e / 17), gi = (int)(e % 17);
      const int b = t >> 12, s = t & 4095;
      const u16* src; const float* gain; float scale; u16* dst; int ncopy = 1; size_t cstride = 0;
      if (gi == 0) {
        src = proj + (size_t)t * NPROJ + 640; gain = p.in[11] + 128; scale = 1.f;
        dst = Km + ((size_t)(b * 4) * S_ + s) * 192 + 128; ncopy = 4; cstride = (size_t)S_ * 192;
      } else if (gi < 9) {
        const int j = gi - 1;
        src = proj + (size_t)t * NPROJ + 704 + j * 64; gain = p.in[12]; scale = 0.125f * LOG2E;
        dst = Qd + ((size_t)(b * 8 + j) * S_ + s) * 64;
      } else {
        const int j = gi - 9;
        src = proj + (size_t)t * NPROJ + 1216 + j * 64; gain = p.in[13]; scale = 1.f;
        dst = Kd + ((size_t)(b * 8 + j) * S_ + s) * 64;
      }
      uint4 raw[8];
#pragma unroll
      for (int q = 0; q < 8; ++q) raw[q] = ((const uint4*)src)[q];
      float ss = 0.f;
#pragma unroll
      for (int q = 0; q < 8; ++q) {
        ss = dot2bf(raw[q].x, raw[q].x, ss); ss = dot2bf(raw[q].y, raw[q].y, ss);
        ss = dot2bf(raw[q].z, raw[q].z, ss); ss = dot2bf(raw[q].w, raw[q].w, ss);
      }
      const float rinv = rsqrtf(ss * (1.f / 64.f) + EPS);
      const float rs = rinv * scale;
#pragma unroll
      for (int q = 0; q < 4; ++q) {
        const unsigned lo[4] = {raw[q].x, raw[q].y, raw[q].z, raw[q].w};
        const unsigned hi[4] = {raw[q + 4].x, raw[q + 4].y, raw[q + 4].z, raw[q + 4].w};
        unsigned o1[4], o2[4];
#pragma unroll
        for (int e2 = 0; e2 < 4; ++e2) {
          const int k = 8 * q + 2 * e2;
          const float4 cs = *(const float4*)(rope + s * 32 + k);
          const float2 ga = *(const float2*)(gain + k), gb = *(const float2*)(gain + 32 + k);
          float x1a = bflo(lo[e2]) * rs * ga.x, x2a = bflo(hi[e2]) * rs * gb.x;
          float x1b = bfhi(lo[e2]) * rs * ga.y, x2b = bfhi(hi[e2]) * rs * gb.y;
          o1[e2] = pk2(x1a * cs.x - x2a * cs.y, x1b * cs.z - x2b * cs.w);
          o2[e2] = pk2(x2a * cs.x + x1a * cs.y, x2b * cs.z + x1b * cs.w);
        }
        uint4 v1 = make_uint4(o1[0], o1[1], o1[2], o1[3]), v2 = make_uint4(o2[0], o2[1], o2[2], o2[3]);
        for (int cpy = 0; cpy < ncopy; ++cpy) {
          ((uint4*)(dst + cpy * cstride))[q] = v1;
          ((uint4*)(dst + cpy * cstride))[q + 4] = v2;
        }
      }
    }
  }
}

template <int NS, int RSK, bool QLDS>
DI void qk_softmax32(const char* kbuf, const bf16x8 (&qf)[NS], const char* qlds, bool needmask, int keybase, int qrow, int h, int r,
                     float& mrun, float& lrun, f32x16 (&O)[4], bf16x8& pf0, bf16x8& pf1) {
  f32x16 sacc;
#pragma unroll
  for (int i = 0; i < 16; ++i) sacc[i] = 0.f;
#pragma unroll
  for (int s = 0; s < NS; ++s) {
    bf16x8 a = *(const bf16x8*)(kbuf + r * RSK + (16 * s + 8 * h) * 2);
    bf16x8 bq;
    if (QLDS) bq = *(const bf16x8*)(qlds + (16 * s + 8 * h) * 2); else bq = qf[s];
    sacc = MFMA(a, bq, sacc);
  }
  if (needmask) {
#pragma unroll
    for (int i = 0; i < 16; ++i) {
      const int key = keybase + 8 * (i >> 2) + 4 * h + (i & 3);
      if (key > qrow) sacc[i] = NEG_INF;
    }
  }
  float mx = sacc[0];
#pragma unroll
  for (int i = 1; i < 16; ++i) mx = fmaxf(mx, sacc[i]);
  mx = xmax32(mx);
  if (__builtin_amdgcn_ballot_w64(mx > mrun + 8.f) != 0ull) {
    const float mnew = fmaxf(mrun, mx);
    const float alpha = __builtin_amdgcn_exp2f(mrun - mnew);
    mrun = mnew;
    lrun *= alpha;
#pragma unroll
    for (int c = 0; c < 4; ++c)
#pragma unroll
      for (int i = 0; i < 16; ++i) O[c][i] *= alpha;
  }
  float rs = 0.f;
#pragma unroll
  for (int i = 0; i < 16; ++i) {
    float pv = __builtin_amdgcn_exp2f(sacc[i] - mrun);
    rs += pv; sacc[i] = pv;
  }
  lrun += rs;
  uint4 pa, pb;
  pa.x = pk2(sacc[0], sacc[1]); pa.y = pk2(sacc[2], sacc[3]); pa.z = pk2(sacc[4], sacc[5]); pa.w = pk2(sacc[6], sacc[7]);
  pb.x = pk2(sacc[8], sacc[9]); pb.y = pk2(sacc[10], sacc[11]); pb.z = pk2(sacc[12], sacc[13]); pb.w = pk2(sacc[14], sacc[15]);
  pf0 = __builtin_bit_cast(bf16x8, pa);
  pf1 = __builtin_bit_cast(bf16x8, pb);
}

template <int DQK, int NMAP>
DI void attn_item(const u16* __restrict__ qb0, const u16* __restrict__ qb1, const u16* __restrict__ kb0,
                  const u16* __restrict__ kb1, const u16* __restrict__ vb, int vstride, int qblk,
                  u16* __restrict__ outp, const float* __restrict__ lamp, const float* __restrict__ subg, char* smem) {
  constexpr int NS = DQK / 16;
  constexpr int RSK = DQK * 2 + 16;
  constexpr int KTILE = 64 * RSK;
  constexpr int VOFF = NMAP * KTILE;
  constexpr int STAGE = VOFF + 64 * 320;
  constexpr int CPR = DQK / 8;
  constexpr int KCH = NMAP * 64 * CPR / 512;
  int tid_ = ltid();
  asm volatile("" : "+v"(tid_));
  const int tid = tid_, lane = tid & 63, w = tid >> 6, h = lane >> 5, r = lane & 31;
  const int blk = (lane >> 4) & 1, q4 = (lane & 15) >> 2, p4 = lane & 3;
  const int q0 = qblk * 256, wrow0 = q0 + 32 * w, qrow = wrow0 + r;
  const int nt = 4 * (qblk + 1);

  constexpr bool QL = (NMAP == 2);
  bf16x8 qfa[NS];
  if (!QL) {
#pragma unroll
    for (int s = 0; s < NS; ++s) qfa[s] = *(const bf16x8*)(qb0 + (size_t)qrow * DQK + 16 * s + 8 * h);
  } else {
#pragma unroll
    for (int s = 0; s < NS; ++s) qfa[s] = bf16x8{0, 0, 0, 0, 0, 0, 0, 0};
#pragma unroll
    for (int i = 0; i < 8; ++i) {
      const int id = tid + 512 * i, mp = id >> 11, rem = id & 2047, row = rem >> 3, c16 = rem & 7;
      *(u32x4*)(smem + 2 * STAGE + mp * 36864 + row * 144 + c16 * 16) =
          *(const u32x4*)((mp ? qb1 : qb0) + (size_t)(q0 + row) * DQK + c16 * 8);
    }
  }
  const char* qla = smem + 2 * STAGE + (32 * w + r) * 144;
  const char* qlb = qla + 36864;
  f32x16 Oa[4], Ob[4];
  float ma = NEG_INF, la = 0.f, mb = NEG_INF, lb = 0.f;
#pragma unroll
  for (int c = 0; c < 4; ++c)
#pragma unroll
    for (int i = 0; i < 16; ++i) { Oa[c][i] = 0.f; if (NMAP == 2) Ob[c][i] = 0.f; }

  u32x4 rk[KCH], rv[2];
  unsigned koff[KCH], voff[2];
#pragma unroll
  for (int i = 0; i < KCH; ++i) {
    const int id = tid + 512 * i;
    if (NMAP == 1) koff[i] = (unsigned)((id / CPR) * DQK + (id % CPR) * 8);
    else koff[i] = (unsigned)((((id & 511) >> 3)) * DQK + (id & 7) * 8);
  }
#pragma unroll
  for (int i = 0; i < 2; ++i) {
    const int id = tid + 512 * i;
    voff[i] = (unsigned)((id >> 4) * vstride + (id & 15) * 8);
  }
  auto gload = [&](int t) __attribute__((always_inline)) {
    const u16* k0t = kb0 + (size_t)t * 64 * DQK;
    const u16* k1t = (NMAP == 2) ? kb1 + (size_t)t * 64 * DQK : k0t;
    const u16* vt = vb + (size_t)t * 64 * vstride;
#pragma unroll
    for (int i = 0; i < KCH; ++i) rk[i] = *(const u32x4*)(((NMAP == 2 && i) ? k1t : k0t) + koff[i]);
#pragma unroll
    for (int i = 0; i < 2; ++i) rv[i] = *(const u32x4*)(vt + voff[i]);
  };
  auto sstore = [&](char* buf) __attribute__((always_inline)) {
#pragma unroll
    for (int i = 0; i < KCH; ++i) {
      const int id = tid + 512 * i;
      if (NMAP == 1) {
        const int row = id / CPR, c16 = id % CPR;
        *(u32x4*)(buf + row * RSK + c16 * 16) = rk[i];
      } else {
        const int rem = id & 511, row = rem >> 3, c16 = rem & 7;
        *(u32x4*)(buf + i * KTILE + row * RSK + c16 * 16) = rk[i];
      }
    }
#pragma unroll
    for (int i = 0; i < 2; ++i) {
      const int id = tid + 512 * i, row = id >> 4, c16 = id & 15;
      *(u32x4*)(buf + VOFF + row * 320 + c16 * 16) = rv[i];
    }
  };

  gload(0);
  sstore(smem);
  gload(1);
  __syncthreads();
  for (int t = 0; t < nt; ++t) {
    char* buf = smem + (t & 1) * STAGE;
    if (t + 1 < nt) {
      sstore(smem + ((t + 1) & 1) * STAGE);
      if (t + 2 < nt) gload(t + 2);
    }
    const int key0 = t * 64;
#pragma unroll
    for (int sub = 0; sub < 2; ++sub) {
      const int ko = sub * 32;
      if (key0 + ko <= wrow0 + 31) {
        const bool needmask = (key0 + ko + 31 > wrow0);
        bf16x8 pa0, pa1, pb0, pb1;
        qk_softmax32<NS, RSK, QL>(buf + ko * RSK, qfa, qla, needmask, key0 + ko, qrow, h, r, ma, la, Oa, pa0, pa1);
        if (NMAP == 2)
          qk_softmax32<NS, RSK, QL>(buf + KTILE + ko * RSK, qfa, qlb, needmask, key0 + ko, qrow, h, r, mb, lb, Ob, pb0, pb1);
#pragma unroll
        for (int ks = 0; ks < 2; ++ks)
#pragma unroll
          for (int c = 0; c < 4; ++c) {
            const char* ap = buf + VOFF + (ko + 16 * ks + 4 * h + q4) * 320 + (32 * c + 16 * blk) * 2 + 8 * p4;
            s16x4 lo = trread(ap), hi = trread(ap + 8 * 320);
            bf16x8 a = __builtin_shufflevector(lo, hi, 0, 1, 2, 3, 4, 5, 6, 7);
            Oa[c] = MFMA(a, ks ? pa1 : pa0, Oa[c]);
            if (NMAP == 2) Ob[c] = MFMA(a, ks ? pb1 : pb0, Ob[c]);
          }
      }
    }
    __syncthreads();
  }
  const float inva = 1.f / xsum32(la);
  if (NMAP == 1) {
#pragma unroll
    for (int c = 0; c < 4; ++c)
#pragma unroll
      for (int i = 0; i < 16; ++i) Oa[c][i] *= inva;
  } else {
    const float li = *lamp / xsum32(lb);
    float s2 = 0.f;
#pragma unroll
    for (int c = 0; c < 4; ++c)
#pragma unroll
      for (int i = 0; i < 16; ++i) {
        float v = Oa[c][i] * inva - li * Ob[c][i];
        Oa[c][i] = v; s2 += v * v;
      }
    s2 = xsum32(s2);
    const float rn = rsqrtf(s2 * (1.f / 128.f) + EPS) * 0.8f;
#pragma unroll
    for (int c = 0; c < 4; ++c)
#pragma unroll
      for (int gq = 0; gq < 4; ++gq) {
        const int d = 32 * c + 8 * gq + 4 * h;
        asm volatile("" ::: "memory");
        float4 gg = *(const float4*)(subg + d);
        Oa[c][4 * gq] *= rn * gg.x; Oa[c][4 * gq + 1] *= rn * gg.y; Oa[c][4 * gq + 2] *= rn * gg.z; Oa[c][4 * gq + 3] *= rn * gg.w;
      }
  }
  {
    u16* base = outp + (size_t)wrow0 * LDH;
    store_rows_bf16_lds(Oa, smem + w * 8704, lane, [&](int row, int c16) __attribute__((always_inline)) { return base + (size_t)row * LDH + c16 * 8; });
  }
  __syncthreads();
}

DI void conv_table_slice(const float* __restrict__ src, uint2* __restrict__ dst, float scale, int slice, int nslices) {
  const size_t groups = (size_t)16384 * 1024 / 16;
  const size_t gt = (size_t)lbid() * 512 + ltid(), NT = (size_t)lgdim() * 512;
  const size_t lo = groups * slice / nslices, hi = groups * (slice + 1) / nslices;
  for (size_t i = lo + gt; i < hi; i += NT) {
    const float4* sp = (const float4*)src + 4 * i;
    float4 a0 = sp[0], a1 = sp[1], a2 = sp[2], a3 = sp[3];
    unsigned w0 = 0, w1 = 0;
    w0 = __builtin_amdgcn_cvt_scalef32_pk_fp4_f32(w0, a0.x * scale, a0.y * scale, 1.0f, 0);
    w0 = __builtin_amdgcn_cvt_scalef32_pk_fp4_f32(w0, a0.z * scale, a0.w * scale, 1.0f, 1);
    w0 = __builtin_amdgcn_cvt_scalef32_pk_fp4_f32(w0, a1.x * scale, a1.y * scale, 1.0f, 2);
    w0 = __builtin_amdgcn_cvt_scalef32_pk_fp4_f32(w0, a1.z * scale, a1.w * scale, 1.0f, 3);
    w1 = __builtin_amdgcn_cvt_scalef32_pk_fp4_f32(w1, a2.x * scale, a2.y * scale, 1.0f, 0);
    w1 = __builtin_amdgcn_cvt_scalef32_pk_fp4_f32(w1, a2.z * scale, a2.w * scale, 1.0f, 1);
    w1 = __builtin_amdgcn_cvt_scalef32_pk_fp4_f32(w1, a3.x * scale, a3.y * scale, 1.0f, 2);
    w1 = __builtin_amdgcn_cvt_scalef32_pk_fp4_f32(w1, a3.z * scale, a3.w * scale, 1.0f, 3);
    dst[i] = make_uint2(w0, w1);
  }
}

DI void phase_attn(const Params& p, char* smem) {
  const int G = lgdim(), g = lbid();
  const u16* Qm = (const u16*)(p.ws + OFF_QM); const u16* Km = (const u16*)(p.ws + OFF_KM);
  const u16* Vm = (const u16*)(p.ws + OFF_VM); const u16* Qd = (const u16*)(p.ws + OFF_QD);
  const u16* Kd = (const u16*)(p.ws + OFF_KD); const u16* proj = (const u16*)(p.ws + OFF_PROJ);
  u16* mixed = (u16*)(p.ws + OFF_H);
  const float* lamp = (const float*)(p.ws + OFF_LAM);
  const int nrounds = (2048 + G - 1) / G;
  for (int k = 0; k * G < 2048; ++k) {
    conv_table_slice(p.in[23], (uint2*)(p.ws + OFF_U), U_SCALE, k, nrounds);
    conv_table_slice(p.in[24], (uint2*)(p.ws + OFF_V), V_SCALE, k, nrounds);
    const int idx = (k & 1) ? k * G + (G - 1 - g) : k * G + g;
    if (idx >= 2048) continue;
    const int level = idx >> 7, qblk = 15 - level, j = idx & 127, type = j & 1, bh = j >> 1;
    const int b = bh >> 2, hd = bh & 3;
    if (type == 0) {
      const size_t ho = (size_t)(b * 4 + hd) * S_;
      attn_item<192, 1>(Qm + ho * 192, nullptr, Km + ho * 192, nullptr, Vm + ho * 128, 128, qblk,
                        mixed + (size_t)b * S_ * LDH + hd * 128, lamp, nullptr, smem);
    } else {
      const size_t h0 = (size_t)(b * 8 + 2 * hd) * S_ * 64, h1 = h0 + (size_t)S_ * 64;
      attn_item<64, 2>(Qd + h0, Qd + h1, Kd + h0, Kd + h1, proj + (size_t)b * S_ * NPROJ + 1728 + hd * 128, NPROJ,
                       qblk, mixed + (size_t)b * S_ * LDH + 512 + hd * 128, lamp, p.in[18], smem);
    }
  }
}

template <int ST>
DI void ins1(float (&T)[16], float s) {
#pragma unroll
  for (int j = 15; j > ST; --j) T[j] = __builtin_amdgcn_fmed3f(T[j - 1], s, T[j]);
  T[ST] = fmaxf(T[ST], s);
}
DI void peer_scores_top16(const char* sk, const u16* __restrict__ pqrow, int lane, float (&T)[16]) {
  const int h = lane >> 5, r = lane & 31;
  bf16x8 bq[8];
#pragma unroll
  for (int s = 0; s < 8; ++s) bq[s] = *(const bf16x8*)(pqrow + 16 * s + 8 * h);
#pragma unroll
  for (int j = 0; j < 16; ++j) T[j] = NEG_INF;
#pragma unroll
  for (int c = 0; c < 4; ++c) {
    f32x16 acc;
#pragma unroll
    for (int i = 0; i < 16; ++i) acc[i] = 0.f;
#pragma unroll
    for (int s = 0; s < 8; ++s) {
      bf16x8 a = *(const bf16x8*)(sk + (32 * c + r) * 272 + (16 * s + 8 * h) * 2);
      acc = MFMA(a, bq[s], acc);
    }
#pragma unroll
    for (int i = 0; i < 16; ++i) {
      const unsigned code = (unsigned)(127 - 32 * c - (i & 3) - 8 * (i >> 2)) - 4u * (unsigned)h;
      ins1<0>(T, __uint_as_float((__float_as_uint(acc[i]) & 0xffffff80u) | code));
    }
  }
  float o[16];
#pragma unroll
  for (int j = 0; j < 16; ++j) {
    auto rr = __builtin_amdgcn_permlane32_swap(__float_as_uint(T[j]), __float_as_uint(T[j]), false, false);
    o[j] = __uint_as_float(h ? rr[0] : rr[1]);
  }
  ins1<0>(T, o[0]); ins1<1>(T, o[1]); ins1<2>(T, o[2]); ins1<3>(T, o[3]);
  ins1<4>(T, o[4]); ins1<5>(T, o[5]); ins1<6>(T, o[6]); ins1<7>(T, o[7]);
  ins1<8>(T, o[8]); ins1<9>(T, o[9]); ins1<10>(T, o[10]); ins1<11>(T, o[11]);
  ins1<12>(T, o[12]); ins1<13>(T, o[13]); ins1<14>(T, o[14]); ins1<15>(T, o[15]);
}

DI float gelu_exact(float x) { return 0.5f * x * (1.f + erff(x * 0.7071067811865476f)); }

DI void load_sk(char* smem, const u16* SK, int hp, int tid) {
#pragma unroll
  for (int i = 0; i < 4; ++i) {
    const int id = tid + 512 * i, row = id >> 4, c16 = id & 15;
    *(u32x4*)(smem + row * 272 + c16 * 16) = *(const u32x4*)(SK + (size_t)hp * 16384 + row * 128 + c16 * 8);
  }
}

DI void peer_route(const Params& p, char* smem, int t0) {
  const int tid = ltid(), lane = tid & 63, w = tid >> 6, h = lane >> 5, r = lane & 31;
  const u16* pq = (const u16*)(p.ws + OFF_PROJ);
  const u16* SK = (const u16*)(p.ws + OFF_SK);
  uint2* topk = (uint2*)(p.ws + OFF_TOPK);
    const int tq = t0 + 32 * w + r;
#pragma unroll 1
    for (int hd = 0; hd < 8; ++hd) {
      float TA[16], TB[16];
      __syncthreads();
      load_sk(smem, SK, hd * 2, tid);
      __syncthreads();
      peer_scores_top16(smem, pq + (size_t)tq * 2048 + (hd * 2) * 128, lane, TA);
      __syncthreads();
      load_sk(smem, SK, hd * 2 + 1, tid);
      __syncthreads();
      peer_scores_top16(smem, pq + (size_t)tq * 2048 + (hd * 2 + 1) * 128, lane, TB);
      float FK[16];
#pragma unroll
      for (int j = 0; j < 16; ++j) FK[j] = NEG_INF;
#pragma unroll
      for (int i = 0; i < 16; ++i)
#pragma unroll
        for (int j = 0; j < 16; ++j)
          if ((i + 1) * (j + 1) <= 16) {
            const float cv = __uint_as_float(__float_as_uint(TA[i]) & 0xffffff80u) + __uint_as_float(__float_as_uint(TB[j]) & 0xffffff80u);
            const float key = __uint_as_float((__float_as_uint(cv) & 0xffffff00u) | (unsigned)(255 - (16 * i + j)));
            const int st = (i + 1) * (j + 1) - 1;
#pragma unroll
            for (int q = 15; q >= 1; --q)
              if (q > st) FK[q] = __builtin_amdgcn_fmed3f(FK[q - 1], key, FK[q]);
            FK[st] = fmaxf(FK[st], key);
          }
      float FV[16]; int FI[16];
#pragma unroll
      for (int m = 0; m < 16; ++m) {
        const unsigned kb = __float_as_uint(FK[m]);
        const int code = 255 - (int)(kb & 255u), ci = code >> 4, cj = code & 15;
        FV[m] = __uint_as_float(kb & 0xffffff00u);
        float ra = TA[0], rb = TB[0];
#pragma unroll
        for (int q = 1; q < 16; ++q) { ra = (ci == q) ? TA[q] : ra; rb = (cj == q) ? TB[q] : rb; }
        FI[m] = (127 - (int)(__float_as_uint(ra) & 127u)) * 128 + (127 - (int)(__float_as_uint(rb) & 127u));
      }
      float e[16], sum = 0.f;
#pragma unroll
      for (int j = 0; j < 16; ++j) { e[j] = expf(FV[j] - FV[0]); sum += e[j]; }
      const float rs = 1.f / sum;
      if (h == 0) {
        u32x4* dst = (u32x4*)(topk + (size_t)tq * 128 + hd * 16);
#pragma unroll
        for (int q = 0; q < 8; ++q) {
          u32x4 o;
          o.x = (unsigned)FI[2 * q]; o.y = __float_as_uint(e[2 * q] * rs);
          o.z = (unsigned)FI[2 * q + 1]; o.w = __float_as_uint(e[2 * q + 1] * rs);
          dst[q] = o;
        }
      }
    }
}

DI void peer_gather(const Params& p, int t0) {
  const int tid = ltid(), lane = tid & 63, w = tid >> 6;
  const uint2* topk = (const uint2*)(p.ws + OFF_TOPK);
  const float* mod = (const float*)(p.ws + OFF_MOD);
  const unsigned char* U8 = (const unsigned char*)(p.ws + OFF_U);
  const unsigned char* V8 = (const unsigned char*)(p.ws + OFF_V);
#pragma unroll 1
  for (int ti = 0; ti < 32; ++ti) {
    const int t = t0 + 32 * w + ti, b = t >> 12;
    const float* mb = mod + b * 6144;
    float* orow = p.out + (size_t)t * 1024 + lane * 16;
    f32x2 xr[8];
#pragma unroll
    for (int q = 0; q < 4; ++q) {
      float4 a = ((const float4*)orow)[q];
      xr[2 * q] = f32x2{a.x, a.y}; xr[2 * q + 1] = f32x2{a.z, a.w};
    }
    float ss = 0.f;
#pragma unroll
    for (int i = 0; i < 8; ++i) ss += xr[i].x * xr[i].x + xr[i].y * xr[i].y;
    ss = wave_sum(ss);
    const float rinv = rsqrtf(ss * (1.f / 1024.f) + EPS);
    f32x2 hf[8];
#pragma unroll
    for (int q = 0; q < 4; ++q) {
      const int d0 = lane * 16 + 4 * q;
      float4 gg = *(const float4*)(p.in[20] + d0);
      float4 sc = *(const float4*)(mb + 4096 + d0);
      float4 sh = *(const float4*)(mb + 3072 + d0);
      hf[2 * q] = f32x2{xr[2 * q].x * rinv * gg.x * (1.f + sc.x) + sh.x, xr[2 * q].y * rinv * gg.y * (1.f + sc.y) + sh.y};
      hf[2 * q + 1] = f32x2{xr[2 * q + 1].x * rinv * gg.z * (1.f + sc.z) + sh.z, xr[2 * q + 1].y * rinv * gg.w * (1.f + sc.w) + sh.w};
    }
    const u32x4 tk = *(const u32x4*)(topk + (size_t)t * 128 + lane * 2);
    f32x2 y[8];
#pragma unroll
    for (int i = 0; i < 8; ++i) y[i] = f32x2{0.f, 0.f};
    uint2 ua[16], va[16], ub[16], vb[16];
    float gA, gB;
    auto issue = [&](int jj, uint2 (&uu)[16], uint2 (&vv)[16], float& gsel) __attribute__((always_inline)) {
      float gs = 0.f;
#pragma unroll
      for (int k = 0; k < 16; ++k) {
        const int l = 8 * jj + (k >> 1);
        const int e = __builtin_amdgcn_readlane((int)((k & 1) ? tk.z : tk.x), l);
        const float g = __uint_as_float(__builtin_amdgcn_readlane((int)((k & 1) ? tk.w : tk.y), l));
        gs = ((lane >> 2) == k) ? g : gs;
        uu[k] = *(const uint2*)(U8 + (size_t)e * 512 + lane * 8);
        vv[k] = *(const uint2*)(V8 + (size_t)e * 512 + lane * 8);
      }
      gsel = gs;
    };
    auto process = [&](const uint2 (&uu)[16], const uint2 (&vv)[16], float gsel) __attribute__((always_inline)) {
      float d[16];
#pragma unroll
      for (int k = 0; k < 16; ++k) {
        f32x2 a2 = f32x2{0.f, 0.f};
        a2 = __builtin_amdgcn_cvt_scalef32_pk_f32_fp4(uu[k].x, 1.0f, 0) * hf[0] + a2;
        a2 = __builtin_amdgcn_cvt_scalef32_pk_f32_fp4(uu[k].x, 1.0f, 1) * hf[1] + a2;
        a2 = __builtin_amdgcn_cvt_scalef32_pk_f32_fp4(uu[k].x, 1.0f, 2) * hf[2] + a2;
        a2 = __builtin_amdgcn_cvt_scalef32_pk_f32_fp4(uu[k].x, 1.0f, 3) * hf[3] + a2;
        a2 = __builtin_amdgcn_cvt_scalef32_pk_f32_fp4(uu[k].y, 1.0f, 0) * hf[4] + a2;
        a2 = __builtin_amdgcn_cvt_scalef32_pk_f32_fp4(uu[k].y, 1.0f, 1) * hf[5] + a2;
        a2 = __builtin_amdgcn_cvt_scalef32_pk_f32_fp4(uu[k].y, 1.0f, 2) * hf[6] + a2;
        a2 = __builtin_amdgcn_cvt_scalef32_pk_f32_fp4(uu[k].y, 1.0f, 3) * hf[7] + a2;
        d[k] = a2.x + a2.y;
      }
      const bool h32 = (lane & 32) != 0, h16 = (lane & 16) != 0, h8 = (lane & 8) != 0, h4 = (lane & 4) != 0;
      float r8[8], r4[4], r2[2];
#pragma unroll
      for (int i = 0; i < 8; ++i) r8[i] = swapsum32(d[i], d[8 + i]);
#pragma unroll
      for (int i = 0; i < 4; ++i) r4[i] = swapsum16(r8[i], r8[4 + i]);
#pragma unroll
      for (int i = 0; i < 2; ++i) r2[i] = (h8 ? r4[2 + i] : r4[i]) + dppmov<0x128>(h8 ? r4[i] : r4[2 + i]);
      float kk = (h4 ? r2[1] : r2[0]) + dppmov<0x141>(h4 ? r2[0] : r2[1]);
      kk += dppmov<0x4E>(kk); kk += dppmov<0xB1>(kk);
      const float coefv = gsel * gelu_exact(kk * (1.f / U_SCALE)) * (1.f / V_SCALE);
#pragma unroll
      for (int k = 0; k < 16; ++k) {
        const float cf = __uint_as_float(__builtin_amdgcn_readlane((int)__float_as_uint(coefv), 4 * k));
        const f32x2 cf2 = f32x2{cf, cf};
        y[0] = __builtin_amdgcn_cvt_scalef32_pk_f32_fp4(vv[k].x, 1.0f, 0) * cf2 + y[0];
        y[1] = __builtin_amdgcn_cvt_scalef32_pk_f32_fp4(vv[k].x, 1.0f, 1) * cf2 + y[1];
        y[2] = __builtin_amdgcn_cvt_scalef32_pk_f32_fp4(vv[k].x, 1.0f, 2) * cf2 + y[2];
        y[3] = __builtin_amdgcn_cvt_scalef32_pk_f32_fp4(vv[k].x, 1.0f, 3) * cf2 + y[3];
        y[4] = __builtin_amdgcn_cvt_scalef32_pk_f32_fp4(vv[k].y, 1.0f, 0) * cf2 + y[4];
        y[5] = __builtin_amdgcn_cvt_scalef32_pk_f32_fp4(vv[k].y, 1.0f, 1) * cf2 + y[5];
        y[6] = __builtin_amdgcn_cvt_scalef32_pk_f32_fp4(vv[k].y, 1.0f, 2) * cf2 + y[6];
        y[7] = __builtin_amdgcn_cvt_scalef32_pk_f32_fp4(vv[k].y, 1.0f, 3) * cf2 + y[7];
      }
    };
    issue(0, ua, va, gA);
#pragma unroll 1
    for (int jj = 0; jj < 8; jj += 2) {
      issue(jj + 1, ub, vb, gB);
      __builtin_amdgcn_sched_barrier(0);
      process(ua, va, gA);
      __builtin_amdgcn_sched_barrier(0);
      issue((jj + 2) & 7, ua, va, gA);
      __builtin_amdgcn_sched_barrier(0);
      process(ub, vb, gB);
      __builtin_amdgcn_sched_barrier(0);
    }
#pragma unroll
    for (int q = 0; q < 4; ++q) {
      float4 g2 = *(const float4*)(mb + 5120 + lane * 16 + 4 * q);
      float4 o;
      o.x = xr[2 * q].x + g2.x * y[2 * q].x; o.y = xr[2 * q].y + g2.y * y[2 * q].y;
      o.z = xr[2 * q + 1].x + g2.z * y[2 * q + 1].x; o.w = xr[2 * q + 1].y + g2.w * y[2 * q + 1].y;
      ((float4*)orow)[q] = o;
    }
  }
}

typedef const __attribute__((address_space(4))) Params* KParamsPtr;
__global__ void __launch_bounds__(512) mega(Params p_arg) {
  __shared__ __attribute__((aligned(16))) char smem[151552];
  for (int ph = p_arg.ph_begin; ph < p_arg.ph_end; ++ph) {
    KParamsPtr kp = (KParamsPtr)__builtin_amdgcn_kernarg_segment_ptr();
    asm volatile("" : "+s"(kp));
    Params p;
#pragma unroll
    for (int i = 0; i < 25; ++i) p.in[i] = kp->in[i];
    p.out = kp->out; p.ws = kp->ws; p.ph_begin = 0; p.ph_end = 0;
    const int G = lgdim();
    if (ph == 0) {
      phase0(p, smem);
    } else if (ph == 1) {
      rownorm_phase(p, p.in[0], p.in[4], 0, 1024, (u16*)(p.ws + OFF_H));
    } else if (ph == 2) {
      u16* proj = (u16*)(p.ws + OFF_PROJ);
      xcd_tiles(p.ws, 0, 9, [&](int tt, int ft2) __attribute__((always_inline)) {
        gemm_tile<1024, false>((const u16*)(p.ws + OFF_WIN), NPROJ, ft2 * 256, (const u16*)(p.ws + OFF_H), LDH,
                               (size_t)tt * 256, smem, [&](f32x16 (&acc)[4], float, int t, int h, int wf, char* wbase, int tg) __attribute__((always_inline)) {
                                 store_tile_bf16_lds(acc, wbase + tg * 8704, proj + (size_t)(t & ~31) * NPROJ + ft2 * 256 + wf * 128, NPROJ, ltid() & 63);
                               });
      });
    } else if (ph == 3) {
      phase_qkv(p, smem);
    } else if (ph == 4) {
      phase_attn(p, smem);
    } else if (ph == 5) {
      const float* mod = (const float*)(p.ws + OFF_MOD);
      xcd_tiles(p.ws, 3, 4, [&](int tt, int ft2) __attribute__((always_inline)) {
        gemm_tile<1024, false>((const u16*)(p.ws + OFF_WOUT), 1024, ft2 * 256, (const u16*)(p.ws + OFF_H), LDH,
                               (size_t)tt * 256, smem, [&](f32x16 (&acc)[4], float, int t, int h, int wf, char* wbase, int tg) __attribute__((always_inline)) {
                                 const int ft = ft2 * 2 + wf, lane = ltid() & 63, r = lane & 31;
#pragma unroll
                                 for (int c = 0; c < 4; ++c)
#pragma unroll
                                   for (int gq = 0; gq < 4; ++gq)
                                     *(float4*)(wbase + r * 528 + (32 * c + 8 * gq + 4 * h) * 4) =
                                         make_float4(acc[c][4 * gq], acc[c][4 * gq + 1], acc[c][4 * gq + 2], acc[c][4 * gq + 3]);
                                 const int tg0 = t & ~31, b = tg0 >> 12;
#pragma unroll
                                 for (int j = 0; j < 16; ++j) {
                                   const int idx = lane + 64 * j, row = idx >> 5, c16 = idx & 31;
                                   const float4 a = *(const float4*)(wbase + row * 528 + c16 * 16);
                                   const int n = ft * 128 + c16 * 4;
                                   const size_t off = (size_t)(tg0 + row) * 1024 + n;
                                   const float4 xv = *(const float4*)(p.in[0] + off);
                                   const float4 g1 = *(const float4*)(mod + b * 6144 + 2048 + n);
                                   float4 o;
                                   o.x = xv.x + g1.x * a.x; o.y = xv.y + g1.y * a.y; o.z = xv.z + g1.z * a.z; o.w = xv.w + g1.w * a.w;
                                   *(float4*)(p.out + off) = o;
                                 }
                               });
      });
    } else if (ph == 6) {
      rownorm_phase(p, p.out, p.in[20], 3072, 4096, (u16*)(p.ws + OFF_H2));
    } else if (ph == 7) {
      u16* pq = (u16*)(p.ws + OFF_PROJ);
      xcd_tiles(p.ws, 4, 8, [&](int tt, int ft2) __attribute__((always_inline)) {
        gemm_tile<1024, false>((const u16*)(p.ws + OFF_WPQ), 2048, ft2 * 256, (const u16*)(p.ws + OFF_H2), LDH,
                               (size_t)tt * 256, smem, [&](f32x16 (&acc)[4], float, int t, int h, int wf, char* wbase, int tg) __attribute__((always_inline)) {
                                 store_tile_bf16_lds(acc, wbase + tg * 8704, pq + (size_t)(t & ~31) * 2048 + ft2 * 256 + wf * 128, 2048, ltid() & 63);
                               });
      });
    } else {
      for (int tt = lbid(); tt < 256; tt += G) {
        peer_route(p, smem, tt * 256);
        __threadfence();
        __syncthreads();
        __threadfence();
        peer_gather(p, tt * 256);
      }
    }
#if COOP
    if (ph + 1 < p_arg.ph_end) cg::this_grid().sync();
#endif
  }
}

extern "C" void kernel_launch(void* const* d_in, const int* in_sizes, int n_in, void* d_out, int out_size,
                              void* d_ws, size_t ws_size, hipStream_t stream) {
  static int grid_blocks = 0;
  if (!grid_blocks) {
    int dev = 0, cus = 0, per_cu = 0;
    hipGetDevice(&dev);
    hipDeviceGetAttribute(&cus, hipDeviceAttributeMultiprocessorCount, dev);
    hipOccupancyMaxActiveBlocksPerMultiprocessor(&per_cu, mega, 512, 0);
    if (per_cu < 1) per_cu = 1;
    if (per_cu > 1) per_cu = 1;
    grid_blocks = cus * per_cu;
  }
  Params p{};
  for (int i = 0; i < 25; ++i) p.in[i] = (const float*)d_in[i];
  p.out = (float*)d_out;
  p.ws = (char*)d_ws;
#if COOP
  p.ph_begin = 0; p.ph_end = 9;
  void* args[] = {&p};
  hipError_t e = hipLaunchCooperativeKernel((void*)mega, dim3(grid_blocks), dim3(512), args, 0, stream);
  if (e != hipSuccess) fprintf(stderr, "cooperative launch failed: %s (grid %d)\n", hipGetErrorString(e), grid_blocks);
#else
  for (int ph = 0; ph < 9; ++ph) {
    p.ph_begin = ph; p.ph_end = ph + 1;
    hipLaunchKernelGGL(mega, dim3(grid_blocks), dim3(512), 0, stream, p);
  }
#endif
}
```

```cpp
#include <hip/hip_runtime.h>
#include <hip/hip_cooperative_groups.h>
#include <cstdio>
namespace cg = cooperative_groups;

typedef unsigned short u16;
typedef short bf16x8 __attribute__((ext_vector_type(8)));
typedef short s16x4 __attribute__((ext_vector_type(4)));
typedef float f32x16 __attribute__((ext_vector_type(16)));
typedef __bf16 bf2_t __attribute__((ext_vector_type(2)));
typedef unsigned u32x4 __attribute__((ext_vector_type(4)));
#define DI __device__ __forceinline__
#define LDSP(T, p) ((__attribute__((address_space(3))) T*)(p))
#define MFMA(a, b, c) __builtin_amdgcn_mfma_f32_32x32x16_bf16((a), (b), (c), 0, 0, 0)

#ifndef COOP
#define COOP 1
#endif

constexpr int S_ = 4096, T_ = 65536, NPROJ = 2304;
constexpr int LDH = 1088;
constexpr float EPS = 1e-6f;
constexpr float LOG2E = 1.4426950408889634f;
constexpr float NEG_INF = -__builtin_inff();
constexpr float U_SCALE = 64.f, V_SCALE = 5.656854f;
typedef float f32x2 __attribute__((ext_vector_type(2)));

constexpr size_t OFF_MOD = 0;
constexpr size_t OFF_LAM = 393216;
constexpr size_t OFF_CNT = 397312;
constexpr size_t OFF_ROPE = 524288;
constexpr size_t OFF_WIN = 1572864;
constexpr size_t OFF_WQ = 6291456;
constexpr size_t OFF_WKV = 6881280;
constexpr size_t OFF_WOUT = 7405568;
constexpr size_t OFF_WPQ = 9502720;
constexpr size_t OFF_SK = 13697024;
constexpr size_t OFF_U = 16777216;
constexpr size_t OFF_V = 50331648;
constexpr size_t OFF_H = 83886080;
constexpr size_t OFF_PROJ = 226492416;
constexpr size_t OFF_QM = 528482304;
constexpr size_t OFF_KM = 629145600;
constexpr size_t OFF_VM = 729808896;
constexpr size_t OFF_QD = 796917760;
constexpr size_t OFF_KD = 864026624;
constexpr size_t OFF_H2 = OFF_QM;
constexpr size_t OFF_TOPK = OFF_VM;

struct Params {
  const float* in[25];
  float* out;
  char* ws;
  int ph_begin, ph_end;
};

DI unsigned pk2(float a, float b) {
  bf2_t r; r[0] = (__bf16)a; r[1] = (__bf16)b; return __builtin_bit_cast(unsigned, r);
}
DI float bflo(unsigned u) { return __uint_as_float(u << 16); }
DI float bfhi(unsigned u) { return __uint_as_float(u & 0xffff0000u); }
DI float dot2bf(unsigned a, unsigned b, float c) {
  return __builtin_amdgcn_fdot2_f32_bf16(__builtin_bit_cast(bf2_t, a), __builtin_bit_cast(bf2_t, b), c, false);
}
DI int lbid() { int t = blockIdx.x; asm volatile("" : "+s"(t)); return t; }
DI int lgdim() { int t = gridDim.x; asm volatile("" : "+s"(t)); return t; }
DI int ltid() { int t = threadIdx.x; asm volatile("" : "+v"(t)); return t; }
DI float xsum32(float v) {
  const unsigned u = __float_as_uint(v);
  auto r = __builtin_amdgcn_permlane32_swap(u, u, false, false);
  return __uint_as_float(r[0]) + __uint_as_float(r[1]);
}
DI float xmax32(float v) {
  const unsigned u = __float_as_uint(v);
  auto r = __builtin_amdgcn_permlane32_swap(u, u, false, false);
  return fmaxf(__uint_as_float(r[0]), __uint_as_float(r[1]));
}
DI float swapsum32(float a, float b) {
  auto r = __builtin_amdgcn_permlane32_swap(__float_as_uint(a), __float_as_uint(b), false, false);
  return __uint_as_float(r[0]) + __uint_as_float(r[1]);
}
DI float swapsum16(float a, float b) {
  auto r = __builtin_amdgcn_permlane16_swap(__float_as_uint(a), __float_as_uint(b), false, false);
  return __uint_as_float(r[0]) + __uint_as_float(r[1]);
}
template <int CTRL>
DI float dppmov(float v) {
  return __uint_as_float((unsigned)__builtin_amdgcn_update_dpp(0, (int)__float_as_uint(v), CTRL, 0xF, 0xF, true));
}
DI float wave_sum(float v) {
  v += dppmov<0x128>(v); v += dppmov<0x124>(v); v += dppmov<0x122>(v); v += dppmov<0x121>(v);
  v = swapsum16(v, v);
  return xsum32(v);
}
DI s16x4 trread(const char* p) { return __builtin_amdgcn_ds_read_tr16_b64_v4i16(LDSP(s16x4, p)); }
DI unsigned xcc_id() { return (unsigned)__builtin_amdgcn_s_getreg((3 << 11) | 20) & 0x7u; }
template <class F>
DI void xcd_tiles(char* ws, int set, int nft, F body) {
  __shared__ int sh_item;
  unsigned* cnt = (unsigned*)(ws + OFF_CNT);
  const int x0 = (int)xcc_id();
  const int per = 32 * nft;
  for (int q = 0; q < 8; ++q) {
    const int x = (x0 + q) & 7;
    for (;;) {
      __syncthreads();
      if (threadIdx.x == 0) sh_item = (int)atomicAdd(cnt + (set * 8 + x) * 32, 1u);
      __syncthreads();
      const int it = sh_item;
      if (it >= per) break;
      body(32 * x + it / nft, it % nft);
    }
  }
}

constexpr int G_ARS = 576;
constexpr int G_ASZ = 64 * G_ARS, G_BSZ = 256 * 144, G_STAGE = G_ASZ + G_BSZ;

template <int K, bool SUMSQ, class Epi>
DI void gemm_tile(const u16* __restrict__ W, int ldw, int n0, const u16* __restrict__ X, int ldx, size_t t0,
                  char* smem, Epi epi) {
  constexpr int KT = K / 64;
  const int tid = ltid(), lane = tid & 63, w = tid >> 6, h = lane >> 5, r = lane & 31;
  const int wf = w & 1, wt = w >> 1;
  const int blk = (lane >> 4) & 1, q4 = (lane & 15) >> 2, p4 = lane & 3;
  u32x4 ra[4], rb[4];
  const unsigned aoff = (unsigned)((tid >> 5) * ldw + (tid & 31) * 8), boff = (unsigned)((tid >> 3) * ldx + (tid & 7) * 8);
  const unsigned asoff = (unsigned)((tid >> 5) * G_ARS + (tid & 31) * 16), bsoff = (unsigned)(G_ASZ + (tid >> 3) * 144 + (tid & 7) * 16);
  auto gload = [&](int kt) __attribute__((always_inline)) {
    const u16* wk = W + (size_t)kt * 64 * ldw + n0;
    const u16* xk = X + t0 * (size_t)ldx + kt * 64;
#pragma unroll
    for (int i = 0; i < 4; ++i) ra[i] = *(const u32x4*)(wk + (size_t)i * 16 * ldw + aoff);
#pragma unroll
    for (int i = 0; i < 4; ++i) rb[i] = *(const u32x4*)(xk + (size_t)i * 64 * ldx + boff);
  };
  auto sstore = [&](char* buf) __attribute__((always_inline)) {
#pragma unroll
    for (int i = 0; i < 4; ++i) *(u32x4*)(buf + asoff + i * 16 * G_ARS) = ra[i];
#pragma unroll
    for (int i = 0; i < 4; ++i) *(u32x4*)(buf + bsoff + i * 64 * 144) = rb[i];
  };
  auto stage_step = [&](int s, char* nbuf, int ktl, bool dowrite, bool doload) __attribute__((always_inline)) {
    const u16* wk = W + (size_t)ktl * 64 * ldw + n0;
    const u16* xk = X + t0 * (size_t)ldx + ktl * 64;
    if (s < 2) {
#pragma unroll
      for (int i = 2 * s; i < 2 * s + 2; ++i) {
        if (dowrite) *(u32x4*)(nbuf + asoff + i * 16 * G_ARS) = ra[i];
        if (doload) ra[i] = *(const u32x4*)(wk + (size_t)i * 16 * ldw + aoff);
      }
    } else {
#pragma unroll
      for (int i = 2 * s - 4; i < 2 * s - 2; ++i) {
        if (dowrite) *(u32x4*)(nbuf + bsoff + i * 64 * 144) = rb[i];
        if (doload) rb[i] = *(const u32x4*)(xk + (size_t)i * 64 * ldx + boff);
      }
    }
  };
  f32x16 acc[2][4];
#pragma unroll
  for (int g = 0; g < 2; ++g)
#pragma unroll
    for (int c = 0; c < 4; ++c)
#pragma unroll
      for (int i = 0; i < 16; ++i) acc[g][c][i] = 0.f;
  float ss0 = 0.f, ss1 = 0.f;
  auto compute = [&](const char* buf, char* nbuf, int ktl, bool dowrite, bool doload) __attribute__((always_inline)) {
    u32x4 bfr[2][2];
    s16x4 alo[2][4], ahi[2][4];
    auto lfrag = [&](int s, int slot) __attribute__((always_inline)) {
      bfr[slot][0] = *(const u32x4*)(buf + G_ASZ + (64 * wt + r) * 144 + (16 * s + 8 * h) * 2);
      bfr[slot][1] = *(const u32x4*)(buf + G_ASZ + (64 * wt + 32 + r) * 144 + (16 * s + 8 * h) * 2);
#pragma unroll
      for (int c = 0; c < 4; ++c) {
        const char* ap = buf + (16 * s + 8 * h + q4) * G_ARS + (128 * wf + 32 * c + 16 * blk) * 2 + 8 * p4;
        alo[slot][c] = trread(ap); ahi[slot][c] = trread(ap + 4 * G_ARS);
      }
    };
    lfrag(0, 0);
#pragma unroll
    for (int s = 0; s < 4; ++s) {
      if (s < 3) lfrag(s + 1, (s + 1) & 1);
      __builtin_amdgcn_sched_barrier(0);
      const u32x4 b0r = bfr[s & 1][0], b1r = bfr[s & 1][1];
      if (SUMSQ) {
        ss0 = dot2bf(b0r.x, b0r.x, ss0); ss0 = dot2bf(b0r.y, b0r.y, ss0);
        ss0 = dot2bf(b0r.z, b0r.z, ss0); ss0 = dot2bf(b0r.w, b0r.w, ss0);
        ss1 = dot2bf(b1r.x, b1r.x, ss1); ss1 = dot2bf(b1r.y, b1r.y, ss1);
        ss1 = dot2bf(b1r.z, b1r.z, ss1); ss1 = dot2bf(b1r.w, b1r.w, ss1);
      }
      const bf16x8 b0 = __builtin_bit_cast(bf16x8, b0r), b1 = __builtin_bit_cast(bf16x8, b1r);
#pragma unroll
      for (int c = 0; c < 4; ++c) {
        const bf16x8 a = __builtin_shufflevector(alo[s & 1][c], ahi[s & 1][c], 0, 1, 2, 3, 4, 5, 6, 7);
        acc[0][c] = MFMA(a, b0, acc[0][c]);
        acc[1][c] = MFMA(a, b1, acc[1][c]);
      }
      __builtin_amdgcn_sched_barrier(0);
      stage_step(s, nbuf, ktl, dowrite, doload);
      __builtin_amdgcn_sched_barrier(0);
    }
  };
  gload(0);
  sstore(smem);
  if (KT > 1) gload(1);
  __syncthreads();
  for (int kt = 0; kt < KT; ++kt) {
    char* buf = smem + (kt & 1) * G_STAGE;
    compute(buf, smem + ((kt + 1) & 1) * G_STAGE, kt + 2, kt + 1 < KT, kt + 2 < KT);
    __syncthreads();
  }
  if (SUMSQ) { ss0 = xsum32(ss0); ss1 = xsum32(ss1); }
  epi(acc[0], ss0, (int)t0 + 64 * wt + r, h, wf, smem + w * 17408, 0);
  epi(acc[1], ss1, (int)t0 + 64 * wt + 32 + r, h, wf, smem + w * 17408, 1);
}

DI void phase0(const Params& p, char* smem) {
  const int tid = ltid(), G = lgdim(), g = lbid();
  const size_t gt = (size_t)g * 512 + tid, NT = (size_t)G * 512;
  float* mod = (float*)(p.ws + OFF_MOD);
  for (int item = g; item < 192; item += G) {
    float* sc = (float*)smem;
    float* red = sc + 16384;
    for (int i = tid; i < 16384; i += 512) { float v = p.in[1][i]; sc[i] = v / (1.f + expf(-v)); }
    __syncthreads();
    const int col = tid & 31, kg = tid >> 5, n = item * 32 + col;
    float acc[16];
#pragma unroll
    for (int b = 0; b < 16; ++b) acc[b] = 0.f;
    const float* aw = p.in[2] + (size_t)(kg * 64) * 6144 + n;
#pragma unroll 1
    for (int k0 = 0; k0 < 64; k0 += 16) {
      float wv[16];
#pragma unroll
      for (int j = 0; j < 16; ++j) wv[j] = aw[(size_t)(k0 + j) * 6144];
#pragma unroll
      for (int j = 0; j < 16; ++j)
#pragma unroll
        for (int b = 0; b < 16; ++b) acc[b] += sc[b * 1024 + kg * 64 + k0 + j] * wv[j];
    }
#pragma unroll
    for (int b = 0; b < 16; ++b) red[(kg * 16 + b) * 32 + col] = acc[b];
    __syncthreads();
    {
      const int b = tid >> 5, cc = tid & 31;
      float sum = 0.f;
#pragma unroll
      for (int k2 = 0; k2 < 16; ++k2) sum += red[(k2 * 16 + b) * 32 + cc];
      mod[b * 6144 + item * 32 + cc] = sum + p.in[3][item * 32 + cc];
    }
    __syncthreads();
  }
  if (g == 0) {
    unsigned* cnt = (unsigned*)(p.ws + OFF_CNT);
    for (int i = tid; i < 8 * 8 * 32; i += 512) cnt[i] = 0u;
  }
  if (g == 0 && tid < 64) {
    float d1 = wave_sum(p.in[14][tid] * p.in[15][tid]);
    float d2 = wave_sum(p.in[16][tid] * p.in[17][tid]);
    if (tid == 0) *(float*)(p.ws + OFF_LAM) = expf(d1) - expf(d2) + 0.2f;
  }
  {
    float2* rope = (float2*)(p.ws + OFF_ROPE);
    for (size_t i = gt; i < 131072; i += NT) {
      int j = (int)(i & 31), sp = (int)(i >> 5);
      float inv = 1.0f / powf(10000.f, (float)j / 32.f);
      float ang = (float)sp * inv, sn, cs;
      sincosf(ang, &sn, &cs);
      rope[i] = make_float2(cs, sn);
    }
  }
  {
    u16* d = (u16*)(p.ws + OFF_WIN);
    for (size_t i = gt; i < (size_t)1024 * 2304; i += NT) {
      int k = (int)(i / 2304), n = (int)(i % 2304);
      float v = (n < 2240) ? p.in[5][(size_t)k * 2240 + n] : 0.f;
      d[i] = (u16)(pk2(v, 0.f) & 0xffff);
    }
  }
  {
    u16* d = (u16*)(p.ws + OFF_WQ);
    for (size_t i = gt; i < (size_t)384 * 768; i += NT) {
      int k = (int)(i / 768), n = (int)(i % 768);
      int src = (n < 512) ? (n >> 7) * 192 + (n & 127) : ((n - 512) >> 6) * 192 + 128 + ((n - 512) & 63);
      float v = p.in[7][(size_t)k * 768 + src] * p.in[6][k];
      d[i] = (u16)(pk2(v, 0.f) & 0xffff);
    }
  }
  {
    u16* d = (u16*)(p.ws + OFF_WKV);
    for (size_t i = gt; i < (size_t)256 * 1024; i += NT) {
      int k = (int)(i >> 10), n = (int)(i & 1023);
      int src = (n < 512) ? (n >> 7) * 256 + (n & 127) : ((n - 512) >> 7) * 256 + 128 + (n & 127);
      float v = p.in[9][(size_t)k * 1024 + src] * p.in[8][k];
      d[i] = (u16)(pk2(v, 0.f) & 0xffff);
    }
  }
  auto conv8 = [&](const float* src, u16* dst, size_t n8) __attribute__((always_inline)) {
    for (size_t i = gt; i < n8; i += NT) {
      float4 a = ((const float4*)src)[2 * i], b = ((const float4*)src)[2 * i + 1];
      uint4 o; o.x = pk2(a.x, a.y); o.y = pk2(a.z, a.w); o.z = pk2(b.x, b.y); o.w = pk2(b.z, b.w);
      ((uint4*)dst)[i] = o;
    }
  };
  conv8(p.in[19], (u16*)(p.ws + OFF_WOUT), (size_t)1024 * 1024 / 8);
  conv8(p.in[21], (u16*)(p.ws + OFF_WPQ), (size_t)1024 * 2048 / 8);
  conv8(p.in[22], (u16*)(p.ws + OFF_SK), (size_t)16 * 128 * 128 / 8);
}

DI void rownorm_phase(const Params& p, const float* src, const float* gain, int sh_off, int sc_off, u16* dst) {
  const int lane = ltid() & 63;
  const int gw = lbid() * 8 + (ltid() >> 6), NW = lgdim() * 8;
  const float* mod = (const float*)(p.ws + OFF_MOD);
  for (int t = gw; t < T_; t += NW) {
    const int b = t >> 12;
    const float* mb = mod + b * 6144;
#pragma unroll
    for (int c = 0; c < 2; ++c) {
    }
    float xv[16];
#pragma unroll
    for (int c = 0; c < 2; ++c) {
      const float4* sp = (const float4*)(src + (size_t)t * 1024 + c * 512 + lane * 8);
      float4 a = sp[0], bq = sp[1];
      xv[c * 8 + 0] = a.x; xv[c * 8 + 1] = a.y; xv[c * 8 + 2] = a.z; xv[c * 8 + 3] = a.w;
      xv[c * 8 + 4] = bq.x; xv[c * 8 + 5] = bq.y; xv[c * 8 + 6] = bq.z; xv[c * 8 + 7] = bq.w;
    }
    float ss = 0.f;
#pragma unroll
    for (int i = 0; i < 16; ++i) ss += xv[i] * xv[i];
    ss = wave_sum(ss);
    const float rinv = rsqrtf(ss * (1.f / 1024.f) + EPS);
#pragma unroll
    for (int c = 0; c < 2; ++c) {
      const int d0 = c * 512 + lane * 8;
      float o[8];
#pragma unroll
      for (int q = 0; q < 2; ++q) {
        float4 gg = *(const float4*)(gain + d0 + 4 * q);
        float4 sc = *(const float4*)(mb + sc_off + d0 + 4 * q);
        float4 sh = *(const float4*)(mb + sh_off + d0 + 4 * q);
        o[4 * q + 0] = xv[c * 8 + 4 * q + 0] * rinv * gg.x * (1.f + sc.x) + sh.x;
        o[4 * q + 1] = xv[c * 8 + 4 * q + 1] * rinv * gg.y * (1.f + sc.y) + sh.y;
        o[4 * q + 2] = xv[c * 8 + 4 * q + 2] * rinv * gg.z * (1.f + sc.z) + sh.z;
        o[4 * q + 3] = xv[c * 8 + 4 * q + 3] * rinv * gg.w * (1.f + sc.w) + sh.w;
      }
      uint4 ov; ov.x = pk2(o[0], o[1]); ov.y = pk2(o[2], o[3]); ov.z = pk2(o[4], o[5]); ov.w = pk2(o[6], o[7]);
      *(uint4*)(dst + (size_t)t * LDH + d0) = ov;
    }
  }
}

DI void store_tile_bf16_lds(f32x16 (&acc)[4], char* wsm, u16* dst0, size_t ld, int lane) {
  const int h = lane >> 5, r = lane & 31;
#pragma unroll
  for (int c = 0; c < 4; ++c)
#pragma unroll
    for (int gq = 0; gq < 4; ++gq) {
      uint2 v; v.x = pk2(acc[c][4 * gq], acc[c][4 * gq + 1]); v.y = pk2(acc[c][4 * gq + 2], acc[c][4 * gq + 3]);
      *(uint2*)(wsm + r * 272 + (32 * c + 8 * gq + 4 * h) * 2) = v;
    }
#pragma unroll
  for (int j = 0; j < 8; ++j) {
    const int idx = lane + 64 * j, row = idx >> 4, c16 = idx & 15;
    const u32x4 v = *(const u32x4*)(wsm + row * 272 + c16 * 16);
    *(u32x4*)(dst0 + (size_t)row * ld + c16 * 8) = v;
  }
}

template <class AddrFn>
DI void store_rows_bf16_lds(f32x16 (&acc)[4], char* wsm, int lane, AddrFn addr) {
  const int h = lane >> 5, r = lane & 31;
#pragma unroll
  for (int c = 0; c < 4; ++c)
#pragma unroll
    for (int gq = 0; gq < 4; ++gq) {
      uint2 v; v.x = pk2(acc[c][4 * gq], acc[c][4 * gq + 1]); v.y = pk2(acc[c][4 * gq + 2], acc[c][4 * gq + 3]);
      *(uint2*)(wsm + r * 272 + (32 * c + 8 * gq + 4 * h) * 2) = v;
    }
#pragma unroll
  for (int j = 0; j < 8; ++j) {
    const int idx = lane + 64 * j, row = idx >> 4, c16 = idx & 15;
    const u32x4 v = *(const u32x4*)(wsm + row * 272 + c16 * 16);
    *(u32x4*)addr(row, c16) = v;
  }
}

DI void phase_qkv(const Params& p, char* smem) {
  const int G = lgdim();
  const u16* proj = (const u16*)(p.ws + OFF_PROJ);
  const float2* rope = (const float2*)(p.ws + OFF_ROPE);
  u16* Qm = (u16*)(p.ws + OFF_QM); u16* Km = (u16*)(p.ws + OFF_KM); u16* Vm = (u16*)(p.ws + OFF_VM);
  u16* Qd = (u16*)(p.ws + OFF_QD); u16* Kd = (u16*)(p.ws + OFF_KD);
  const float QS = 0.07216878364870322f * LOG2E;
  xcd_tiles(p.ws, 1, 3, [&](int tt, int ft2) __attribute__((always_inline)) {
    const float* qg = p.in[10];
    gemm_tile<384, true>((const u16*)(p.ws + OFF_WQ), 768, ft2 * 256, proj, NPROJ, (size_t)tt * 256, smem,
      [&](f32x16 (&acc)[4], float ss, int t, int h, int wf, char* wbase, int tg) __attribute__((always_inline)) {
        const int ft = ft2 * 2 + wf;
        const float rinv = rsqrtf(ss * (1.f / 384.f) + EPS);
        const int lane = ltid() & 63, tg0 = t & ~31, b = tg0 >> 12, s0 = tg0 & 4095, s = t & 4095;
        char* wsm = wbase + tg * 8704;
        if (ft < 4) {
          float s2 = 0.f;
#pragma unroll
          for (int c = 0; c < 4; ++c)
#pragma unroll
            for (int k = 0; k < 16; ++k) { float v = acc[c][k] * rinv; s2 += v * v; }
          s2 = xsum32(s2);
          const float r2 = rsqrtf(s2 * (1.f / 128.f) + EPS) * rinv * QS;
#pragma unroll
          for (int c = 0; c < 4; ++c)
#pragma unroll
            for (int gq = 0; gq < 4; ++gq) {
              const int d = 32 * c + 8 * gq + 4 * h;
              float4 gg = *(const float4*)(qg + d);
              acc[c][4 * gq] *= r2 * gg.x; acc[c][4 * gq + 1] *= r2 * gg.y;
              acc[c][4 * gq + 2] *= r2 * gg.z; acc[c][4 * gq + 3] *= r2 * gg.w;
            }
          u16* base = Qm + ((size_t)(b * 4 + ft) * S_ + s0) * 192;
          store_rows_bf16_lds(acc, wsm, lane, [&](int row, int c16) __attribute__((always_inline)) { return base + (size_t)row * 192 + c16 * 8; });
        } else {
#pragma unroll
          for (int cp = 0; cp < 2; ++cp) {
            float s2 = 0.f;
#pragma unroll
            for (int k = 0; k < 16; ++k) {
              float v1 = acc[2 * cp][k] * rinv, v2 = acc[2 * cp + 1][k] * rinv;
              s2 += v1 * v1 + v2 * v2;
            }
            s2 = xsum32(s2);
            const float r2 = rsqrtf(s2 * (1.f / 64.f) + EPS) * rinv;
#pragma unroll
            for (int gq = 0; gq < 4; ++gq) {
              const int j = 8 * gq + 4 * h;
              float4 g1 = *(const float4*)(qg + 128 + j), g2 = *(const float4*)(qg + 160 + j);
              const float4* rp = (const float4*)(rope + s * 32 + j);
              float4 cs01 = rp[0], cs23 = rp[1];
              float x1, x2;
              x1 = acc[2 * cp][4 * gq + 0] * r2 * g1.x; x2 = acc[2 * cp + 1][4 * gq + 0] * r2 * g2.x;
              acc[2 * cp][4 * gq + 0] = (x1 * cs01.x - x2 * cs01.y) * QS; acc[2 * cp + 1][4 * gq + 0] = (x2 * cs01.x + x1 * cs01.y) * QS;
              x1 = acc[2 * cp][4 * gq + 1] * r2 * g1.y; x2 = acc[2 * cp + 1][4 * gq + 1] * r2 * g2.y;
              acc[2 * cp][4 * gq + 1] = (x1 * cs01.z - x2 * cs01.w) * QS; acc[2 * cp + 1][4 * gq + 1] = (x2 * cs01.z + x1 * cs01.w) * QS;
              x1 = acc[2 * cp][4 * gq + 2] * r2 * g1.z; x2 = acc[2 * cp + 1][4 * gq + 2] * r2 * g2.z;
              acc[2 * cp][4 * gq + 2] = (x1 * cs23.x - x2 * cs23.y) * QS; acc[2 * cp + 1][4 * gq + 2] = (x2 * cs23.x + x1 * cs23.y) * QS;
              x1 = acc[2 * cp][4 * gq + 3] * r2 * g1.w; x2 = acc[2 * cp + 1][4 * gq + 3] * r2 * g2.w;
              acc[2 * cp][4 * gq + 3] = (x1 * cs23.z - x2 * cs23.w) * QS; acc[2 * cp + 1][4 * gq + 3] = (x2 * cs23.z + x1 * cs23.w) * QS;
            }
          }
          u16* base = Qm + ((size_t)(b * 4 + (ft - 4) * 2) * S_ + s0) * 192 + 128;
          store_rows_bf16_lds(acc, wsm, lane, [&](int row, int c16) __attribute__((always_inline)) {
            return base + (size_t)(c16 >> 3) * S_ * 192 + (size_t)row * 192 + (c16 & 7) * 8; });
        }
      });
  });
  xcd_tiles(p.ws, 2, 4, [&](int tt, int ft2) __attribute__((always_inline)) {
    const float* kg = p.in[11];
    gemm_tile<256, true>((const u16*)(p.ws + OFF_WKV), 1024, ft2 * 256, proj + 384, NPROJ, (size_t)tt * 256, smem,
      [&](f32x16 (&acc)[4], float ss, int t, int h, int wf, char* wbase, int tg) __attribute__((always_inline)) {
        const int ft = ft2 * 2 + wf;
        const float rinv = rsqrtf(ss * (1.f / 256.f) + EPS);
        const int lane = ltid() & 63, tg0 = t & ~31, b = tg0 >> 12, s0 = tg0 & 4095;
        char* wsm = wbase + tg * 8704;
        if (ft < 4) {
          float s2 = 0.f;
#pragma unroll
          for (int c = 0; c < 4; ++c)
#pragma unroll
            for (int k = 0; k < 16; ++k) { float v = acc[c][k] * rinv; s2 += v * v; }
          s2 = xsum32(s2);
          const float r2 = rsqrtf(s2 * (1.f / 128.f) + EPS) * rinv;
#pragma unroll
          for (int c = 0; c < 4; ++c)
#pragma unroll
            for (int gq = 0; gq < 4; ++gq) {
              const int d = 32 * c + 8 * gq + 4 * h;
              float4 gg = *(const float4*)(kg + d);
              acc[c][4 * gq] *= r2 * gg.x; acc[c][4 * gq + 1] *= r2 * gg.y;
              acc[c][4 * gq + 2] *= r2 * gg.z; acc[c][4 * gq + 3] *= r2 * gg.w;
            }
          u16* base = Km + ((size_t)(b * 4 + ft) * S_ + s0) * 192;
          store_rows_bf16_lds(acc, wsm, lane, [&](int row, int c16) __attribute__((always_inline)) { return base + (size_t)row * 192 + c16 * 8; });
        } else {
#pragma unroll
          for (int c = 0; c < 4; ++c)
#pragma unroll
            for (int k = 0; k < 16; ++k) acc[c][k] *= rinv;
          u16* base = Vm + ((size_t)(b * 4 + (ft - 4)) * S_ + s0) * 128;
          store_rows_bf16_lds(acc, wsm, lane, [&](int row, int c16) __attribute__((always_inline)) { return base + (size_t)row * 128 + c16 * 8; });
        }
      });
  });
  {
    const size_t gt = (size_t)lbid() * 512 + ltid(), NT = (size_t)G * 512;
    for (size_t e = gt; e < (size_t)T_ * 17; e += NT) {
      const int t = (int)(e / 17), gi = (int)(e % 17);
      const int b = t >> 12, s = t & 4095;
      const u16* src; const float* gain; float scale; u16* dst; int ncopy = 1; size_t cstride = 0;
      if (gi == 0) {
        src = proj + (size_t)t * NPROJ + 640; gain = p.in[11] + 128; scale = 1.f;
        dst = Km + ((size_t)(b * 4) * S_ + s) * 192 + 128; ncopy = 4; cstride = (size_t)S_ * 192;
      } else if (gi < 9) {
        const int j = gi - 1;
        src = proj + (size_t)t * NPROJ + 704 + j * 64; gain = p.in[12]; scale = 0.125f * LOG2E;
        dst = Qd + ((size_t)(b * 8 + j) * S_ + s) * 64;
      } else {
        const int j = gi - 9;
        src = proj + (size_t)t * NPROJ + 1216 + j * 64; gain = p.in[13]; scale = 1.f;
        dst = Kd + ((size_t)(b * 8 + j) * S_ + s) * 64;
      }
      uint4 raw[8];
#pragma unroll
      for (int q = 0; q < 8; ++q) raw[q] = ((const uint4*)src)[q];
      float ss = 0.f;
#pragma unroll
      for (int q = 0; q < 8; ++q) {
        ss = dot2bf(raw[q].x, raw[q].x, ss); ss = dot2bf(raw[q].y, raw[q].y, ss);
        ss = dot2bf(raw[q].z, raw[q].z, ss); ss = dot2bf(raw[q].w, raw[q].w, ss);
      }
      const float rinv = rsqrtf(ss * (1.f / 64.f) + EPS);
      const float rs = rinv * scale;
#pragma unroll
      for (int q = 0; q < 4; ++q) {
        const unsigned lo[4] = {raw[q].x, raw[q].y, raw[q].z, raw[q].w};
        const unsigned hi[4] = {raw[q + 4].x, raw[q + 4].y, raw[q + 4].z, raw[q + 4].w};
        unsigned o1[4], o2[4];
#pragma unroll
        for (int e2 = 0; e2 < 4; ++e2) {
          const int k = 8 * q + 2 * e2;
          const float4 cs = *(const float4*)(rope + s * 32 + k);
          const float2 ga = *(const float2*)(gain + k), gb = *(const float2*)(gain + 32 + k);
          float x1a = bflo(lo[e2]) * rs * ga.x, x2a = bflo(hi[e2]) * rs * gb.x;
          float x1b = bfhi(lo[e2]) * rs * ga.y, x2b = bfhi(hi[e2]) * rs * gb.y;
          o1[e2] = pk2(x1a * cs.x - x2a * cs.y, x1b * cs.z - x2b * cs.w);
          o2[e2] = pk2(x2a * cs.x + x1a * cs.y, x2b * cs.z + x1b * cs.w);
        }
        uint4 v1 = make_uint4(o1[0], o1[1], o1[2], o1[3]), v2 = make_uint4(o2[0], o2[1], o2[2], o2[3]);
        for (int cpy = 0; cpy < ncopy; ++cpy) {
          ((uint4*)(dst + cpy * cstride))[q] = v1;
          ((uint4*)(dst + cpy * cstride))[q + 4] = v2;
        }
      }
    }
  }
}

template <int NS, int RSK, bool QLDS>
DI void qk_softmax32(const char* kbuf, const bf16x8 (&qf)[NS], const char* qlds, bool needmask, int keybase, int qrow, int h, int r,
                     float& mrun, float& lrun, f32x16 (&O)[4], bf16x8& pf0, bf16x8& pf1) {
  f32x16 sacc;
#pragma unroll
  for (int i = 0; i < 16; ++i) sacc[i] = 0.f;
#pragma unroll
  for (int s = 0; s < NS; ++s) {
    bf16x8 a = *(const bf16x8*)(kbuf + r * RSK + (16 * s + 8 * h) * 2);
    bf16x8 bq;
    if (QLDS) bq = *(const bf16x8*)(qlds + (16 * s + 8 * h) * 2); else bq = qf[s];
    sacc = MFMA(a, bq, sacc);
  }
  if (needmask) {
#pragma unroll
    for (int i = 0; i < 16; ++i) {
      const int key = keybase + 8 * (i >> 2) + 4 * h + (i & 3);
      if (key > qrow) sacc[i] = NEG_INF;
    }
  }
  float mx = sacc[0];
#pragma unroll
  for (int i = 1; i < 16; ++i) mx = fmaxf(mx, sacc[i]);
  mx = xmax32(mx);
  if (__builtin_amdgcn_ballot_w64(mx > mrun + 8.f) != 0ull) {
    const float mnew = fmaxf(mrun, mx);
    const float alpha = __builtin_amdgcn_exp2f(mrun - mnew);
    mrun = mnew;
    lrun *= alpha;
#pragma unroll
    for (int c = 0; c < 4; ++c)
#pragma unroll
      for (int i = 0; i < 16; ++i) O[c][i] *= alpha;
  }
  float rs = 0.f;
#pragma unroll
  for (int i = 0; i < 16; ++i) {
    float pv = __builtin_amdgcn_exp2f(sacc[i] - mrun);
    rs += pv; sacc[i] = pv;
  }
  lrun += rs;
  uint4 pa, pb;
  pa.x = pk2(sacc[0], sacc[1]); pa.y = pk2(sacc[2], sacc[3]); pa.z = pk2(sacc[4], sacc[5]); pa.w = pk2(sacc[6], sacc[7]);
  pb.x = pk2(sacc[8], sacc[9]); pb.y = pk2(sacc[10], sacc[11]); pb.z = pk2(sacc[12], sacc[13]); pb.w = pk2(sacc[14], sacc[15]);
  pf0 = __builtin_bit_cast(bf16x8, pa);
  pf1 = __builtin_bit_cast(bf16x8, pb);
}

template <int DQK, int NMAP>
DI void attn_item(const u16* __restrict__ qb0, const u16* __restrict__ qb1, const u16* __restrict__ kb0,
                  const u16* __restrict__ kb1, const u16* __restrict__ vb, int vstride, int qblk,
                  u16* __restrict__ outp, const float* __restrict__ lamp, const float* __restrict__ subg, char* smem) {
  constexpr int NS = DQK / 16;
  constexpr int RSK = DQK * 2 + 16;
  constexpr int KTILE = 64 * RSK;
  constexpr int VOFF = NMAP * KTILE;
  constexpr int STAGE = VOFF + 64 * 320;
  constexpr int CPR = DQK / 8;
  constexpr int KCH = NMAP * 64 * CPR / 512;
  int tid_ = ltid();
  asm volatile("" : "+v"(tid_));
  const int tid = tid_, lane = tid & 63, w = tid >> 6, h = lane >> 5, r = lane & 31;
  const int blk = (lane >> 4) & 1, q4 = (lane & 15) >> 2, p4 = lane & 3;
  const int q0 = qblk * 256, wrow0 = q0 + 32 * w, qrow = wrow0 + r;
  const int nt = 4 * (qblk + 1);

  constexpr bool QL = (NMAP == 2);
  bf16x8 qfa[NS];
  if (!QL) {
#pragma unroll
    for (int s = 0; s < NS; ++s) qfa[s] = *(const bf16x8*)(qb0 + (size_t)qrow * DQK + 16 * s + 8 * h);
  } else {
#pragma unroll
    for (int s = 0; s < NS; ++s) qfa[s] = bf16x8{0, 0, 0, 0, 0, 0, 0, 0};
#pragma unroll
    for (int i = 0; i < 8; ++i) {
      const int id = tid + 512 * i, mp = id >> 11, rem = id & 2047, row = rem >> 3, c16 = rem & 7;
      *(u32x4*)(smem + 2 * STAGE + mp * 36864 + row * 144 + c16 * 16) =
          *(const u32x4*)((mp ? qb1 : qb0) + (size_t)(q0 + row) * DQK + c16 * 8);
    }
  }
  const char* qla = smem + 2 * STAGE + (32 * w + r) * 144;
  const char* qlb = qla + 36864;
  f32x16 Oa[4], Ob[4];
  float ma = NEG_INF, la = 0.f, mb = NEG_INF, lb = 0.f;
#pragma unroll
  for (int c = 0; c < 4; ++c)
#pragma unroll
    for (int i = 0; i < 16; ++i) { Oa[c][i] = 0.f; if (NMAP == 2) Ob[c][i] = 0.f; }

  u32x4 rk[KCH], rv[2];
  unsigned koff[KCH], voff[2];
#pragma unroll
  for (int i = 0; i < KCH; ++i) {
    const int id = tid + 512 * i;
    if (NMAP == 1) koff[i] = (unsigned)((id / CPR) * DQK + (id % CPR) * 8);
    else koff[i] = (unsigned)((((id & 511) >> 3)) * DQK + (id & 7) * 8);
  }
#pragma unroll
  for (int i = 0; i < 2; ++i) {
    const int id = tid + 512 * i;
    voff[i] = (unsigned)((id >> 4) * vstride + (id & 15) * 8);
  }
  auto gload = [&](int t) __attribute__((always_inline)) {
    const u16* k0t = kb0 + (size_t)t * 64 * DQK;
    const u16* k1t = (NMAP == 2) ? kb1 + (size_t)t * 64 * DQK : k0t;
    const u16* vt = vb + (size_t)t * 64 * vstride;
#pragma unroll
    for (int i = 0; i < KCH; ++i) rk[i] = *(const u32x4*)(((NMAP == 2 && i) ? k1t : k0t) + koff[i]);
#pragma unroll
    for (int i = 0; i < 2; ++i) rv[i] = *(const u32x4*)(vt + voff[i]);
  };
  auto sstore = [&](char* buf) __attribute__((always_inline)) {
#pragma unroll
    for (int i = 0; i < KCH; ++i) {
      const int id = tid + 512 * i;
      if (NMAP == 1) {
        const int row = id / CPR, c16 = id % CPR;
        *(u32x4*)(buf + row * RSK + c16 * 16) = rk[i];
      } else {
        const int rem = id & 511, row = rem >> 3, c16 = rem & 7;
        *(u32x4*)(buf + i * KTILE + row * RSK + c16 * 16) = rk[i];
      }
    }
#pragma unroll
    for (int i = 0; i < 2; ++i) {
      const int id = tid + 512 * i, row = id >> 4, c16 = id & 15;
      *(u32x4*)(buf + VOFF + row * 320 + c16 * 16) = rv[i];
    }
  };

  gload(0);
  sstore(smem);
  gload(1);
  __syncthreads();
  for (int t = 0; t < nt; ++t) {
    char* buf = smem + (t & 1) * STAGE;
    if (t + 1 < nt) {
      sstore(smem + ((t + 1) & 1) * STAGE);
      if (t + 2 < nt) gload(t + 2);
    }
    const int key0 = t * 64;
#pragma unroll
    for (int sub = 0; sub < 2; ++sub) {
      const int ko = sub * 32;
      if (key0 + ko <= wrow0 + 31) {
        const bool needmask = (key0 + ko + 31 > wrow0);
        bf16x8 pa0, pa1, pb0, pb1;
        qk_softmax32<NS, RSK, QL>(buf + ko * RSK, qfa, qla, needmask, key0 + ko, qrow, h, r, ma, la, Oa, pa0, pa1);
        if (NMAP == 2)
          qk_softmax32<NS, RSK, QL>(buf + KTILE + ko * RSK, qfa, qlb, needmask, key0 + ko, qrow, h, r, mb, lb, Ob, pb0, pb1);
#pragma unroll
        for (int ks = 0; ks < 2; ++ks)
#pragma unroll
          for (int c = 0; c < 4; ++c) {
            const char* ap = buf + VOFF + (ko + 16 * ks + 4 * h + q4) * 320 + (32 * c + 16 * blk) * 2 + 8 * p4;
            s16x4 lo = trread(ap), hi = trread(ap + 8 * 320);
            bf16x8 a = __builtin_shufflevector(lo, hi, 0, 1, 2, 3, 4, 5, 6, 7);
            Oa[c] = MFMA(a, ks ? pa1 : pa0, Oa[c]);
            if (NMAP == 2) Ob[c] = MFMA(a, ks ? pb1 : pb0, Ob[c]);
          }
      }
    }
    __syncthreads();
  }
  const float inva = 1.f / xsum32(la);
  if (NMAP == 1) {
#pragma unroll
    for (int c = 0; c < 4; ++c)
#pragma unroll
      for (int i = 0; i < 16; ++i) Oa[c][i] *= inva;
  } else {
    const float li = *lamp / xsum32(lb);
    float s2 = 0.f;
#pragma unroll
    for (int c = 0; c < 4; ++c)
#pragma unroll
      for (int i = 0; i < 16; ++i) {
        float v = Oa[c][i] * inva - li * Ob[c][i];
        Oa[c][i] = v; s2 += v * v;
      }
    s2 = xsum32(s2);
    const float rn = rsqrtf(s2 * (1.f / 128.f) + EPS) * 0.8f;
#pragma unroll
    for (int c = 0; c < 4; ++c)
#pragma unroll
      for (int gq = 0; gq < 4; ++gq) {
        const int d = 32 * c + 8 * gq + 4 * h;
        asm volatile("" ::: "memory");
        float4 gg = *(const float4*)(subg + d);
        Oa[c][4 * gq] *= rn * gg.x; Oa[c][4 * gq + 1] *= rn * gg.y; Oa[c][4 * gq + 2] *= rn * gg.z; Oa[c][4 * gq + 3] *= rn * gg.w;
      }
  }
  {
    u16* base = outp + (size_t)wrow0 * LDH;
    store_rows_bf16_lds(Oa, smem + w * 8704, lane, [&](int row, int c16) __attribute__((always_inline)) { return base + (size_t)row * LDH + c16 * 8; });
  }
  __syncthreads();
}

DI void conv_table_slice(const float* __restrict__ src, uint2* __restrict__ dst, float scale, int slice, int nslices) {
  const size_t groups = (size_t)16384 * 1024 / 16;
  const size_t gt = (size_t)lbid() * 512 + ltid(), NT = (size_t)lgdim() * 512;
  const size_t lo = groups * slice / nslices, hi = groups * (slice + 1) / nslices;
  for (size_t i = lo + gt; i < hi; i += NT) {
    const float4* sp = (const float4*)src + 4 * i;
    float4 a0 = sp[0], a1 = sp[1], a2 = sp[2], a3 = sp[3];
    unsigned w0 = 0, w1 = 0;
    w0 = __builtin_amdgcn_cvt_scalef32_pk_fp4_f32(w0, a0.x * scale, a0.y * scale, 1.0f, 0);
    w0 = __builtin_amdgcn_cvt_scalef32_pk_fp4_f32(w0, a0.z * scale, a0.w * scale, 1.0f, 1);
    w0 = __builtin_amdgcn_cvt_scalef32_pk_fp4_f32(w0, a1.x * scale, a1.y * scale, 1.0f, 2);
    w0 = __builtin_amdgcn_cvt_scalef32_pk_fp4_f32(w0, a1.z * scale, a1.w * scale, 1.0f, 3);
    w1 = __builtin_amdgcn_cvt_scalef32_pk_fp4_f32(w1, a2.x * scale, a2.y * scale, 1.0f, 0);
    w1 = __builtin_amdgcn_cvt_scalef32_pk_fp4_f32(w1, a2.z * scale, a2.w * scale, 1.0f, 1);
    w1 = __builtin_amdgcn_cvt_scalef32_pk_fp4_f32(w1, a3.x * scale, a3.y * scale, 1.0f, 2);
    w1 = __builtin_amdgcn_cvt_scalef32_pk_fp4_f32(w1, a3.z * scale, a3.w * scale, 1.0f, 3);
    dst[i] = make_uint2(w0, w1);
  }
}

DI void phase_attn(const Params& p, char* smem) {
  const int G = lgdim(), g = lbid();
  const u16* Qm = (const u16*)(p.ws + OFF_QM); const u16* Km = (const u16*)(p.ws + OFF_KM);
  const u16* Vm = (const u16*)(p.ws + OFF_VM); const u16* Qd = (const u16*)(p.ws + OFF_QD);
  const u16* Kd = (const u16*)(p.ws + OFF_KD); const u16* proj = (const u16*)(p.ws + OFF_PROJ);
  u16* mixed = (u16*)(p.ws + OFF_H);
  const float* lamp = (const float*)(p.ws + OFF_LAM);
  const int nrounds = (2048 + G - 1) / G;
  for (int k = 0; k * G < 2048; ++k) {
    conv_table_slice(p.in[23], (uint2*)(p.ws + OFF_U), U_SCALE, k, nrounds);
    conv_table_slice(p.in[24], (uint2*)(p.ws + OFF_V), V_SCALE, k, nrounds);
    const int idx = (k & 1) ? k * G + (G - 1 - g) : k * G + g;
    if (idx >= 2048) continue;
    const int level = idx >> 7, qblk = 15 - level, j = idx & 127, type = j & 1, bh = j >> 1;
    const int b = bh >> 2, hd = bh & 3;
    if (type == 0) {
      const size_t ho = (size_t)(b * 4 + hd) * S_;
      attn_item<192, 1>(Qm + ho * 192, nullptr, Km + ho * 192, nullptr, Vm + ho * 128, 128, qblk,
                        mixed + (size_t)b * S_ * LDH + hd * 128, lamp, nullptr, smem);
    } else {
      const size_t h0 = (size_t)(b * 8 + 2 * hd) * S_ * 64, h1 = h0 + (size_t)S_ * 64;
      attn_item<64, 2>(Qd + h0, Qd + h1, Kd + h0, Kd + h1, proj + (size_t)b * S_ * NPROJ + 1728 + hd * 128, NPROJ,
                       qblk, mixed + (size_t)b * S_ * LDH + 512 + hd * 128, lamp, p.in[18], smem);
    }
  }
}

template <int ST>
DI void ins1(float (&T)[16], float s) {
#pragma unroll
  for (int j = 15; j > ST; --j) T[j] = __builtin_amdgcn_fmed3f(T[j - 1], s, T[j]);
  T[ST] = fmaxf(T[ST], s);
}
DI void peer_scores_top16(const char* sk, const u16* __restrict__ pqrow, int lane, float (&T)[16]) {
  const int h = lane >> 5, r = lane & 31;
  bf16x8 bq[8];
#pragma unroll
  for (int s = 0; s < 8; ++s) bq[s] = *(const bf16x8*)(pqrow + 16 * s + 8 * h);
#pragma unroll
  for (int j = 0; j < 16; ++j) T[j] = NEG_INF;
#pragma unroll
  for (int c = 0; c < 4; ++c) {
    f32x16 acc;
#pragma unroll
    for (int i = 0; i < 16; ++i) acc[i] = 0.f;
#pragma unroll
    for (int s = 0; s < 8; ++s) {
      bf16x8 a = *(const bf16x8*)(sk + (32 * c + r) * 272 + (16 * s + 8 * h) * 2);
      acc = MFMA(a, bq[s], acc);
    }
#pragma unroll
    for (int i = 0; i < 16; ++i) {
      const unsigned code = (unsigned)(127 - 32 * c - (i & 3) - 8 * (i >> 2)) - 4u * (unsigned)h;
      ins1<0>(T, __uint_as_float((__float_as_uint(acc[i]) & 0xffffff80u) | code));
    }
  }
  float o[16];
#pragma unroll
  for (int j = 0; j < 16; ++j) {
    auto rr = __builtin_amdgcn_permlane32_swap(__float_as_uint(T[j]), __float_as_uint(T[j]), false, false);
    o[j] = __uint_as_float(h ? rr[0] : rr[1]);
  }
  ins1<0>(T, o[0]); ins1<1>(T, o[1]); ins1<2>(T, o[2]); ins1<3>(T, o[3]);
  ins1<4>(T, o[4]); ins1<5>(T, o[5]); ins1<6>(T, o[6]); ins1<7>(T, o[7]);
  ins1<8>(T, o[8]); ins1<9>(T, o[9]); ins1<10>(T, o[10]); ins1<11>(T, o[11]);
  ins1<12>(T, o[12]); ins1<13>(T, o[13]); ins1<14>(T, o[14]); ins1<15>(T, o[15]);
}

DI float gelu_exact(float x) { return 0.5f * x * (1.f + erff(x * 0.7071067811865476f)); }

DI void load_sk(char* smem, const u16* SK, int hp, int tid) {
#pragma unroll
  for (int i = 0; i < 4; ++i) {
    const int id = tid + 512 * i, row = id >> 4, c16 = id & 15;
    *(u32x4*)(smem + row * 272 + c16 * 16) = *(const u32x4*)(SK + (size_t)hp * 16384 + row * 128 + c16 * 8);
  }
}

DI void peer_route(const Params& p, char* smem, int t0) {
  const int tid = ltid(), lane = tid & 63, w = tid >> 6, h = lane >> 5, r = lane & 31;
  const u16* pq = (const u16*)(p.ws + OFF_PROJ);
  const u16* SK = (const u16*)(p.ws + OFF_SK);
  uint2* topk = (uint2*)(p.ws + OFF_TOPK);
    const int tq = t0 + 32 * w + r;
#pragma unroll 1
    for (int hd = 0; hd < 8; ++hd) {
      float TA[16], TB[16];
      __syncthreads();
      load_sk(smem, SK, hd * 2, tid);
      __syncthreads();
      peer_scores_top16(smem, pq + (size_t)tq * 2048 + (hd * 2) * 128, lane, TA);
      __syncthreads();
      load_sk(smem, SK, hd * 2 + 1, tid);
      __syncthreads();
      peer_scores_top16(smem, pq + (size_t)tq * 2048 + (hd * 2 + 1) * 128, lane, TB);
      float FK[16];
#pragma unroll
      for (int j = 0; j < 16; ++j) FK[j] = NEG_INF;
#pragma unroll
      for (int i = 0; i < 16; ++i)
#pragma unroll
        for (int j = 0; j < 16; ++j)
          if ((i + 1) * (j + 1) <= 16) {
            const float cv = __uint_as_float(__float_as_uint(TA[i]) & 0xffffff80u) + __uint_as_float(__float_as_uint(TB[j]) & 0xffffff80u);
            const float key = __uint_as_float((__float_as_uint(cv) & 0xffffff00u) | (unsigned)(255 - (16 * i + j)));
            const int st = (i + 1) * (j + 1) - 1;
#pragma unroll
            for (int q = 15; q >= 1; --q)
              if (q > st) FK[q] = __builtin_amdgcn_fmed3f(FK[q - 1], key, FK[q]);
            FK[st] = fmaxf(FK[st], key);
          }
      float FV[16]; int FI[16];
#pragma unroll
      for (int m = 0; m < 16; ++m) {
        const unsigned kb = __float_as_uint(FK[m]);
        const int code = 255 - (int)(kb & 255u), ci = code >> 4, cj = code & 15;
        FV[m] = __uint_as_float(kb & 0xffffff00u);
        float ra = TA[0], rb = TB[0];
#pragma unroll
        for (int q = 1; q < 16; ++q) { ra = (ci == q) ? TA[q] : ra; rb = (cj == q) ? TB[q] : rb; }
        FI[m] = (127 - (int)(__float_as_uint(ra) & 127u)) * 128 + (127 - (int)(__float_as_uint(rb) & 127u));
      }
      float e[16], sum = 0.f;
#pragma unroll
      for (int j = 0; j < 16; ++j) { e[j] = expf(FV[j] - FV[0]); sum += e[j]; }
      const float rs = 1.f / sum;
      if (h == 0) {
        u32x4* dst = (u32x4*)(topk + (size_t)tq * 128 + hd * 16);
#pragma unroll
        for (int q = 0; q < 8; ++q) {
          u32x4 o;
          o.x = (unsigned)FI[2 * q]; o.y = __float_as_uint(e[2 * q] * rs);
          o.z = (unsigned)FI[2 * q + 1]; o.w = __float_as_uint(e[2 * q + 1] * rs);
          dst[q] = o;
        }
      }
    }
}

DI void peer_gather(const Params& p, int t0) {
  const int tid = ltid(), lane = tid & 63, w = tid >> 6;
  const uint2* topk = (const uint2*)(p.ws + OFF_TOPK);
  const float* mod = (const float*)(p.ws + OFF_MOD);
  const unsigned char* U8 = (const unsigned char*)(p.ws + OFF_U);
  const unsigned char* V8 = (const unsigned char*)(p.ws + OFF_V);
#pragma unroll 1
  for (int ti = 0; ti < 32; ++ti) {
    const int t = t0 + 32 * w + ti, b = t >> 12;
    const float* mb = mod + b * 6144;
    float* orow = p.out + (size_t)t * 1024 + lane * 16;
    f32x2 xr[8];
#pragma unroll
    for (int q = 0; q < 4; ++q) {
      float4 a = ((const float4*)orow)[q];
      xr[2 * q] = f32x2{a.x, a.y}; xr[2 * q + 1] = f32x2{a.z, a.w};
    }
    float ss = 0.f;
#pragma unroll
    for (int i = 0; i < 8; ++i) ss += xr[i].x * xr[i].x + xr[i].y * xr[i].y;
    ss = wave_sum(ss);
    const float rinv = rsqrtf(ss * (1.f / 1024.f) + EPS);
    f32x2 hf[8];
#pragma unroll
    for (int q = 0; q < 4; ++q) {
      const int d0 = lane * 16 + 4 * q;
      float4 gg = *(const float4*)(p.in[20] + d0);
      float4 sc = *(const float4*)(mb + 4096 + d0);
      float4 sh = *(const float4*)(mb + 3072 + d0);
      hf[2 * q] = f32x2{xr[2 * q].x * rinv * gg.x * (1.f + sc.x) + sh.x, xr[2 * q].y * rinv * gg.y * (1.f + sc.y) + sh.y};
      hf[2 * q + 1] = f32x2{xr[2 * q + 1].x * rinv * gg.z * (1.f + sc.z) + sh.z, xr[2 * q + 1].y * rinv * gg.w * (1.f + sc.w) + sh.w};
    }
    const u32x4 tk = *(const u32x4*)(topk + (size_t)t * 128 + lane * 2);
    f32x2 y[8];
#pragma unroll
    for (int i = 0; i < 8; ++i) y[i] = f32x2{0.f, 0.f};
    uint2 ua[16], va[16], ub[16], vb[16];
    float gA, gB;
    auto issue = [&](int jj, uint2 (&uu)[16], uint2 (&vv)[16], float& gsel) __attribute__((always_inline)) {
      float gs = 0.f;
#pragma unroll
      for (int k = 0; k < 16; ++k) {
        const int l = 8 * jj + (k >> 1);
        const int e = __builtin_amdgcn_readlane((int)((k & 1) ? tk.z : tk.x), l);
        const float g = __uint_as_float(__builtin_amdgcn_readlane((int)((k & 1) ? tk.w : tk.y), l));
        gs = ((lane >> 2) == k) ? g : gs;
        uu[k] = *(const uint2*)(U8 + (size_t)e * 512 + lane * 8);
        vv[k] = *(const uint2*)(V8 + (size_t)e * 512 + lane * 8);
      }
      gsel = gs;
    };
    auto process = [&](const uint2 (&uu)[16], const uint2 (&vv)[16], float gsel) __attribute__((always_inline)) {
      float d[16];
#pragma unroll
      for (int k = 0; k < 16; ++k) {
        f32x2 a2 = f32x2{0.f, 0.f};
        a2 = __builtin_amdgcn_cvt_scalef32_pk_f32_fp4(uu[k].x, 1.0f, 0) * hf[0] + a2;
        a2 = __builtin_amdgcn_cvt_scalef32_pk_f32_fp4(uu[k].x, 1.0f, 1) * hf[1] + a2;
        a2 = __builtin_amdgcn_cvt_scalef32_pk_f32_fp4(uu[k].x, 1.0f, 2) * hf[2] + a2;
        a2 = __builtin_amdgcn_cvt_scalef32_pk_f32_fp4(uu[k].x, 1.0f, 3) * hf[3] + a2;
        a2 = __builtin_amdgcn_cvt_scalef32_pk_f32_fp4(uu[k].y, 1.0f, 0) * hf[4] + a2;
        a2 = __builtin_amdgcn_cvt_scalef32_pk_f32_fp4(uu[k].y, 1.0f, 1) * hf[5] + a2;
        a2 = __builtin_amdgcn_cvt_scalef32_pk_f32_fp4(uu[k].y, 1.0f, 2) * hf[6] + a2;
        a2 = __builtin_amdgcn_cvt_scalef32_pk_f32_fp4(uu[k].y, 1.0f, 3) * hf[7] + a2;
        d[k] = a2.x + a2.y;
      }
      const bool h32 = (lane & 32) != 0, h16 = (lane & 16) != 0, h8 = (lane & 8) != 0, h4 = (lane & 4) != 0;
      float r8[8], r4[4], r2[2];
#pragma unroll
      for (int i = 0; i < 8; ++i) r8[i] = swapsum32(d[i], d[8 + i]);
#pragma unroll
      for (int i = 0; i < 4; ++i) r4[i] = swapsum16(r8[i], r8[4 + i]);
#pragma unroll
      for (int i = 0; i < 2; ++i) r2[i] = (h8 ? r4[2 + i] : r4[i]) + dppmov<0x128>(h8 ? r4[i] : r4[2 + i]);
      float kk = (h4 ? r2[1] : r2[0]) + dppmov<0x141>(h4 ? r2[0] : r2[1]);
      kk += dppmov<0x4E>(kk); kk += dppmov<0xB1>(kk);
      const float coefv = gsel * gelu_exact(kk * (1.f / U_SCALE)) * (1.f / V_SCALE);
#pragma unroll
      for (int k = 0; k < 16; ++k) {
        const float cf = __uint_as_float(__builtin_amdgcn_readlane((int)__float_as_uint(coefv), 4 * k));
        const f32x2 cf2 = f32x2{cf, cf};
        y[0] = __builtin_amdgcn_cvt_scalef32_pk_f32_fp4(vv[k].x, 1.0f, 0) * cf2 + y[0];
        y[1] = __builtin_amdgcn_cvt_scalef32_pk_f32_fp4(vv[k].x, 1.0f, 1) * cf2 + y[1];
        y[2] = __builtin_amdgcn_cvt_scalef32_pk_f32_fp4(vv[k].x, 1.0f, 2) * cf2 + y[2];
        y[3] = __builtin_amdgcn_cvt_scalef32_pk_f32_fp4(vv[k].x, 1.0f, 3) * cf2 + y[3];
        y[4] = __builtin_amdgcn_cvt_scalef32_pk_f32_fp4(vv[k].y, 1.0f, 0) * cf2 + y[4];
        y[5] = __builtin_amdgcn_cvt_scalef32_pk_f32_fp4(vv[k].y, 1.0f, 1) * cf2 + y[5];
        y[6] = __builtin_amdgcn_cvt_scalef32_pk_f32_fp4(vv[k].y, 1.0f, 2) * cf2 + y[6];
        y[7] = __builtin_amdgcn_cvt_scalef32_pk_f32_fp4(vv[k].y, 1.0f, 3) * cf2 + y[7];
      }
    };
    issue(0, ua, va, gA);
#pragma unroll 1
    for (int jj = 0; jj < 8; jj += 2) {
      issue(jj + 1, ub, vb, gB);
      __builtin_amdgcn_sched_barrier(0);
      process(ua, va, gA);
      __builtin_amdgcn_sched_barrier(0);
      issue((jj + 2) & 7, ua, va, gA);
      __builtin_amdgcn_sched_barrier(0);
      process(ub, vb, gB);
      __builtin_amdgcn_sched_barrier(0);
    }
#pragma unroll
    for (int q = 0; q < 4; ++q) {
      float4 g2 = *(const float4*)(mb + 5120 + lane * 16 + 4 * q);
      float4 o;
      o.x = xr[2 * q].x + g2.x * y[2 * q].x; o.y = xr[2 * q].y + g2.y * y[2 * q].y;
      o.z = xr[2 * q + 1].x + g2.z * y[2 * q + 1].x; o.w = xr[2 * q + 1].y + g2.w * y[2 * q + 1].y;
      ((float4*)orow)[q] = o;
    }
  }
}

constexpr size_t OFF_BAR = 413696;
#define XB_TMO      128
#define XB_XCNT(j)  (256  + 64 * (j))
#define XB_XSUB(j)  (1280 + 64 * (j))
#define XB_XGEN(j)  (2304 + 64 * (j))
#define XB_TOP      3328
#define XB_TOPGEN   3392
#define XCD_BAR_WORDS 3456
#define XB_SPIN_CAP (1u << 18)
#define XLAS __attribute__((address_space(3)))
DI unsigned xb_ld(unsigned* p) { return __hip_atomic_load(p, __ATOMIC_RELAXED, __HIP_MEMORY_SCOPE_AGENT); }
DI unsigned xb_add(unsigned* p, unsigned v) { return __hip_atomic_fetch_add(p, v, __ATOMIC_RELAXED, __HIP_MEMORY_SCOPE_AGENT); }
DI unsigned xb_xcc_id() { return (unsigned)__builtin_amdgcn_s_getreg((3 << 11) | 20) & 0xFu; }
#define XB_SPIN(cond, bar) do { unsigned _sp = 0; while (cond) { __builtin_amdgcn_s_sleep(1); \
    if ((++_sp & 255u) == 0u) { if (xb_ld(&(bar)[XB_TMO])) break; if (_sp > XB_SPIN_CAP) { atomicAdd(&(bar)[XB_TMO], 1u); break; } } } } while (0)
DI void xcd_barrier_complete(unsigned* bar, unsigned x, unsigned& nloc, unsigned& nx) {
  const unsigned G = gridDim.x;
  unsigned sum, cnt, mine, sp = 0u;
  for (;;) {
    sum = 0u; cnt = 0u; mine = 0u;
#pragma unroll
    for (unsigned j = 0; j < 16; ++j) { const unsigned c = xb_ld(&bar[XB_XCNT(j)]); sum += c; cnt += (c > 0u) ? 1u : 0u; mine = (j == x) ? c : mine; }
    if (sum == G) break;
    __builtin_amdgcn_s_sleep(1);
    if ((++sp & 255u) == 0u) { if (xb_ld(&bar[XB_TMO])) break; if (sp > XB_SPIN_CAP) { atomicAdd(&bar[XB_TMO], 1u); break; } }
  }
  nloc = mine > 0u ? mine : 1u; nx = cnt > 0u ? cnt : 1u;
}
DI void xcd_barrier(unsigned* bar, volatile XLAS unsigned* st) {
  asm volatile("s_waitcnt vmcnt(0)" ::: "memory");
  __syncthreads();
  if (threadIdx.x == 0) {
    const unsigned x = xb_xcc_id();
    __builtin_amdgcn_s_waitcnt(0);
    unsigned nloc = st[0], nx = st[1];
    if (nloc == 0u) { xcd_barrier_complete(bar, x, nloc, nx); st[0] = nloc; st[1] = nx; }
    const unsigned old = xb_add(&bar[XB_XSUB(x)], 1u);
    const unsigned gen = old / nloc;
    if (old + 1u == (gen + 1u) * nloc) {
      __builtin_amdgcn_fence(__ATOMIC_RELEASE, "agent");
      asm volatile("s_waitcnt vmcnt(0)" ::: "memory");
      const unsigned og = xb_add(&bar[XB_TOP], 1u);
      const unsigned tg = og / nx;
      if (og + 1u == (tg + 1u) * nx) xb_add(&bar[XB_TOPGEN], 1u);
      else XB_SPIN(xb_ld(&bar[XB_TOPGEN]) == tg, bar);
      __builtin_amdgcn_fence(__ATOMIC_ACQUIRE, "agent");
      xb_add(&bar[XB_XGEN(x)], 1u);
      asm volatile("s_waitcnt vmcnt(0)" ::: "memory");
    } else {
      XB_SPIN(xb_ld(&bar[XB_XGEN(x)]) == gen, bar);
      __builtin_amdgcn_fence(__ATOMIC_ACQUIRE, "agent");
      asm volatile("s_waitcnt vmcnt(0)" ::: "memory");
    }
  }
  __syncthreads();
}

typedef const __attribute__((address_space(4))) Params* KParamsPtr;
__global__ void __launch_bounds__(512) mega(Params p_arg) {
  __shared__ __attribute__((aligned(16))) char smem[151552];
  __shared__ uint4 xb_words;
  if (threadIdx.x == 0) {
    xb_words = make_uint4(0u, 0u, 0u, 0u);
    (void)xb_add(&((unsigned*)(p_arg.ws + OFF_BAR))[XB_XCNT(xb_xcc_id())], 1u);
  }
  __syncthreads();
  for (int ph = p_arg.ph_begin; ph < p_arg.ph_end; ++ph) {
    KParamsPtr kp = (KParamsPtr)__builtin_amdgcn_kernarg_segment_ptr();
    asm volatile("" : "+s"(kp));
    Params p;
#pragma unroll
    for (int i = 0; i < 25; ++i) p.in[i] = kp->in[i];
    p.out = kp->out; p.ws = kp->ws; p.ph_begin = 0; p.ph_end = 0;
    const int G = lgdim();
    if (ph == 0) {
      phase0(p, smem);
    } else if (ph == 1) {
      rownorm_phase(p, p.in[0], p.in[4], 0, 1024, (u16*)(p.ws + OFF_H));
    } else if (ph == 2) {
      u16* proj = (u16*)(p.ws + OFF_PROJ);
      xcd_tiles(p.ws, 0, 9, [&](int tt, int ft2) __attribute__((always_inline)) {
        gemm_tile<1024, false>((const u16*)(p.ws + OFF_WIN), NPROJ, ft2 * 256, (const u16*)(p.ws + OFF_H), LDH,
                               (size_t)tt * 256, smem, [&](f32x16 (&acc)[4], float, int t, int h, int wf, char* wbase, int tg) __attribute__((always_inline)) {
                                 store_tile_bf16_lds(acc, wbase + tg * 8704, proj + (size_t)(t & ~31) * NPROJ + ft2 * 256 + wf * 128, NPROJ, ltid() & 63);
                               });
      });
    } else if (ph == 3) {
      phase_qkv(p, smem);
    } else if (ph == 4) {
      phase_attn(p, smem);
    } else if (ph == 5) {
      const float* mod = (const float*)(p.ws + OFF_MOD);
      xcd_tiles(p.ws, 3, 4, [&](int tt, int ft2) __attribute__((always_inline)) {
        gemm_tile<1024, false>((const u16*)(p.ws + OFF_WOUT), 1024, ft2 * 256, (const u16*)(p.ws + OFF_H), LDH,
                               (size_t)tt * 256, smem, [&](f32x16 (&acc)[4], float, int t, int h, int wf, char* wbase, int tg) __attribute__((always_inline)) {
                                 const int ft = ft2 * 2 + wf, lane = ltid() & 63, r = lane & 31;
#pragma unroll
                                 for (int c = 0; c < 4; ++c)
#pragma unroll
                                   for (int gq = 0; gq < 4; ++gq)
                                     *(float4*)(wbase + r * 528 + (32 * c + 8 * gq + 4 * h) * 4) =
                                         make_float4(acc[c][4 * gq], acc[c][4 * gq + 1], acc[c][4 * gq + 2], acc[c][4 * gq + 3]);
                                 const int tg0 = t & ~31, b = tg0 >> 12;
#pragma unroll
                                 for (int j = 0; j < 16; ++j) {
                                   const int idx = lane + 64 * j, row = idx >> 5, c16 = idx & 31;
                                   const float4 a = *(const float4*)(wbase + row * 528 + c16 * 16);
                                   const int n = ft * 128 + c16 * 4;
                                   const size_t off = (size_t)(tg0 + row) * 1024 + n;
                                   const float4 xv = *(const float4*)(p.in[0] + off);
                                   const float4 g1 = *(const float4*)(mod + b * 6144 + 2048 + n);
                                   float4 o;
                                   o.x = xv.x + g1.x * a.x; o.y = xv.y + g1.y * a.y; o.z = xv.z + g1.z * a.z; o.w = xv.w + g1.w * a.w;
                                   *(float4*)(p.out + off) = o;
                                 }
                               });
      });
    } else if (ph == 6) {
      rownorm_phase(p, p.out, p.in[20], 3072, 4096, (u16*)(p.ws + OFF_H2));
    } else if (ph == 7) {
      u16* pq = (u16*)(p.ws + OFF_PROJ);
      xcd_tiles(p.ws, 4, 8, [&](int tt, int ft2) __attribute__((always_inline)) {
        gemm_tile<1024, false>((const u16*)(p.ws + OFF_WPQ), 2048, ft2 * 256, (const u16*)(p.ws + OFF_H2), LDH,
                               (size_t)tt * 256, smem, [&](f32x16 (&acc)[4], float, int t, int h, int wf, char* wbase, int tg) __attribute__((always_inline)) {
                                 store_tile_bf16_lds(acc, wbase + tg * 8704, pq + (size_t)(t & ~31) * 2048 + ft2 * 256 + wf * 128, 2048, ltid() & 63);
                               });
      });
    } else {
      for (int tt = lbid(); tt < 256; tt += G) {
        peer_route(p, smem, tt * 256);
        __threadfence();
        __syncthreads();
        __threadfence();
        peer_gather(p, tt * 256);
      }
    }
#if COOP
    if (ph + 1 < p_arg.ph_end) {
      if (ph == 0) cg::this_grid().sync();
      else xcd_barrier((unsigned*)(p.ws + OFF_BAR), (volatile XLAS unsigned*)&xb_words);
    }
#endif
  }
}

extern "C" void kernel_launch(void* const* d_in, const int* in_sizes, int n_in, void* d_out, int out_size,
                              void* d_ws, size_t ws_size, hipStream_t stream) {
  static int grid_blocks = 0;
  if (!grid_blocks) {
    int dev = 0, cus = 0, per_cu = 0;
    hipGetDevice(&dev);
    hipDeviceGetAttribute(&cus, hipDeviceAttributeMultiprocessorCount, dev);
    hipOccupancyMaxActiveBlocksPerMultiprocessor(&per_cu, mega, 512, 0);
    if (per_cu < 1) per_cu = 1;
    if (per_cu > 1) per_cu = 1;
    grid_blocks = cus * per_cu;
  }
  Params p{};
  for (int i = 0; i < 25; ++i) p.in[i] = (const float*)d_in[i];
  p.out = (float*)d_out;
  p.ws = (char*)d_ws;
  hipMemsetAsync((char*)d_ws + OFF_BAR, 0, XCD_BAR_WORDS * sizeof(unsigned), stream);
#if COOP
  p.ph_begin = 0; p.ph_end = 9;
  void* args[] = {&p};
  hipError_t e = hipLaunchCooperativeKernel((void*)mega, dim3(grid_blocks), dim3(512), args, 0, stream);
  if (e != hipSuccess) fprintf(stderr, "cooperative launch failed: %s (grid %d)\n", hipGetErrorString(e), grid_blocks);
#else
  for (int ph = 0; ph < 9; ++ph) {
    p.ph_begin = ph; p.ph_end = ph + 1;
    hipLaunchKernelGGL(mega, dim3(grid_blocks), dim3(512), 0, stream, p);
  }
#endif
}
```

```cpp
#include <hip/hip_runtime.h>
#include <hip/hip_cooperative_groups.h>
#include <cstdio>
namespace cg = cooperative_groups;

typedef unsigned short u16;
typedef short bf16x8 __attribute__((ext_vector_type(8)));
typedef short s16x4 __attribute__((ext_vector_type(4)));
typedef float f32x16 __attribute__((ext_vector_type(16)));
typedef __bf16 bf2_t __attribute__((ext_vector_type(2)));
typedef unsigned u32x4 __attribute__((ext_vector_type(4)));
#define DI __device__ __forceinline__
#define LDSP(T, p) ((__attribute__((address_space(3))) T*)(p))
#define MFMA(a, b, c) __builtin_amdgcn_mfma_f32_32x32x16_bf16((a), (b), (c), 0, 0, 0)

#ifndef COOP
#define COOP 1
#endif

constexpr int S_ = 4096, T_ = 65536, NPROJ = 2304;
constexpr int LDH = 1088;
constexpr float EPS = 1e-6f;
constexpr float LOG2E = 1.4426950408889634f;
constexpr float NEG_INF = -__builtin_inff();
constexpr float U_SCALE = 64.f, V_SCALE = 5.656854f;
typedef float f32x2 __attribute__((ext_vector_type(2)));

constexpr size_t OFF_MOD = 0;
constexpr size_t OFF_LAM = 393216;
constexpr size_t OFF_CNT = 397312;
constexpr size_t OFF_ROPE = 524288;
constexpr size_t OFF_WIN = 1572864;
constexpr size_t OFF_WQ = 6291456;
constexpr size_t OFF_WKV = 6881280;
constexpr size_t OFF_WOUT = 7405568;
constexpr size_t OFF_WPQ = 9502720;
constexpr size_t OFF_SK = 13697024;
constexpr size_t OFF_U = 16777216;
constexpr size_t OFF_V = 50331648;
constexpr size_t OFF_H = 83886080;
constexpr size_t OFF_PROJ = 226492416;
constexpr size_t OFF_QM = 528482304;
constexpr size_t OFF_KM = 629145600;
constexpr size_t OFF_VM = 729808896;
constexpr size_t OFF_QD = 796917760;
constexpr size_t OFF_KD = 864026624;
constexpr size_t OFF_H2 = OFF_QM;
constexpr size_t OFF_TOPK = OFF_VM;

struct Params {
  const float* in[25];
  float* out;
  char* ws;
  int ph_begin, ph_end;
};

DI unsigned pk2(float a, float b) {
  bf2_t r; r[0] = (__bf16)a; r[1] = (__bf16)b; return __builtin_bit_cast(unsigned, r);
}
DI float bflo(unsigned u) { return __uint_as_float(u << 16); }
DI float bfhi(unsigned u) { return __uint_as_float(u & 0xffff0000u); }
DI float dot2bf(unsigned a, unsigned b, float c) {
  return __builtin_amdgcn_fdot2_f32_bf16(__builtin_bit_cast(bf2_t, a), __builtin_bit_cast(bf2_t, b), c, false);
}
DI int lbid() { int t = blockIdx.x; asm volatile("" : "+s"(t)); return t; }
DI int lgdim() { int t = gridDim.x; asm volatile("" : "+s"(t)); return t; }
DI int ltid() { int t = threadIdx.x; asm volatile("" : "+v"(t)); return t; }
DI float xsum32(float v) {
  const unsigned u = __float_as_uint(v);
  auto r = __builtin_amdgcn_permlane32_swap(u, u, false, false);
  return __uint_as_float(r[0]) + __uint_as_float(r[1]);
}
DI float xmax32(float v) {
  const unsigned u = __float_as_uint(v);
  auto r = __builtin_amdgcn_permlane32_swap(u, u, false, false);
  return fmaxf(__uint_as_float(r[0]), __uint_as_float(r[1]));
}
DI float swapsum32(float a, float b) {
  auto r = __builtin_amdgcn_permlane32_swap(__float_as_uint(a), __float_as_uint(b), false, false);
  return __uint_as_float(r[0]) + __uint_as_float(r[1]);
}
DI float swapsum16(float a, float b) {
  auto r = __builtin_amdgcn_permlane16_swap(__float_as_uint(a), __float_as_uint(b), false, false);
  return __uint_as_float(r[0]) + __uint_as_float(r[1]);
}
template <int CTRL>
DI float dppmov(float v) {
  return __uint_as_float((unsigned)__builtin_amdgcn_update_dpp(0, (int)__float_as_uint(v), CTRL, 0xF, 0xF, true));
}
DI float wave_sum(float v) {
  v += dppmov<0x128>(v); v += dppmov<0x124>(v); v += dppmov<0x122>(v); v += dppmov<0x121>(v);
  v = swapsum16(v, v);
  return xsum32(v);
}
DI s16x4 trread(const char* p) { return __builtin_amdgcn_ds_read_tr16_b64_v4i16(LDSP(s16x4, p)); }
DI unsigned xcc_id() { return (unsigned)__builtin_amdgcn_s_getreg((3 << 11) | 20) & 0x7u; }
template <class F>
DI void xcd_tiles(char* ws, int set, int nft, F body) {
  __shared__ int sh_item;
  unsigned* cnt = (unsigned*)(ws + OFF_CNT);
  const int x0 = (int)xcc_id();
  const int per = 32 * nft;
  for (int q = 0; q < 8; ++q) {
    const int x = (x0 + q) & 7;
    for (;;) {
      __syncthreads();
      if (threadIdx.x == 0) sh_item = (int)atomicAdd(cnt + (set * 8 + x) * 32, 1u);
      __syncthreads();
      const int it = sh_item;
      if (it >= per) break;
      body(32 * x + it / nft, it % nft);
    }
  }
}

constexpr int G_ARS = 576;
constexpr int G_ASZ = 64 * G_ARS, G_BSZ = 256 * 144, G_STAGE = G_ASZ + G_BSZ;

template <int K, bool SUMSQ, class Epi>
DI void gemm_tile(const u16* __restrict__ W, int ldw, int n0, const u16* __restrict__ X, int ldx, size_t t0,
                  char* smem, Epi epi) {
  constexpr int KT = K / 64;
  const int tid = ltid(), lane = tid & 63, w = tid >> 6, h = lane >> 5, r = lane & 31;
  const int wf = w & 1, wt = w >> 1;
  const int blk = (lane >> 4) & 1, q4 = (lane & 15) >> 2, p4 = lane & 3;
  u32x4 ra[4], rb[4];
  const unsigned aoff = (unsigned)((tid >> 5) * ldw + (tid & 31) * 8), boff = (unsigned)((tid >> 3) * ldx + (tid & 7) * 8);
  const unsigned asoff = (unsigned)((tid >> 5) * G_ARS + (tid & 31) * 16), bsoff = (unsigned)(G_ASZ + (tid >> 3) * 144 + (tid & 7) * 16);
  auto gload = [&](int kt) __attribute__((always_inline)) {
    const u16* wk = W + (size_t)kt * 64 * ldw + n0;
    const u16* xk = X + t0 * (size_t)ldx + kt * 64;
#pragma unroll
    for (int i = 0; i < 4; ++i) ra[i] = *(const u32x4*)(wk + (size_t)i * 16 * ldw + aoff);
#pragma unroll
    for (int i = 0; i < 4; ++i) rb[i] = *(const u32x4*)(xk + (size_t)i * 64 * ldx + boff);
  };
  auto sstore = [&](char* buf) __attribute__((always_inline)) {
#pragma unroll
    for (int i = 0; i < 4; ++i) *(u32x4*)(buf + asoff + i * 16 * G_ARS) = ra[i];
#pragma unroll
    for (int i = 0; i < 4; ++i) *(u32x4*)(buf + bsoff + i * 64 * 144) = rb[i];
  };
  auto stage_step = [&](int s, char* nbuf, int ktl, bool dowrite, bool doload) __attribute__((always_inline)) {
    const u16* wk = W + (size_t)ktl * 64 * ldw + n0;
    const u16* xk = X + t0 * (size_t)ldx + ktl * 64;
    if (s < 2) {
#pragma unroll
      for (int i = 2 * s; i < 2 * s + 2; ++i) {
        if (dowrite) *(u32x4*)(nbuf + asoff + i * 16 * G_ARS) = ra[i];
        if (doload) ra[i] = *(const u32x4*)(wk + (size_t)i * 16 * ldw + aoff);
      }
    } else {
#pragma unroll
      for (int i = 2 * s - 4; i < 2 * s - 2; ++i) {
        if (dowrite) *(u32x4*)(nbuf + bsoff + i * 64 * 144) = rb[i];
        if (doload) rb[i] = *(const u32x4*)(xk + (size_t)i * 64 * ldx + boff);
      }
    }
  };
  f32x16 acc[2][4];
#pragma unroll
  for (int g = 0; g < 2; ++g)
#pragma unroll
    for (int c = 0; c < 4; ++c)
#pragma unroll
      for (int i = 0; i < 16; ++i) acc[g][c][i] = 0.f;
  float ss0 = 0.f, ss1 = 0.f;
  auto compute = [&](const char* buf, char* nbuf, int ktl, bool dowrite, bool doload) __attribute__((always_inline)) {
    u32x4 bfr[2][2];
    s16x4 alo[2][4], ahi[2][4];
    auto lfrag = [&](int s, int slot) __attribute__((always_inline)) {
      bfr[slot][0] = *(const u32x4*)(buf + G_ASZ + (64 * wt + r) * 144 + (16 * s + 8 * h) * 2);
      bfr[slot][1] = *(const u32x4*)(buf + G_ASZ + (64 * wt + 32 + r) * 144 + (16 * s + 8 * h) * 2);
#pragma unroll
      for (int c = 0; c < 4; ++c) {
        const char* ap = buf + (16 * s + 8 * h + q4) * G_ARS + (128 * wf + 32 * c + 16 * blk) * 2 + 8 * p4;
        alo[slot][c] = trread(ap); ahi[slot][c] = trread(ap + 4 * G_ARS);
      }
    };
    lfrag(0, 0);
#pragma unroll
    for (int s = 0; s < 4; ++s) {
      if (s < 3) lfrag(s + 1, (s + 1) & 1);
      __builtin_amdgcn_sched_barrier(0);
      const u32x4 b0r = bfr[s & 1][0], b1r = bfr[s & 1][1];
      if (SUMSQ) {
        ss0 = dot2bf(b0r.x, b0r.x, ss0); ss0 = dot2bf(b0r.y, b0r.y, ss0);
        ss0 = dot2bf(b0r.z, b0r.z, ss0); ss0 = dot2bf(b0r.w, b0r.w, ss0);
        ss1 = dot2bf(b1r.x, b1r.x, ss1); ss1 = dot2bf(b1r.y, b1r.y, ss1);
        ss1 = dot2bf(b1r.z, b1r.z, ss1); ss1 = dot2bf(b1r.w, b1r.w, ss1);
      }
      const bf16x8 b0 = __builtin_bit_cast(bf16x8, b0r), b1 = __builtin_bit_cast(bf16x8, b1r);
#pragma unroll
      for (int c = 0; c < 4; ++c) {
        const bf16x8 a = __builtin_shufflevector(alo[s & 1][c], ahi[s & 1][c], 0, 1, 2, 3, 4, 5, 6, 7);
        acc[0][c] = MFMA(a, b0, acc[0][c]);
        acc[1][c] = MFMA(a, b1, acc[1][c]);
      }
      __builtin_amdgcn_sched_barrier(0);
      stage_step(s, nbuf, ktl, dowrite, doload);
      __builtin_amdgcn_sched_barrier(0);
    }
  };
  gload(0);
  sstore(smem);
  if (KT > 1) gload(1);
  __syncthreads();
  for (int kt = 0; kt < KT; ++kt) {
    char* buf = smem + (kt & 1) * G_STAGE;
    compute(buf, smem + ((kt + 1) & 1) * G_STAGE, kt + 2, kt + 1 < KT, kt + 2 < KT);
    __syncthreads();
  }
  if (SUMSQ) { ss0 = xsum32(ss0); ss1 = xsum32(ss1); }
  epi(acc[0], ss0, (int)t0 + 64 * wt + r, h, wf, smem + w * 17408, 0);
  epi(acc[1], ss1, (int)t0 + 64 * wt + 32 + r, h, wf, smem + w * 17408, 1);
}

DI void phase0(const Params& p, char* smem) {
  const int tid = ltid(), G = lgdim(), g = lbid();
  const size_t gt = (size_t)g * 512 + tid, NT = (size_t)G * 512;
  float* mod = (float*)(p.ws + OFF_MOD);
  for (int item = g; item < 192; item += G) {
    float* sc = (float*)smem;
    float* red = sc + 16384;
    for (int i = tid; i < 16384; i += 512) { float v = p.in[1][i]; sc[i] = v / (1.f + expf(-v)); }
    __syncthreads();
    const int col = tid & 31, kg = tid >> 5, n = item * 32 + col;
    float acc[16];
#pragma unroll
    for (int b = 0; b < 16; ++b) acc[b] = 0.f;
    const float* aw = p.in[2] + (size_t)(kg * 64) * 6144 + n;
#pragma unroll 1
    for (int k0 = 0; k0 < 64; k0 += 16) {
      float wv[16];
#pragma unroll
      for (int j = 0; j < 16; ++j) wv[j] = aw[(size_t)(k0 + j) * 6144];
#pragma unroll
      for (int j = 0; j < 16; ++j)
#pragma unroll
        for (int b = 0; b < 16; ++b) acc[b] += sc[b * 1024 + kg * 64 + k0 + j] * wv[j];
    }
#pragma unroll
    for (int b = 0; b < 16; ++b) red[(kg * 16 + b) * 32 + col] = acc[b];
    __syncthreads();
    {
      const int b = tid >> 5, cc = tid & 31;
      float sum = 0.f;
#pragma unroll
      for (int k2 = 0; k2 < 16; ++k2) sum += red[(k2 * 16 + b) * 32 + cc];
      mod[b * 6144 + item * 32 + cc] = sum + p.in[3][item * 32 + cc];
    }
    __syncthreads();
  }
  if (g == 0) {
    unsigned* cnt = (unsigned*)(p.ws + OFF_CNT);
    for (int i = tid; i < 8 * 8 * 32; i += 512) cnt[i] = 0u;
  }
  if (g == 0 && tid < 64) {
    float d1 = wave_sum(p.in[14][tid] * p.in[15][tid]);
    float d2 = wave_sum(p.in[16][tid] * p.in[17][tid]);
    if (tid == 0) *(float*)(p.ws + OFF_LAM) = expf(d1) - expf(d2) + 0.2f;
  }
  {
    float2* rope = (float2*)(p.ws + OFF_ROPE);
    for (size_t i = gt; i < 131072; i += NT) {
      int j = (int)(i & 31), sp = (int)(i >> 5);
      float inv = 1.0f / powf(10000.f, (float)j / 32.f);
      float ang = (float)sp * inv, sn, cs;
      sincosf(ang, &sn, &cs);
      rope[i] = make_float2(cs, sn);
    }
  }
  {
    u16* d = (u16*)(p.ws + OFF_WIN);
    for (size_t i = gt; i < (size_t)1024 * 2304; i += NT) {
      int k = (int)(i / 2304), n = (int)(i % 2304);
      float v = (n < 2240) ? p.in[5][(size_t)k * 2240 + n] : 0.f;
      d[i] = (u16)(pk2(v, 0.f) & 0xffff);
    }
  }
  {
    u16* d = (u16*)(p.ws + OFF_WQ);
    for (size_t i = gt; i < (size_t)384 * 768; i += NT) {
      int k = (int)(i / 768), n = (int)(i % 768);
      int src = (n < 512) ? (n >> 7) * 192 + (n & 127) : ((n - 512) >> 6) * 192 + 128 + ((n - 512) & 63);
      float v = p.in[7][(size_t)k * 768 + src] * p.in[6][k];
      d[i] = (u16)(pk2(v, 0.f) & 0xffff);
    }
  }
  {
    u16* d = (u16*)(p.ws + OFF_WKV);
    for (size_t i = gt; i < (size_t)256 * 1024; i += NT) {
      int k = (int)(i >> 10), n = (int)(i & 1023);
      int src = (n < 512) ? (n >> 7) * 256 + (n & 127) : ((n - 512) >> 7) * 256 + 128 + (n & 127);
      float v = p.in[9][(size_t)k * 1024 + src] * p.in[8][k];
      d[i] = (u16)(pk2(v, 0.f) & 0xffff);
    }
  }
  auto conv8 = [&](const float* src, u16* dst, size_t n8) __attribute__((always_inline)) {
    for (size_t i = gt; i < n8; i += NT) {
      float4 a = ((const float4*)src)[2 * i], b = ((const float4*)src)[2 * i + 1];
      uint4 o; o.x = pk2(a.x, a.y); o.y = pk2(a.z, a.w); o.z = pk2(b.x, b.y); o.w = pk2(b.z, b.w);
      ((uint4*)dst)[i] = o;
    }
  };
  conv8(p.in[19], (u16*)(p.ws + OFF_WOUT), (size_t)1024 * 1024 / 8);
  conv8(p.in[21], (u16*)(p.ws + OFF_WPQ), (size_t)1024 * 2048 / 8);
  conv8(p.in[22], (u16*)(p.ws + OFF_SK), (size_t)16 * 128 * 128 / 8);
}

DI void rownorm_phase(const Params& p, const float* src, const float* gain, int sh_off, int sc_off, u16* dst) {
  const int lane = ltid() & 63;
  const int gw = lbid() * 8 + (ltid() >> 6), NW = lgdim() * 8;
  const float* mod = (const float*)(p.ws + OFF_MOD);
  for (int t = gw; t < T_; t += NW) {
    const int b = t >> 12;
    const float* mb = mod + b * 6144;
#pragma unroll
    for (int c = 0; c < 2; ++c) {
    }
    float xv[16];
#pragma unroll
    for (int c = 0; c < 2; ++c) {
      const float4* sp = (const float4*)(src + (size_t)t * 1024 + c * 512 + lane * 8);
      float4 a = sp[0], bq = sp[1];
      xv[c * 8 + 0] = a.x; xv[c * 8 + 1] = a.y; xv[c * 8 + 2] = a.z; xv[c * 8 + 3] = a.w;
      xv[c * 8 + 4] = bq.x; xv[c * 8 + 5] = bq.y; xv[c * 8 + 6] = bq.z; xv[c * 8 + 7] = bq.w;
    }
    float ss = 0.f;
#pragma unroll
    for (int i = 0; i < 16; ++i) ss += xv[i] * xv[i];
    ss = wave_sum(ss);
    const float rinv = rsqrtf(ss * (1.f / 1024.f) + EPS);
#pragma unroll
    for (int c = 0; c < 2; ++c) {
      const int d0 = c * 512 + lane * 8;
      float o[8];
#pragma unroll
      for (int q = 0; q < 2; ++q) {
        float4 gg = *(const float4*)(gain + d0 + 4 * q);
        float4 sc = *(const float4*)(mb + sc_off + d0 + 4 * q);
        float4 sh = *(const float4*)(mb + sh_off + d0 + 4 * q);
        o[4 * q + 0] = xv[c * 8 + 4 * q + 0] * rinv * gg.x * (1.f + sc.x) + sh.x;
        o[4 * q + 1] = xv[c * 8 + 4 * q + 1] * rinv * gg.y * (1.f + sc.y) + sh.y;
        o[4 * q + 2] = xv[c * 8 + 4 * q + 2] * rinv * gg.z * (1.f + sc.z) + sh.z;
        o[4 * q + 3] = xv[c * 8 + 4 * q + 3] * rinv * gg.w * (1.f + sc.w) + sh.w;
      }
      uint4 ov; ov.x = pk2(o[0], o[1]); ov.y = pk2(o[2], o[3]); ov.z = pk2(o[4], o[5]); ov.w = pk2(o[6], o[7]);
      *(uint4*)(dst + (size_t)t * LDH + d0) = ov;
    }
  }
}

DI void store_tile_bf16_lds(f32x16 (&acc)[4], char* wsm, u16* dst0, size_t ld, int lane) {
  const int h = lane >> 5, r = lane & 31;
#pragma unroll
  for (int c = 0; c < 4; ++c)
#pragma unroll
    for (int gq = 0; gq < 4; ++gq) {
      uint2 v; v.x = pk2(acc[c][4 * gq], acc[c][4 * gq + 1]); v.y = pk2(acc[c][4 * gq + 2], acc[c][4 * gq + 3]);
      *(uint2*)(wsm + r * 272 + (32 * c + 8 * gq + 4 * h) * 2) = v;
    }
#pragma unroll
  for (int j = 0; j < 8; ++j) {
    const int idx = lane + 64 * j, row = idx >> 4, c16 = idx & 15;
    const u32x4 v = *(const u32x4*)(wsm + row * 272 + c16 * 16);
    *(u32x4*)(dst0 + (size_t)row * ld + c16 * 8) = v;
  }
}

template <class AddrFn>
DI void store_rows_bf16_lds(f32x16 (&acc)[4], char* wsm, int lane, AddrFn addr) {
  const int h = lane >> 5, r = lane & 31;
#pragma unroll
  for (int c = 0; c < 4; ++c)
#pragma unroll
    for (int gq = 0; gq < 4; ++gq) {
      uint2 v; v.x = pk2(acc[c][4 * gq], acc[c][4 * gq + 1]); v.y = pk2(acc[c][4 * gq + 2], acc[c][4 * gq + 3]);
      *(uint2*)(wsm + r * 272 + (32 * c + 8 * gq + 4 * h) * 2) = v;
    }
#pragma unroll
  for (int j = 0; j < 8; ++j) {
    const int idx = lane + 64 * j, row = idx >> 4, c16 = idx & 15;
    const u32x4 v = *(const u32x4*)(wsm + row * 272 + c16 * 16);
    *(u32x4*)addr(row, c16) = v;
  }
}

DI void phase_qkv(const Params& p, char* smem) {
  const int G = lgdim();
  const u16* proj = (const u16*)(p.ws + OFF_PROJ);
  const float2* rope = (const float2*)(p.ws + OFF_ROPE);
  u16* Qm = (u16*)(p.ws + OFF_QM); u16* Km = (u16*)(p.ws + OFF_KM); u16* Vm = (u16*)(p.ws + OFF_VM);
  u16* Qd = (u16*)(p.ws + OFF_QD); u16* Kd = (u16*)(p.ws + OFF_KD);
  const float QS = 0.07216878364870322f * LOG2E;
  xcd_tiles(p.ws, 1, 3, [&](int tt, int ft2) __attribute__((always_inline)) {
    const float* qg = p.in[10];
    gemm_tile<384, true>((const u16*)(p.ws + OFF_WQ), 768, ft2 * 256, proj, NPROJ, (size_t)tt * 256, smem,
      [&](f32x16 (&acc)[4], float ss, int t, int h, int wf, char* wbase, int tg) __attribute__((always_inline)) {
        const int ft = ft2 * 2 + wf;
        const float rinv = rsqrtf(ss * (1.f / 384.f) + EPS);
        const int lane = ltid() & 63, tg0 = t & ~31, b = tg0 >> 12, s0 = tg0 & 4095, s = t & 4095;
        char* wsm = wbase + tg * 8704;
        if (ft < 4) {
          float s2 = 0.f;
#pragma unroll
          for (int c = 0; c < 4; ++c)
#pragma unroll
            for (int k = 0; k < 16; ++k) { float v = acc[c][k] * rinv; s2 += v * v; }
          s2 = xsum32(s2);
          const float r2 = rsqrtf(s2 * (1.f / 128.f) + EPS) * rinv * QS;
#pragma unroll
          for (int c = 0; c < 4; ++c)
#pragma unroll
            for (int gq = 0; gq < 4; ++gq) {
              const int d = 32 * c + 8 * gq + 4 * h;
              float4 gg = *(const float4*)(qg + d);
              acc[c][4 * gq] *= r2 * gg.x; acc[c][4 * gq + 1] *= r2 * gg.y;
              acc[c][4 * gq + 2] *= r2 * gg.z; acc[c][4 * gq + 3] *= r2 * gg.w;
            }
          u16* base = Qm + ((size_t)(b * 4 + ft) * S_ + s0) * 192;
          store_rows_bf16_lds(acc, wsm, lane, [&](int row, int c16) __attribute__((always_inline)) { return base + (size_t)row * 192 + c16 * 8; });
        } else {
#pragma unroll
          for (int cp = 0; cp < 2; ++cp) {
            float s2 = 0.f;
#pragma unroll
            for (int k = 0; k < 16; ++k) {
              float v1 = acc[2 * cp][k] * rinv, v2 = acc[2 * cp + 1][k] * rinv;
              s2 += v1 * v1 + v2 * v2;
            }
            s2 = xsum32(s2);
            const float r2 = rsqrtf(s2 * (1.f / 64.f) + EPS) * rinv;
#pragma unroll
            for (int gq = 0; gq < 4; ++gq) {
              const int j = 8 * gq + 4 * h;
              float4 g1 = *(const float4*)(qg + 128 + j), g2 = *(const float4*)(qg + 160 + j);
              const float4* rp = (const float4*)(rope + s * 32 + j);
              float4 cs01 = rp[0], cs23 = rp[1];
              float x1, x2;
              x1 = acc[2 * cp][4 * gq + 0] * r2 * g1.x; x2 = acc[2 * cp + 1][4 * gq + 0] * r2 * g2.x;
              acc[2 * cp][4 * gq + 0] = (x1 * cs01.x - x2 * cs01.y) * QS; acc[2 * cp + 1][4 * gq + 0] = (x2 * cs01.x + x1 * cs01.y) * QS;
              x1 = acc[2 * cp][4 * gq + 1] * r2 * g1.y; x2 = acc[2 * cp + 1][4 * gq + 1] * r2 * g2.y;
              acc[2 * cp][4 * gq + 1] = (x1 * cs01.z - x2 * cs01.w) * QS; acc[2 * cp + 1][4 * gq + 1] = (x2 * cs01.z + x1 * cs01.w) * QS;
              x1 = acc[2 * cp][4 * gq + 2] * r2 * g1.z; x2 = acc[2 * cp + 1][4 * gq + 2] * r2 * g2.z;
              acc[2 * cp][4 * gq + 2] = (x1 * cs23.x - x2 * cs23.y) * QS; acc[2 * cp + 1][4 * gq + 2] = (x2 * cs23.x + x1 * cs23.y) * QS;
              x1 = acc[2 * cp][4 * gq + 3] * r2 * g1.w; x2 = acc[2 * cp + 1][4 * gq + 3] * r2 * g2.w;
              acc[2 * cp][4 * gq + 3] = (x1 * cs23.z - x2 * cs23.w) * QS; acc[2 * cp + 1][4 * gq + 3] = (x2 * cs23.z + x1 * cs23.w) * QS;
            }
          }
          u16* base = Qm + ((size_t)(b * 4 + (ft - 4) * 2) * S_ + s0) * 192 + 128;
          store_rows_bf16_lds(acc, wsm, lane, [&](int row, int c16) __attribute__((always_inline)) {
            return base + (size_t)(c16 >> 3) * S_ * 192 + (size_t)row * 192 + (c16 & 7) * 8; });
        }
      });
  });
  xcd_tiles(p.ws, 2, 4, [&](int tt, int ft2) __attribute__((always_inline)) {
    const float* kg = p.in[11];
    gemm_tile<256, true>((const u16*)(p.ws + OFF_WKV), 1024, ft2 * 256, proj + 384, NPROJ, (size_t)tt * 256, smem,
      [&](f32x16 (&acc)[4], float ss, int t, int h, int wf, char* wbase, int tg) __attribute__((always_inline)) {
        const int ft = ft2 * 2 + wf;
        const float rinv = rsqrtf(ss * (1.f / 256.f) + EPS);
        const int lane = ltid() & 63, tg0 = t & ~31, b = tg0 >> 12, s0 = tg0 & 4095;
        char* wsm = wbase + tg * 8704;
        if (ft < 4) {
          float s2 = 0.f;
#pragma unroll
          for (int c = 0; c < 4; ++c)
#pragma unroll
            for (int k = 0; k < 16; ++k) { float v = acc[c][k] * rinv; s2 += v * v; }
          s2 = xsum32(s2);
          const float r2 = rsqrtf(s2 * (1.f / 128.f) + EPS) * rinv;
#pragma unroll
          for (int c = 0; c < 4; ++c)
#pragma unroll
            for (int gq = 0; gq < 4; ++gq) {
              const int d = 32 * c + 8 * gq + 4 * h;
              float4 gg = *(const float4*)(kg + d);
              acc[c][4 * gq] *= r2 * gg.x; acc[c][4 * gq + 1] *= r2 * gg.y;
              acc[c][4 * gq + 2] *= r2 * gg.z; acc[c][4 * gq + 3] *= r2 * gg.w;
            }
          u16* base = Km + ((size_t)(b * 4 + ft) * S_ + s0) * 192;
          store_rows_bf16_lds(acc, wsm, lane, [&](int row, int c16) __attribute__((always_inline)) { return base + (size_t)row * 192 + c16 * 8; });
        } else {
#pragma unroll
          for (int c = 0; c < 4; ++c)
#pragma unroll
            for (int k = 0; k < 16; ++k) acc[c][k] *= rinv;
          u16* base = Vm + ((size_t)(b * 4 + (ft - 4)) * S_ + s0) * 128;
          store_rows_bf16_lds(acc, wsm, lane, [&](int row, int c16) __attribute__((always_inline)) { return base + (size_t)row * 128 + c16 * 8; });
        }
      });
  });
  {
    const size_t gt = (size_t)lbid() * 512 + ltid(), NT = (size_t)G * 512;
    for (size_t e = gt; e < (size_t)T_ * 17; e += NT) {
      const int t = (int)(e / 17), gi = (int)(e % 17);
      const int b = t >> 12, s = t & 4095;
      const u16* src; const float* gain; float scale; u16* dst; int ncopy = 1; size_t cstride = 0;
      if (gi == 0) {
        src = proj + (size_t)t * NPROJ + 640; gain = p.in[11] + 128; scale = 1.f;
        dst = Km + ((size_t)(b * 4) * S_ + s) * 192 + 128; ncopy = 4; cstride = (size_t)S_ * 192;
      } else if (gi < 9) {
        const int j = gi - 1;
        src = proj + (size_t)t * NPROJ + 704 + j * 64; gain = p.in[12]; scale = 0.125f * LOG2E;
        dst = Qd + ((size_t)(b * 8 + j) * S_ + s) * 64;
      } else {
        const int j = gi - 9;
        src = proj + (size_t)t * NPROJ + 1216 + j * 64; gain = p.in[13]; scale = 1.f;
        dst = Kd + ((size_t)(b * 8 + j) * S_ + s) * 64;
      }
      uint4 raw[8];
#pragma unroll
      for (int q = 0; q < 8; ++q) raw[q] = ((const uint4*)src)[q];
      float ss = 0.f;
#pragma unroll
      for (int q = 0; q < 8; ++q) {
        ss = dot2bf(raw[q].x, raw[q].x, ss); ss = dot2bf(raw[q].y, raw[q].y, ss);
        ss = dot2bf(raw[q].z, raw[q].z, ss); ss = dot2bf(raw[q].w, raw[q].w, ss);
      }
      const float rinv = rsqrtf(ss * (1.f / 64.f) + EPS);
      const float rs = rinv * scale;
#pragma unroll
      for (int q = 0; q < 4; ++q) {
        const unsigned lo[4] = {raw[q].x, raw[q].y, raw[q].z, raw[q].w};
        const unsigned hi[4] = {raw[q + 4].x, raw[q + 4].y, raw[q + 4].z, raw[q + 4].w};
        unsigned o1[4], o2[4];
#pragma unroll
        for (int e2 = 0; e2 < 4; ++e2) {
          const int k = 8 * q + 2 * e2;
          const float4 cs = *(const float4*)(rope + s * 32 + k);
          const float2 ga = *(const float2*)(gain + k), gb = *(const float2*)(gain + 32 + k);
          float x1a = bflo(lo[e2]) * rs * ga.x, x2a = bflo(hi[e2]) * rs * gb.x;
          float x1b = bfhi(lo[e2]) * rs * ga.y, x2b = bfhi(hi[e2]) * rs * gb.y;
          o1[e2] = pk2(x1a * cs.x - x2a * cs.y, x1b * cs.z - x2b * cs.w);
          o2[e2] = pk2(x2a * cs.x + x1a * cs.y, x2b * cs.z + x1b * cs.w);
        }
        uint4 v1 = make_uint4(o1[0], o1[1], o1[2], o1[3]), v2 = make_uint4(o2[0], o2[1], o2[2], o2[3]);
        for (int cpy = 0; cpy < ncopy; ++cpy) {
          ((uint4*)(dst + cpy * cstride))[q] = v1;
          ((uint4*)(dst + cpy * cstride))[q + 4] = v2;
        }
      }
    }
  }
}

template <int NS, int RSK, bool QLDS>
DI void qk_softmax32(const char* kbuf, const bf16x8 (&qf)[NS], const char* qlds, bool needmask, int keybase, int qrow, int h, int r,
                     float& mrun, float& lrun, f32x16 (&O)[4], bf16x8& pf0, bf16x8& pf1) {
  f32x16 sacc;
#pragma unroll
  for (int i = 0; i < 16; ++i) sacc[i] = 0.f;
#pragma unroll
  for (int s = 0; s < NS; ++s) {
    bf16x8 a = *(const bf16x8*)(kbuf + r * RSK + (16 * s + 8 * h) * 2);
    bf16x8 bq;
    if (QLDS) bq = *(const bf16x8*)(qlds + (16 * s + 8 * h) * 2); else bq = qf[s];
    sacc = MFMA(a, bq, sacc);
  }
  if (needmask) {
#pragma unroll
    for (int i = 0; i < 16; ++i) {
      const int key = keybase + 8 * (i >> 2) + 4 * h + (i & 3);
      if (key > qrow) sacc[i] = NEG_INF;
    }
  }
  float mx = sacc[0];
#pragma unroll
  for (int i = 1; i < 16; ++i) mx = fmaxf(mx, sacc[i]);
  mx = xmax32(mx);
  if (__builtin_amdgcn_ballot_w64(mx > mrun + 8.f) != 0ull) {
    const float mnew = fmaxf(mrun, mx);
    const float alpha = __builtin_amdgcn_exp2f(mrun - mnew);
    mrun = mnew;
    lrun *= alpha;
#pragma unroll
    for (int c = 0; c < 4; ++c)
#pragma unroll
      for (int i = 0; i < 16; ++i) O[c][i] *= alpha;
  }
  float rs = 0.f;
#pragma unroll
  for (int i = 0; i < 16; ++i) {
    float pv = __builtin_amdgcn_exp2f(sacc[i] - mrun);
    rs += pv; sacc[i] = pv;
  }
  lrun += rs;
  uint4 pa, pb;
  pa.x = pk2(sacc[0], sacc[1]); pa.y = pk2(sacc[2], sacc[3]); pa.z = pk2(sacc[4], sacc[5]); pa.w = pk2(sacc[6], sacc[7]);
  pb.x = pk2(sacc[8], sacc[9]); pb.y = pk2(sacc[10], sacc[11]); pb.z = pk2(sacc[12], sacc[13]); pb.w = pk2(sacc[14], sacc[15]);
  pf0 = __builtin_bit_cast(bf16x8, pa);
  pf1 = __builtin_bit_cast(bf16x8, pb);
}

template <int DQK, int NMAP>
DI void attn_item(const u16* __restrict__ qb0, const u16* __restrict__ qb1, const u16* __restrict__ kb0,
                  const u16* __restrict__ kb1, const u16* __restrict__ vb, int vstride, int qblk,
                  u16* __restrict__ outp, const float* __restrict__ lamp, const float* __restrict__ subg, char* smem) {
  constexpr int NS = DQK / 16;
  constexpr int RSK = DQK * 2 + 16;
  constexpr int KTILE = 64 * RSK;
  constexpr int VOFF = NMAP * KTILE;
  constexpr int STAGE = VOFF + 64 * 320;
  constexpr int CPR = DQK / 8;
  constexpr int KCH = NMAP * 64 * CPR / 512;
  int tid_ = ltid();
  asm volatile("" : "+v"(tid_));
  const int tid = tid_, lane = tid & 63, w = tid >> 6, h = lane >> 5, r = lane & 31;
  const int blk = (lane >> 4) & 1, q4 = (lane & 15) >> 2, p4 = lane & 3;
  const int q0 = qblk * 256, wrow0 = q0 + 32 * w, qrow = wrow0 + r;
  const int nt = 4 * (qblk + 1);

  constexpr bool QL = (NMAP == 2);
  bf16x8 qfa[NS];
  if (!QL) {
#pragma unroll
    for (int s = 0; s < NS; ++s) qfa[s] = *(const bf16x8*)(qb0 + (size_t)qrow * DQK + 16 * s + 8 * h);
  } else {
#pragma unroll
    for (int s = 0; s < NS; ++s) qfa[s] = bf16x8{0, 0, 0, 0, 0, 0, 0, 0};
#pragma unroll
    for (int i = 0; i < 8; ++i) {
      const int id = tid + 512 * i, mp = id >> 11, rem = id & 2047, row = rem >> 3, c16 = rem & 7;
      *(u32x4*)(smem + 2 * STAGE + mp * 36864 + row * 144 + c16 * 16) =
          *(const u32x4*)((mp ? qb1 : qb0) + (size_t)(q0 + row) * DQK + c16 * 8);
    }
  }
  const char* qla = smem + 2 * STAGE + (32 * w + r) * 144;
  const char* qlb = qla + 36864;
  f32x16 Oa[4], Ob[4];
  float ma = NEG_INF, la = 0.f, mb = NEG_INF, lb = 0.f;
#pragma unroll
  for (int c = 0; c < 4; ++c)
#pragma unroll
    for (int i = 0; i < 16; ++i) { Oa[c][i] = 0.f; if (NMAP == 2) Ob[c][i] = 0.f; }

  u32x4 rk[KCH], rv[2];
  unsigned koff[KCH], voff[2];
#pragma unroll
  for (int i = 0; i < KCH; ++i) {
    const int id = tid + 512 * i;
    if (NMAP == 1) koff[i] = (unsigned)((id / CPR) * DQK + (id % CPR) * 8);
    else koff[i] = (unsigned)((((id & 511) >> 3)) * DQK + (id & 7) * 8);
  }
#pragma unroll
  for (int i = 0; i < 2; ++i) {
    const int id = tid + 512 * i;
    voff[i] = (unsigned)((id >> 4) * vstride + (id & 15) * 8);
  }
  auto gload = [&](int t) __attribute__((always_inline)) {
    const u16* k0t = kb0 + (size_t)t * 64 * DQK;
    const u16* k1t = (NMAP == 2) ? kb1 + (size_t)t * 64 * DQK : k0t;
    const u16* vt = vb + (size_t)t * 64 * vstride;
#pragma unroll
    for (int i = 0; i < KCH; ++i) rk[i] = *(const u32x4*)(((NMAP == 2 && i) ? k1t : k0t) + koff[i]);
#pragma unroll
    for (int i = 0; i < 2; ++i) rv[i] = *(const u32x4*)(vt + voff[i]);
  };
  auto sstore = [&](char* buf) __attribute__((always_inline)) {
#pragma unroll
    for (int i = 0; i < KCH; ++i) {
      const int id = tid + 512 * i;
      if (NMAP == 1) {
        const int row = id / CPR, c16 = id % CPR;
        *(u32x4*)(buf + row * RSK + c16 * 16) = rk[i];
      } else {
        const int rem = id & 511, row = rem >> 3, c16 = rem & 7;
        *(u32x4*)(buf + i * KTILE + row * RSK + c16 * 16) = rk[i];
      }
    }
#pragma unroll
    for (int i = 0; i < 2; ++i) {
      const int id = tid + 512 * i, row = id >> 4, c16 = id & 15;
      *(u32x4*)(buf + VOFF + row * 320 + c16 * 16) = rv[i];
    }
  };

  gload(0);
  sstore(smem);
  gload(1);
  __syncthreads();
  for (int t = 0; t < nt; ++t) {
    char* buf = smem + (t & 1) * STAGE;
    if (t + 1 < nt) {
      sstore(smem + ((t + 1) & 1) * STAGE);
      if (t + 2 < nt) gload(t + 2);
    }
    const int key0 = t * 64;
#pragma unroll
    for (int sub = 0; sub < 2; ++sub) {
      const int ko = sub * 32;
      if (key0 + ko <= wrow0 + 31) {
        const bool needmask = (key0 + ko + 31 > wrow0);
        bf16x8 pa0, pa1, pb0, pb1;
        qk_softmax32<NS, RSK, QL>(buf + ko * RSK, qfa, qla, needmask, key0 + ko, qrow, h, r, ma, la, Oa, pa0, pa1);
        if (NMAP == 2)
          qk_softmax32<NS, RSK, QL>(buf + KTILE + ko * RSK, qfa, qlb, needmask, key0 + ko, qrow, h, r, mb, lb, Ob, pb0, pb1);
#pragma unroll
        for (int ks = 0; ks < 2; ++ks)
#pragma unroll
          for (int c = 0; c < 4; ++c) {
            const char* ap = buf + VOFF + (ko + 16 * ks + 4 * h + q4) * 320 + (32 * c + 16 * blk) * 2 + 8 * p4;
            s16x4 lo = trread(ap), hi = trread(ap + 8 * 320);
            bf16x8 a = __builtin_shufflevector(lo, hi, 0, 1, 2, 3, 4, 5, 6, 7);
            Oa[c] = MFMA(a, ks ? pa1 : pa0, Oa[c]);
            if (NMAP == 2) Ob[c] = MFMA(a, ks ? pb1 : pb0, Ob[c]);
          }
      }
    }
    __syncthreads();
  }
  const float inva = 1.f / xsum32(la);
  if (NMAP == 1) {
#pragma unroll
    for (int c = 0; c < 4; ++c)
#pragma unroll
      for (int i = 0; i < 16; ++i) Oa[c][i] *= inva;
  } else {
    const float li = *lamp / xsum32(lb);
    float s2 = 0.f;
#pragma unroll
    for (int c = 0; c < 4; ++c)
#pragma unroll
      for (int i = 0; i < 16; ++i) {
        float v = Oa[c][i] * inva - li * Ob[c][i];
        Oa[c][i] = v; s2 += v * v;
      }
    s2 = xsum32(s2);
    const float rn = rsqrtf(s2 * (1.f / 128.f) + EPS) * 0.8f;
#pragma unroll
    for (int c = 0; c < 4; ++c)
#pragma unroll
      for (int gq = 0; gq < 4; ++gq) {
        const int d = 32 * c + 8 * gq + 4 * h;
        asm volatile("" ::: "memory");
        float4 gg = *(const float4*)(subg + d);
        Oa[c][4 * gq] *= rn * gg.x; Oa[c][4 * gq + 1] *= rn * gg.y; Oa[c][4 * gq + 2] *= rn * gg.z; Oa[c][4 * gq + 3] *= rn * gg.w;
      }
  }
  {
    u16* base = outp + (size_t)wrow0 * LDH;
    store_rows_bf16_lds(Oa, smem + w * 8704, lane, [&](int row, int c16) __attribute__((always_inline)) { return base + (size_t)row * LDH + c16 * 8; });
  }
  __syncthreads();
}

DI void conv_table_slice(const float* __restrict__ src, uint2* __restrict__ dst, float scale, int slice, int nslices) {
  const size_t groups = (size_t)16384 * 1024 / 16;
  const size_t gt = (size_t)lbid() * 512 + ltid(), NT = (size_t)lgdim() * 512;
  const size_t lo = groups * slice / nslices, hi = groups * (slice + 1) / nslices;
  for (size_t i = lo + gt; i < hi; i += NT) {
    const float4* sp = (const float4*)src + 4 * i;
    float4 a0 = sp[0], a1 = sp[1], a2 = sp[2], a3 = sp[3];
    unsigned w0 = 0, w1 = 0;
    w0 = __builtin_amdgcn_cvt_scalef32_pk_fp4_f32(w0, a0.x * scale, a0.y * scale, 1.0f, 0);
    w0 = __builtin_amdgcn_cvt_scalef32_pk_fp4_f32(w0, a0.z * scale, a0.w * scale, 1.0f, 1);
    w0 = __builtin_amdgcn_cvt_scalef32_pk_fp4_f32(w0, a1.x * scale, a1.y * scale, 1.0f, 2);
    w0 = __builtin_amdgcn_cvt_scalef32_pk_fp4_f32(w0, a1.z * scale, a1.w * scale, 1.0f, 3);
    w1 = __builtin_amdgcn_cvt_scalef32_pk_fp4_f32(w1, a2.x * scale, a2.y * scale, 1.0f, 0);
    w1 = __builtin_amdgcn_cvt_scalef32_pk_fp4_f32(w1, a2.z * scale, a2.w * scale, 1.0f, 1);
    w1 = __builtin_amdgcn_cvt_scalef32_pk_fp4_f32(w1, a3.x * scale, a3.y * scale, 1.0f, 2);
    w1 = __builtin_amdgcn_cvt_scalef32_pk_fp4_f32(w1, a3.z * scale, a3.w * scale, 1.0f, 3);
    dst[i] = make_uint2(w0, w1);
  }
}

DI void phase_attn(const Params& p, char* smem) {
  const int G = lgdim(), g = lbid();
  const u16* Qm = (const u16*)(p.ws + OFF_QM); const u16* Km = (const u16*)(p.ws + OFF_KM);
  const u16* Vm = (const u16*)(p.ws + OFF_VM); const u16* Qd = (const u16*)(p.ws + OFF_QD);
  const u16* Kd = (const u16*)(p.ws + OFF_KD); const u16* proj = (const u16*)(p.ws + OFF_PROJ);
  u16* mixed = (u16*)(p.ws + OFF_H);
  const float* lamp = (const float*)(p.ws + OFF_LAM);
  const int nrounds = (2048 + G - 1) / G;
  for (int k = 0; k * G < 2048; ++k) {
    conv_table_slice(p.in[23], (uint2*)(p.ws + OFF_U), U_SCALE, k, nrounds);
    conv_table_slice(p.in[24], (uint2*)(p.ws + OFF_V), V_SCALE, k, nrounds);
    const int idx = (k & 1) ? k * G + (G - 1 - g) : k * G + g;
    if (idx >= 2048) continue;
    const int level = idx >> 7, qblk = 15 - level, j = idx & 127, type = j & 1, bh = j >> 1;
    const int b = bh >> 2, hd = bh & 3;
    if (type == 0) {
      const size_t ho = (size_t)(b * 4 + hd) * S_;
      attn_item<192, 1>(Qm + ho * 192, nullptr, Km + ho * 192, nullptr, Vm + ho * 128, 128, qblk,
                        mixed + (size_t)b * S_ * LDH + hd * 128, lamp, nullptr, smem);
    } else {
      const size_t h0 = (size_t)(b * 8 + 2 * hd) * S_ * 64, h1 = h0 + (size_t)S_ * 64;
      attn_item<64, 2>(Qd + h0, Qd + h1, Kd + h0, Kd + h1, proj + (size_t)b * S_ * NPROJ + 1728 + hd * 128, NPROJ,
                       qblk, mixed + (size_t)b * S_ * LDH + 512 + hd * 128, lamp, p.in[18], smem);
    }
  }
}

template <int ST>
DI void ins1(float (&T)[16], float s) {
#pragma unroll
  for (int j = 15; j > ST; --j) T[j] = __builtin_amdgcn_fmed3f(T[j - 1], s, T[j]);
  T[ST] = fmaxf(T[ST], s);
}
DI void peer_scores_top16(const char* sk, const u16* __restrict__ pqrow, int lane, float (&T)[16]) {
  const int h = lane >> 5, r = lane & 31;
  bf16x8 bq[8];
#pragma unroll
  for (int s = 0; s < 8; ++s) bq[s] = *(const bf16x8*)(pqrow + 16 * s + 8 * h);
#pragma unroll
  for (int j = 0; j < 16; ++j) T[j] = NEG_INF;
#pragma unroll
  for (int c = 0; c < 4; ++c) {
    f32x16 acc;
#pragma unroll
    for (int i = 0; i < 16; ++i) acc[i] = 0.f;
#pragma unroll
    for (int s = 0; s < 8; ++s) {
      bf16x8 a = *(const bf16x8*)(sk + (32 * c + r) * 272 + (16 * s + 8 * h) * 2);
      acc = MFMA(a, bq[s], acc);
    }
#pragma unroll
    for (int i = 0; i < 16; ++i) {
      const unsigned code = (unsigned)(127 - 32 * c - (i & 3) - 8 * (i >> 2)) - 4u * (unsigned)h;
      ins1<0>(T, __uint_as_float((__float_as_uint(acc[i]) & 0xffffff80u) | code));
    }
  }
  float o[16];
#pragma unroll
  for (int j = 0; j < 16; ++j) {
    auto rr = __builtin_amdgcn_permlane32_swap(__float_as_uint(T[j]), __float_as_uint(T[j]), false, false);
    o[j] = __uint_as_float(h ? rr[0] : rr[1]);
  }
  ins1<0>(T, o[0]); ins1<1>(T, o[1]); ins1<2>(T, o[2]); ins1<3>(T, o[3]);
  ins1<4>(T, o[4]); ins1<5>(T, o[5]); ins1<6>(T, o[6]); ins1<7>(T, o[7]);
  ins1<8>(T, o[8]); ins1<9>(T, o[9]); ins1<10>(T, o[10]); ins1<11>(T, o[11]);
  ins1<12>(T, o[12]); ins1<13>(T, o[13]); ins1<14>(T, o[14]); ins1<15>(T, o[15]);
}

DI float gelu_exact(float x) { return 0.5f * x * (1.f + erff(x * 0.7071067811865476f)); }

DI void load_sk(char* smem, const u16* SK, int hp, int tid) {
#pragma unroll
  for (int i = 0; i < 4; ++i) {
    const int id = tid + 512 * i, row = id >> 4, c16 = id & 15;
    *(u32x4*)(smem + row * 272 + c16 * 16) = *(const u32x4*)(SK + (size_t)hp * 16384 + row * 128 + c16 * 8);
  }
}

DI void peer_route(const Params& p, char* smem, int t0) {
  const int tid = ltid(), lane = tid & 63, w = tid >> 6, h = lane >> 5, r = lane & 31;
  const u16* pq = (const u16*)(p.ws + OFF_PROJ);
  const u16* SK = (const u16*)(p.ws + OFF_SK);
  uint2* topk = (uint2*)(p.ws + OFF_TOPK);
    const int tq = t0 + 32 * w + r;
#pragma unroll 1
    for (int hd = 0; hd < 8; ++hd) {
      float TA[16], TB[16];
      __syncthreads();
      load_sk(smem, SK, hd * 2, tid);
      __syncthreads();
      peer_scores_top16(smem, pq + (size_t)tq * 2048 + (hd * 2) * 128, lane, TA);
      __syncthreads();
      load_sk(smem, SK, hd * 2 + 1, tid);
      __syncthreads();
      peer_scores_top16(smem, pq + (size_t)tq * 2048 + (hd * 2 + 1) * 128, lane, TB);
      float FK[16];
#pragma unroll
      for (int j = 0; j < 16; ++j) FK[j] = NEG_INF;
#pragma unroll
      for (int i = 0; i < 16; ++i)
#pragma unroll
        for (int j = 0; j < 16; ++j)
          if ((i + 1) * (j + 1) <= 16) {
            const float cv = __uint_as_float(__float_as_uint(TA[i]) & 0xffffff80u) + __uint_as_float(__float_as_uint(TB[j]) & 0xffffff80u);
            const float key = __uint_as_float((__float_as_uint(cv) & 0xffffff00u) | (unsigned)(255 - (16 * i + j)));
            const int st = (i + 1) * (j + 1) - 1;
#pragma unroll
            for (int q = 15; q >= 1; --q)
              if (q > st) FK[q] = __builtin_amdgcn_fmed3f(FK[q - 1], key, FK[q]);
            FK[st] = fmaxf(FK[st], key);
          }
      float FV[16]; int FI[16];
#pragma unroll
      for (int m = 0; m < 16; ++m) {
        const unsigned kb = __float_as_uint(FK[m]);
        const int code = 255 - (int)(kb & 255u), ci = code >> 4, cj = code & 15;
        FV[m] = __uint_as_float(kb & 0xffffff00u);
        float ra = TA[0], rb = TB[0];
#pragma unroll
        for (int q = 1; q < 16; ++q) { ra = (ci == q) ? TA[q] : ra; rb = (cj == q) ? TB[q] : rb; }
        FI[m] = (127 - (int)(__float_as_uint(ra) & 127u)) * 128 + (127 - (int)(__float_as_uint(rb) & 127u));
      }
      float e[16], sum = 0.f;
#pragma unroll
      for (int j = 0; j < 16; ++j) { e[j] = expf(FV[j] - FV[0]); sum += e[j]; }
      const float rs = 1.f / sum;
      if (h == 0) {
        u32x4* dst = (u32x4*)(topk + (size_t)tq * 128 + hd * 16);
#pragma unroll
        for (int q = 0; q < 8; ++q) {
          u32x4 o;
          o.x = (unsigned)FI[2 * q]; o.y = __float_as_uint(e[2 * q] * rs);
          o.z = (unsigned)FI[2 * q + 1]; o.w = __float_as_uint(e[2 * q + 1] * rs);
          dst[q] = o;
        }
      }
    }
}

DI void peer_gather(const Params& p, int t0) {
  const int tid = ltid(), lane = tid & 63, w = tid >> 6;
  const uint2* topk = (const uint2*)(p.ws + OFF_TOPK);
  const float* mod = (const float*)(p.ws + OFF_MOD);
  const unsigned char* U8 = (const unsigned char*)(p.ws + OFF_U);
  const unsigned char* V8 = (const unsigned char*)(p.ws + OFF_V);
#pragma unroll 1
  for (int ti = 0; ti < 32; ++ti) {
    const int t = t0 + 32 * w + ti, b = t >> 12;
    const float* mb = mod + b * 6144;
    float* orow = p.out + (size_t)t * 1024 + lane * 16;
    f32x2 xr[8];
#pragma unroll
    for (int q = 0; q < 4; ++q) {
      float4 a = ((const float4*)orow)[q];
      xr[2 * q] = f32x2{a.x, a.y}; xr[2 * q + 1] = f32x2{a.z, a.w};
    }
    float ss = 0.f;
#pragma unroll
    for (int i = 0; i < 8; ++i) ss += xr[i].x * xr[i].x + xr[i].y * xr[i].y;
    ss = wave_sum(ss);
    const float rinv = rsqrtf(ss * (1.f / 1024.f) + EPS);
    f32x2 hf[8];
#pragma unroll
    for (int q = 0; q < 4; ++q) {
      const int d0 = lane * 16 + 4 * q;
      float4 gg = *(const float4*)(p.in[20] + d0);
      float4 sc = *(const float4*)(mb + 4096 + d0);
      float4 sh = *(const float4*)(mb + 3072 + d0);
      hf[2 * q] = f32x2{xr[2 * q].x * rinv * gg.x * (1.f + sc.x) + sh.x, xr[2 * q].y * rinv * gg.y * (1.f + sc.y) + sh.y};
      hf[2 * q + 1] = f32x2{xr[2 * q + 1].x * rinv * gg.z * (1.f + sc.z) + sh.z, xr[2 * q + 1].y * rinv * gg.w * (1.f + sc.w) + sh.w};
    }
    const u32x4 tk = *(const u32x4*)(topk + (size_t)t * 128 + lane * 2);
    f32x2 y[8];
#pragma unroll
    for (int i = 0; i < 8; ++i) y[i] = f32x2{0.f, 0.f};
    uint2 ua[16], va[16], ub[16], vb[16];
    float gA, gB;
    auto issue = [&](int jj, uint2 (&uu)[16], uint2 (&vv)[16], float& gsel) __attribute__((always_inline)) {
      float gs = 0.f;
#pragma unroll
      for (int k = 0; k < 16; ++k) {
        const int l = 8 * jj + (k >> 1);
        const int e = __builtin_amdgcn_readlane((int)((k & 1) ? tk.z : tk.x), l);
        const float g = __uint_as_float(__builtin_amdgcn_readlane((int)((k & 1) ? tk.w : tk.y), l));
        gs = ((lane >> 2) == k) ? g : gs;
        uu[k] = *(const uint2*)(U8 + (size_t)e * 512 + lane * 8);
        vv[k] = *(const uint2*)(V8 + (size_t)e * 512 + lane * 8);
      }
      gsel = gs;
    };
    auto process = [&](const uint2 (&uu)[16], const uint2 (&vv)[16], float gsel) __attribute__((always_inline)) {
      float d[16];
#pragma unroll
      for (int k = 0; k < 16; ++k) {
        f32x2 a2 = f32x2{0.f, 0.f};
        a2 = __builtin_amdgcn_cvt_scalef32_pk_f32_fp4(uu[k].x, 1.0f, 0) * hf[0] + a2;
        a2 = __builtin_amdgcn_cvt_scalef32_pk_f32_fp4(uu[k].x, 1.0f, 1) * hf[1] + a2;
        a2 = __builtin_amdgcn_cvt_scalef32_pk_f32_fp4(uu[k].x, 1.0f, 2) * hf[2] + a2;
        a2 = __builtin_amdgcn_cvt_scalef32_pk_f32_fp4(uu[k].x, 1.0f, 3) * hf[3] + a2;
        a2 = __builtin_amdgcn_cvt_scalef32_pk_f32_fp4(uu[k].y, 1.0f, 0) * hf[4] + a2;
        a2 = __builtin_amdgcn_cvt_scalef32_pk_f32_fp4(uu[k].y, 1.0f, 1) * hf[5] + a2;
        a2 = __builtin_amdgcn_cvt_scalef32_pk_f32_fp4(uu[k].y, 1.0f, 2) * hf[6] + a2;
        a2 = __builtin_amdgcn_cvt_scalef32_pk_f32_fp4(uu[k].y, 1.0f, 3) * hf[7] + a2;
        d[k] = a2.x + a2.y;
      }
      const bool h32 = (lane & 32) != 0, h16 = (lane & 16) != 0, h8 = (lane & 8) != 0, h4 = (lane & 4) != 0;
      float r8[8], r4[4], r2[2];
#pragma unroll
      for (int i = 0; i < 8; ++i) r8[i] = swapsum32(d[i], d[8 + i]);
#pragma unroll
      for (int i = 0; i < 4; ++i) r4[i] = swapsum16(r8[i], r8[4 + i]);
#pragma unroll
      for (int i = 0; i < 2; ++i) r2[i] = (h8 ? r4[2 + i] : r4[i]) + dppmov<0x128>(h8 ? r4[i] : r4[2 + i]);
      float kk = (h4 ? r2[1] : r2[0]) + dppmov<0x141>(h4 ? r2[0] : r2[1]);
      kk += dppmov<0x4E>(kk); kk += dppmov<0xB1>(kk);
      const float coefv = gsel * gelu_exact(kk * (1.f / U_SCALE)) * (1.f / V_SCALE);
#pragma unroll
      for (int k = 0; k < 16; ++k) {
        const float cf = __uint_as_float(__builtin_amdgcn_readlane((int)__float_as_uint(coefv), 4 * k));
        const f32x2 cf2 = f32x2{cf, cf};
        y[0] = __builtin_amdgcn_cvt_scalef32_pk_f32_fp4(vv[k].x, 1.0f, 0) * cf2 + y[0];
        y[1] = __builtin_amdgcn_cvt_scalef32_pk_f32_fp4(vv[k].x, 1.0f, 1) * cf2 + y[1];
        y[2] = __builtin_amdgcn_cvt_scalef32_pk_f32_fp4(vv[k].x, 1.0f, 2) * cf2 + y[2];
        y[3] = __builtin_amdgcn_cvt_scalef32_pk_f32_fp4(vv[k].x, 1.0f, 3) * cf2 + y[3];
        y[4] = __builtin_amdgcn_cvt_scalef32_pk_f32_fp4(vv[k].y, 1.0f, 0) * cf2 + y[4];
        y[5] = __builtin_amdgcn_cvt_scalef32_pk_f32_fp4(vv[k].y, 1.0f, 1) * cf2 + y[5];
        y[6] = __builtin_amdgcn_cvt_scalef32_pk_f32_fp4(vv[k].y, 1.0f, 2) * cf2 + y[6];
        y[7] = __builtin_amdgcn_cvt_scalef32_pk_f32_fp4(vv[k].y, 1.0f, 3) * cf2 + y[7];
      }
    };
    issue(0, ua, va, gA);
#pragma unroll 1
    for (int jj = 0; jj < 8; jj += 2) {
      issue(jj + 1, ub, vb, gB);
      __builtin_amdgcn_sched_barrier(0);
      process(ua, va, gA);
      __builtin_amdgcn_sched_barrier(0);
      issue((jj + 2) & 7, ua, va, gA);
      __builtin_amdgcn_sched_barrier(0);
      process(ub, vb, gB);
      __builtin_amdgcn_sched_barrier(0);
    }
#pragma unroll
    for (int q = 0; q < 4; ++q) {
      float4 g2 = *(const float4*)(mb + 5120 + lane * 16 + 4 * q);
      float4 o;
      o.x = xr[2 * q].x + g2.x * y[2 * q].x; o.y = xr[2 * q].y + g2.y * y[2 * q].y;
      o.z = xr[2 * q + 1].x + g2.z * y[2 * q + 1].x; o.w = xr[2 * q + 1].y + g2.w * y[2 * q + 1].y;
      ((float4*)orow)[q] = o;
    }
  }
}

constexpr size_t OFF_BAR = 413696;
#define XB_TMO      128
#define XB_XCNT(j)  (256  + 64 * (j))
#define XB_XSUB(j)  (1280 + 64 * (j))
#define XB_XGEN(j)  (2304 + 64 * (j))
#define XB_TOP      3328
#define XB_TOPGEN   3392
#define XCD_BAR_WORDS 3456
#define XB_SPIN_CAP (1u << 18)
#define XLAS __attribute__((address_space(3)))
DI unsigned xb_ld(unsigned* p) { return __hip_atomic_load(p, __ATOMIC_RELAXED, __HIP_MEMORY_SCOPE_AGENT); }
DI unsigned xb_add(unsigned* p, unsigned v) { return __hip_atomic_fetch_add(p, v, __ATOMIC_RELAXED, __HIP_MEMORY_SCOPE_AGENT); }
DI unsigned xb_xcc_id() { return (unsigned)__builtin_amdgcn_s_getreg((3 << 11) | 20) & 0xFu; }
#define XB_SPIN(cond, bar) do { unsigned _sp = 0; while (cond) { __builtin_amdgcn_s_sleep(1); \
    if ((++_sp & 255u) == 0u) { if (xb_ld(&(bar)[XB_TMO])) break; if (_sp > XB_SPIN_CAP) { atomicAdd(&(bar)[XB_TMO], 1u); break; } } } } while (0)
DI void xcd_barrier_complete(unsigned* bar, unsigned x, unsigned& nloc, unsigned& nx) {
  const unsigned G = gridDim.x;
  unsigned sum, cnt, mine, sp = 0u;
  for (;;) {
    sum = 0u; cnt = 0u; mine = 0u;
#pragma unroll
    for (unsigned j = 0; j < 16; ++j) { const unsigned c = xb_ld(&bar[XB_XCNT(j)]); sum += c; cnt += (c > 0u) ? 1u : 0u; mine = (j == x) ? c : mine; }
    if (sum == G) break;
    __builtin_amdgcn_s_sleep(1);
    if ((++sp & 255u) == 0u) { if (xb_ld(&bar[XB_TMO])) break; if (sp > XB_SPIN_CAP) { atomicAdd(&bar[XB_TMO], 1u); break; } }
  }
  nloc = mine > 0u ? mine : 1u; nx = cnt > 0u ? cnt : 1u;
}
DI void xcd_barrier(unsigned* bar, volatile XLAS unsigned* st) {
  asm volatile("s_waitcnt vmcnt(0)" ::: "memory");
  __syncthreads();
  if (threadIdx.x == 0) {
    const unsigned x = xb_xcc_id();
    __builtin_amdgcn_s_waitcnt(0);
    unsigned nloc = st[0], nx = st[1];
    if (nloc == 0u) { xcd_barrier_complete(bar, x, nloc, nx); st[0] = nloc; st[1] = nx; }
    const unsigned old = xb_add(&bar[XB_XSUB(x)], 1u);
    const unsigned gen = old / nloc;
    if (old + 1u == (gen + 1u) * nloc) {
      __builtin_amdgcn_fence(__ATOMIC_RELEASE, "agent");
      asm volatile("s_waitcnt vmcnt(0)" ::: "memory");
      const unsigned og = xb_add(&bar[XB_TOP], 1u);
      const unsigned tg = og / nx;
      if (og + 1u == (tg + 1u) * nx) xb_add(&bar[XB_TOPGEN], 1u);
      else XB_SPIN(xb_ld(&bar[XB_TOPGEN]) == tg, bar);
      __builtin_amdgcn_fence(__ATOMIC_ACQUIRE, "agent");
      xb_add(&bar[XB_XGEN(x)], 1u);
      asm volatile("s_waitcnt vmcnt(0)" ::: "memory");
    } else {
      XB_SPIN(xb_ld(&bar[XB_XGEN(x)]) == gen, bar);
      __builtin_amdgcn_fence(__ATOMIC_ACQUIRE, "agent");
      asm volatile("s_waitcnt vmcnt(0)" ::: "memory");
    }
  }
  __syncthreads();
}

typedef const __attribute__((address_space(4))) Params* KParamsPtr;
__global__ void __launch_bounds__(512) mega(Params p_arg) {
  __shared__ __attribute__((aligned(16))) char smem[151552];
  __shared__ uint4 xb_words;
  if (threadIdx.x == 0) {
    xb_words = make_uint4(0u, 0u, 0u, 0u);
    (void)xb_add(&((unsigned*)(p_arg.ws + OFF_BAR))[XB_XCNT(xb_xcc_id())], 1u);
  }
  __syncthreads();
  for (int ph = p_arg.ph_begin; ph < p_arg.ph_end; ++ph) {
    KParamsPtr kp = (KParamsPtr)__builtin_amdgcn_kernarg_segment_ptr();
    asm volatile("" : "+s"(kp));
    Params p;
#pragma unroll
    for (int i = 0; i < 25; ++i) p.in[i] = kp->in[i];
    p.out = kp->out; p.ws = kp->ws; p.ph_begin = 0; p.ph_end = 0;
    const int G = lgdim();
    if (ph == 0) {
      phase0(p, smem);
    } else if (ph == 1) {
      rownorm_phase(p, p.in[0], p.in[4], 0, 1024, (u16*)(p.ws + OFF_H));
    } else if (ph == 2) {
      u16* proj = (u16*)(p.ws + OFF_PROJ);
      xcd_tiles(p.ws, 0, 9, [&](int tt, int ft2) __attribute__((always_inline)) {
        gemm_tile<1024, false>((const u16*)(p.ws + OFF_WIN), NPROJ, ft2 * 256, (const u16*)(p.ws + OFF_H), LDH,
                               (size_t)tt * 256, smem, [&](f32x16 (&acc)[4], float, int t, int h, int wf, char* wbase, int tg) __attribute__((always_inline)) {
                                 store_tile_bf16_lds(acc, wbase + tg * 8704, proj + (size_t)(t & ~31) * NPROJ + ft2 * 256 + wf * 128, NPROJ, ltid() & 63);
                               });
      });
    } else if (ph == 3) {
      phase_qkv(p, smem);
    } else if (ph == 4) {
      phase_attn(p, smem);
    } else if (ph == 5) {
      const float* mod = (const float*)(p.ws + OFF_MOD);
      xcd_tiles(p.ws, 3, 4, [&](int tt, int ft2) __attribute__((always_inline)) {
        gemm_tile<1024, false>((const u16*)(p.ws + OFF_WOUT), 1024, ft2 * 256, (const u16*)(p.ws + OFF_H), LDH,
                               (size_t)tt * 256, smem, [&](f32x16 (&acc)[4], float, int t, int h, int wf, char* wbase, int tg) __attribute__((always_inline)) {
                                 const int ft = ft2 * 2 + wf, lane = ltid() & 63, r = lane & 31;
#pragma unroll
                                 for (int c = 0; c < 4; ++c)
#pragma unroll
                                   for (int gq = 0; gq < 4; ++gq)
                                     *(float4*)(wbase + r * 528 + (32 * c + 8 * gq + 4 * h) * 4) =
                                         make_float4(acc[c][4 * gq], acc[c][4 * gq + 1], acc[c][4 * gq + 2], acc[c][4 * gq + 3]);
                                 const int tg0 = t & ~31, b = tg0 >> 12;
#pragma unroll
                                 for (int j = 0; j < 16; ++j) {
                                   const int idx = lane + 64 * j, row = idx >> 5, c16 = idx & 31;
                                   const float4 a = *(const float4*)(wbase + row * 528 + c16 * 16);
                                   const int n = ft * 128 + c16 * 4;
                                   const size_t off = (size_t)(tg0 + row) * 1024 + n;
                                   const float4 xv = *(const float4*)(p.in[0] + off);
                                   const float4 g1 = *(const float4*)(mod + b * 6144 + 2048 + n);
                                   float4 o;
                                   o.x = xv.x + g1.x * a.x; o.y = xv.y + g1.y * a.y; o.z = xv.z + g1.z * a.z; o.w = xv.w + g1.w * a.w;
                                   *(float4*)(p.out + off) = o;
                                 }
                               });
      });
    } else if (ph == 6) {
      rownorm_phase(p, p.out, p.in[20], 3072, 4096, (u16*)(p.ws + OFF_H2));
    } else if (ph == 7) {
      u16* pq = (u16*)(p.ws + OFF_PROJ);
      xcd_tiles(p.ws, 4, 8, [&](int tt, int ft2) __attribute__((always_inline)) {
        gemm_tile<1024, false>((const u16*)(p.ws + OFF_WPQ), 2048, ft2 * 256, (const u16*)(p.ws + OFF_H2), LDH,
                               (size_t)tt * 256, smem, [&](f32x16 (&acc)[4], float, int t, int h, int wf, char* wbase, int tg) __attribute__((always_inline)) {
                                 store_tile_bf16_lds(acc, wbase + tg * 8704, pq + (size_t)(t & ~31) * 2048 + ft2 * 256 + wf * 128, 2048, ltid() & 63);
                               });
      });
    } else {
      for (int tt = lbid(); tt < 256; tt += G) {
        peer_route(p, smem, tt * 256);
        asm volatile("s_waitcnt vmcnt(0)" ::: "memory");
        __syncthreads();
        if (threadIdx.x == 0) {
          __builtin_amdgcn_fence(__ATOMIC_ACQUIRE, "agent");
          asm volatile("s_waitcnt vmcnt(0)" ::: "memory");
        }
        __syncthreads();
        peer_gather(p, tt * 256);
      }
    }
#if COOP
    if (ph + 1 < p_arg.ph_end) {
      if (ph == 0) cg::this_grid().sync();
      else xcd_barrier((unsigned*)(p.ws + OFF_BAR), (volatile XLAS unsigned*)&xb_words);
    }
#endif
  }
}

extern "C" void kernel_launch(void* const* d_in, const int* in_sizes, int n_in, void* d_out, int out_size,
                              void* d_ws, size_t ws_size, hipStream_t stream) {
  static int grid_blocks = 0;
  if (!grid_blocks) {
    int dev = 0, cus = 0, per_cu = 0;
    hipGetDevice(&dev);
    hipDeviceGetAttribute(&cus, hipDeviceAttributeMultiprocessorCount, dev);
    hipOccupancyMaxActiveBlocksPerMultiprocessor(&per_cu, mega, 512, 0);
    if (per_cu < 1) per_cu = 1;
    if (per_cu > 1) per_cu = 1;
    grid_blocks = cus * per_cu;
  }
  Params p{};
  for (int i = 0; i < 25; ++i) p.in[i] = (const float*)d_in[i];
  p.out = (float*)d_out;
  p.ws = (char*)d_ws;
  hipMemsetAsync((char*)d_ws + OFF_BAR, 0, XCD_BAR_WORDS * sizeof(unsigned), stream);
#if COOP
  p.ph_begin = 0; p.ph_end = 9;
  void* args[] = {&p};
  hipError_t e = hipLaunchCooperativeKernel((void*)mega, dim3(grid_blocks), dim3(512), args, 0, stream);
  if (e != hipSuccess) fprintf(stderr, "cooperative launch failed: %s (grid %d)\n", hipGetErrorString(e), grid_blocks);
#else
  for (int ph = 0; ph < 9; ++ph) {
    p.ph_begin = ph; p.ph_end = ph + 1;
    hipLaunchKernelGGL(mega, dim3(grid_blocks), dim3(512), 0, stream, p);
  }
#endif
}
```

```cpp
#include <hip/hip_runtime.h>
#include <hip/hip_cooperative_groups.h>
#include <cstdio>
namespace cg = cooperative_groups;

typedef unsigned short u16;
typedef short bf16x8 __attribute__((ext_vector_type(8)));
typedef short s16x4 __attribute__((ext_vector_type(4)));
typedef float f32x16 __attribute__((ext_vector_type(16)));
typedef __bf16 bf2_t __attribute__((ext_vector_type(2)));
typedef unsigned u32x4 __attribute__((ext_vector_type(4)));
#define DI __device__ __forceinline__
#define LDSP(T, p) ((__attribute__((address_space(3))) T*)(p))
#define MFMA(a, b, c) __builtin_amdgcn_mfma_f32_32x32x16_bf16((a), (b), (c), 0, 0, 0)

#ifndef COOP
#define COOP 1
#endif

constexpr int S_ = 4096, T_ = 65536, NPROJ = 2304;
constexpr int LDH = 1088;
constexpr float EPS = 1e-6f;
constexpr float LOG2E = 1.4426950408889634f;
constexpr float NEG_INF = -__builtin_inff();
constexpr float U_SCALE = 64.f, V_SCALE = 5.656854f;
typedef float f32x2 __attribute__((ext_vector_type(2)));

constexpr size_t OFF_MOD = 0;
constexpr size_t OFF_LAM = 393216;
constexpr size_t OFF_BAR = 413696;
constexpr int XCD_BAR_WORDS = 3456;
constexpr size_t OFF_CNT = 397312;
constexpr size_t OFF_ROPE = 524288;
constexpr size_t OFF_WIN = 1572864;
constexpr size_t OFF_WQ = 6291456;
constexpr size_t OFF_WKV = 6881280;
constexpr size_t OFF_WOUT = 7405568;
constexpr size_t OFF_WPQ = 9502720;
constexpr size_t OFF_SK = 13697024;
constexpr size_t OFF_U = 16777216;
constexpr size_t OFF_V = 50331648;
constexpr size_t OFF_H = 83886080;
constexpr size_t OFF_PROJ = 226492416;
constexpr size_t OFF_QM = 528482304;
constexpr size_t OFF_KM = 629145600;
constexpr size_t OFF_VM = 729808896;
constexpr size_t OFF_QD = 796917760;
constexpr size_t OFF_KD = 864026624;
constexpr size_t OFF_H2 = OFF_QM;
constexpr size_t OFF_TOPK = OFF_VM;

struct Params {
  const float* in[25];
  float* out;
  char* ws;
  int ph_begin, ph_end;
};

DI unsigned pk2(float a, float b) {
  bf2_t r; r[0] = (__bf16)a; r[1] = (__bf16)b; return __builtin_bit_cast(unsigned, r);
}
DI float bflo(unsigned u) { return __uint_as_float(u << 16); }
DI float bfhi(unsigned u) { return __uint_as_float(u & 0xffff0000u); }
DI float dot2bf(unsigned a, unsigned b, float c) {
  return __builtin_amdgcn_fdot2_f32_bf16(__builtin_bit_cast(bf2_t, a), __builtin_bit_cast(bf2_t, b), c, false);
}
DI int lbid() { int t = blockIdx.x; asm volatile("" : "+s"(t)); return t; }
DI int lgdim() { int t = gridDim.x; asm volatile("" : "+s"(t)); return t; }
DI int ltid() { int t = threadIdx.x; asm volatile("" : "+v"(t)); return t; }
DI float xsum32(float v) {
  const unsigned u = __float_as_uint(v);
  auto r = __builtin_amdgcn_permlane32_swap(u, u, false, false);
  return __uint_as_float(r[0]) + __uint_as_float(r[1]);
}
DI float xmax32(float v) {
  const unsigned u = __float_as_uint(v);
  auto r = __builtin_amdgcn_permlane32_swap(u, u, false, false);
  return fmaxf(__uint_as_float(r[0]), __uint_as_float(r[1]));
}
DI float swapsum32(float a, float b) {
  auto r = __builtin_amdgcn_permlane32_swap(__float_as_uint(a), __float_as_uint(b), false, false);
  return __uint_as_float(r[0]) + __uint_as_float(r[1]);
}
DI float swapsum16(float a, float b) {
  auto r = __builtin_amdgcn_permlane16_swap(__float_as_uint(a), __float_as_uint(b), false, false);
  return __uint_as_float(r[0]) + __uint_as_float(r[1]);
}
template <int CTRL>
DI float dppmov(float v) {
  return __uint_as_float((unsigned)__builtin_amdgcn_update_dpp(0, (int)__float_as_uint(v), CTRL, 0xF, 0xF, true));
}
DI float wave_sum(float v) {
  v += dppmov<0x128>(v); v += dppmov<0x124>(v); v += dppmov<0x122>(v); v += dppmov<0x121>(v);
  v = swapsum16(v, v);
  return xsum32(v);
}
DI s16x4 trread(const char* p) { return __builtin_amdgcn_ds_read_tr16_b64_v4i16(LDSP(s16x4, p)); }
DI unsigned xcc_id() { return (unsigned)__builtin_amdgcn_s_getreg((3 << 11) | 20) & 0x7u; }
template <class F>
DI void xcd_tiles(char* ws, int set, int nft, F body) {
  __shared__ int sh_item;
  unsigned* cnt = (unsigned*)(ws + OFF_CNT);
  const int x0 = (int)xcc_id();
  const int per = 32 * nft;
  for (int q = 0; q < 8; ++q) {
    const int x = (x0 + q) & 7;
    for (;;) {
      __syncthreads();
      if (threadIdx.x == 0) sh_item = (int)atomicAdd(cnt + (set * 8 + x) * 32, 1u);
      __syncthreads();
      const int it = sh_item;
      if (it >= per) break;
      body(32 * x + it / nft, it % nft);
    }
  }
}

constexpr int G_ARS = 576;
constexpr int G_ASZ = 64 * G_ARS, G_BSZ = 256 * 144, G_STAGE = G_ASZ + G_BSZ;

template <int K, bool SUMSQ, class Epi>
DI void gemm_tile(const u16* __restrict__ W, int ldw, int n0, const u16* __restrict__ X, int ldx, size_t t0,
                  char* smem, Epi epi) {
  constexpr int KT = K / 64;
  const int tid = ltid(), lane = tid & 63, w = tid >> 6, h = lane >> 5, r = lane & 31;
  const int wf = w & 1, wt = w >> 1;
  const int blk = (lane >> 4) & 1, q4 = (lane & 15) >> 2, p4 = lane & 3;
  u32x4 ra[4], rb[4];
  const unsigned aoff = (unsigned)((tid >> 5) * ldw + (tid & 31) * 8), boff = (unsigned)((tid >> 3) * ldx + (tid & 7) * 8);
  const unsigned asoff = (unsigned)((tid >> 5) * G_ARS + (tid & 31) * 16), bsoff = (unsigned)(G_ASZ + (tid >> 3) * 144 + (tid & 7) * 16);
  auto gload = [&](int kt) __attribute__((always_inline)) {
    const u16* wk = W + (size_t)kt * 64 * ldw + n0;
    const u16* xk = X + t0 * (size_t)ldx + kt * 64;
#pragma unroll
    for (int i = 0; i < 4; ++i) ra[i] = *(const u32x4*)(wk + (size_t)i * 16 * ldw + aoff);
#pragma unroll
    for (int i = 0; i < 4; ++i) rb[i] = *(const u32x4*)(xk + (size_t)i * 64 * ldx + boff);
  };
  auto sstore = [&](char* buf) __attribute__((always_inline)) {
#pragma unroll
    for (int i = 0; i < 4; ++i) *(u32x4*)(buf + asoff + i * 16 * G_ARS) = ra[i];
#pragma unroll
    for (int i = 0; i < 4; ++i) *(u32x4*)(buf + bsoff + i * 64 * 144) = rb[i];
  };
  auto stage_step = [&](int s, char* nbuf, int ktl, bool dowrite, bool doload) __attribute__((always_inline)) {
    const u16* wk = W + (size_t)ktl * 64 * ldw + n0;
    const u16* xk = X + t0 * (size_t)ldx + ktl * 64;
    if (s < 2) {
#pragma unroll
      for (int i = 2 * s; i < 2 * s + 2; ++i) {
        if (dowrite) *(u32x4*)(nbuf + asoff + i * 16 * G_ARS) = ra[i];
        if (doload) ra[i] = *(const u32x4*)(wk + (size_t)i * 16 * ldw + aoff);
      }
    } else {
#pragma unroll
      for (int i = 2 * s - 4; i < 2 * s - 2; ++i) {
        if (dowrite) *(u32x4*)(nbuf + bsoff + i * 64 * 144) = rb[i];
        if (doload) rb[i] = *(const u32x4*)(xk + (size_t)i * 64 * ldx + boff);
      }
    }
  };
  f32x16 acc[2][4];
#pragma unroll
  for (int g = 0; g < 2; ++g)
#pragma unroll
    for (int c = 0; c < 4; ++c)
#pragma unroll
      for (int i = 0; i < 16; ++i) acc[g][c][i] = 0.f;
  float ss0 = 0.f, ss1 = 0.f;
  auto compute = [&](const char* buf, char* nbuf, int ktl, bool dowrite, bool doload) __attribute__((always_inline)) {
    u32x4 bfr[2][2];
    s16x4 alo[2][4], ahi[2][4];
    auto lfrag = [&](int s, int slot) __attribute__((always_inline)) {
      bfr[slot][0] = *(const u32x4*)(buf + G_ASZ + (64 * wt + r) * 144 + (16 * s + 8 * h) * 2);
      bfr[slot][1] = *(const u32x4*)(buf + G_ASZ + (64 * wt + 32 + r) * 144 + (16 * s + 8 * h) * 2);
#pragma unroll
      for (int c = 0; c < 4; ++c) {
        const char* ap = buf + (16 * s + 8 * h + q4) * G_ARS + (128 * wf + 32 * c + 16 * blk) * 2 + 8 * p4;
        alo[slot][c] = trread(ap); ahi[slot][c] = trread(ap + 4 * G_ARS);
      }
    };
    lfrag(0, 0);
#pragma unroll
    for (int s = 0; s < 4; ++s) {
      if (s < 3) lfrag(s + 1, (s + 1) & 1);
      __builtin_amdgcn_sched_barrier(0);
      const u32x4 b0r = bfr[s & 1][0], b1r = bfr[s & 1][1];
      if (SUMSQ) {
        ss0 = dot2bf(b0r.x, b0r.x, ss0); ss0 = dot2bf(b0r.y, b0r.y, ss0);
        ss0 = dot2bf(b0r.z, b0r.z, ss0); ss0 = dot2bf(b0r.w, b0r.w, ss0);
        ss1 = dot2bf(b1r.x, b1r.x, ss1); ss1 = dot2bf(b1r.y, b1r.y, ss1);
        ss1 = dot2bf(b1r.z, b1r.z, ss1); ss1 = dot2bf(b1r.w, b1r.w, ss1);
      }
      const bf16x8 b0 = __builtin_bit_cast(bf16x8, b0r), b1 = __builtin_bit_cast(bf16x8, b1r);
#pragma unroll
      for (int c = 0; c < 4; ++c) {
        const bf16x8 a = __builtin_shufflevector(alo[s & 1][c], ahi[s & 1][c], 0, 1, 2, 3, 4, 5, 6, 7);
        acc[0][c] = MFMA(a, b0, acc[0][c]);
        acc[1][c] = MFMA(a, b1, acc[1][c]);
      }
      __builtin_amdgcn_sched_barrier(0);
      stage_step(s, nbuf, ktl, dowrite, doload);
      __builtin_amdgcn_sched_barrier(0);
    }
  };
  gload(0);
  sstore(smem);
  if (KT > 1) gload(1);
  __syncthreads();
  for (int kt = 0; kt < KT; ++kt) {
    char* buf = smem + (kt & 1) * G_STAGE;
    compute(buf, smem + ((kt + 1) & 1) * G_STAGE, kt + 2, kt + 1 < KT, kt + 2 < KT);
    __syncthreads();
  }
  if (SUMSQ) { ss0 = xsum32(ss0); ss1 = xsum32(ss1); }
  epi(acc[0], ss0, (int)t0 + 64 * wt + r, h, wf, smem + w * 17408, 0);
  epi(acc[1], ss1, (int)t0 + 64 * wt + 32 + r, h, wf, smem + w * 17408, 1);
}

DI void phase0(const Params& p, char* smem) {
  const int tid = ltid(), G = lgdim(), g = lbid();
  const size_t gt = (size_t)g * 512 + tid, NT = (size_t)G * 512;
  float* mod = (float*)(p.ws + OFF_MOD);
  for (int item = g; item < 192; item += G) {
    float* sc = (float*)smem;
    float* red = sc + 16384;
    for (int i = tid; i < 16384; i += 512) { float v = p.in[1][i]; sc[i] = v / (1.f + expf(-v)); }
    __syncthreads();
    const int col = tid & 31, kg = tid >> 5, n = item * 32 + col;
    float acc[16];
#pragma unroll
    for (int b = 0; b < 16; ++b) acc[b] = 0.f;
    const float* aw = p.in[2] + (size_t)(kg * 64) * 6144 + n;
#pragma unroll 1
    for (int k0 = 0; k0 < 64; k0 += 16) {
      float wv[16];
#pragma unroll
      for (int j = 0; j < 16; ++j) wv[j] = aw[(size_t)(k0 + j) * 6144];
#pragma unroll
      for (int j = 0; j < 16; ++j)
#pragma unroll
        for (int b = 0; b < 16; ++b) acc[b] += sc[b * 1024 + kg * 64 + k0 + j] * wv[j];
    }
#pragma unroll
    for (int b = 0; b < 16; ++b) red[(kg * 16 + b) * 32 + col] = acc[b];
    __syncthreads();
    {
      const int b = tid >> 5, cc = tid & 31;
      float sum = 0.f;
#pragma unroll
      for (int k2 = 0; k2 < 16; ++k2) sum += red[(k2 * 16 + b) * 32 + cc];
      mod[b * 6144 + item * 32 + cc] = sum + p.in[3][item * 32 + cc];
    }
    __syncthreads();
  }
  if (g == 0) {
    unsigned* cnt = (unsigned*)(p.ws + OFF_CNT);
    for (int i = tid; i < 8 * 8 * 32; i += 512) cnt[i] = 0u;
    unsigned* bar = (unsigned*)(p.ws + OFF_BAR);
    for (int i = tid; i < XCD_BAR_WORDS; i += 512) bar[i] = 0u;
  }
  if (g == 0 && tid < 64) {
    float d1 = wave_sum(p.in[14][tid] * p.in[15][tid]);
    float d2 = wave_sum(p.in[16][tid] * p.in[17][tid]);
    if (tid == 0) *(float*)(p.ws + OFF_LAM) = expf(d1) - expf(d2) + 0.2f;
  }
  {
    float2* rope = (float2*)(p.ws + OFF_ROPE);
    for (size_t i = gt; i < 131072; i += NT) {
      int j = (int)(i & 31), sp = (int)(i >> 5);
      float inv = 1.0f / powf(10000.f, (float)j / 32.f);
      float ang = (float)sp * inv, sn, cs;
      sincosf(ang, &sn, &cs);
      rope[i] = make_float2(cs, sn);
    }
  }
  {
    u16* d = (u16*)(p.ws + OFF_WIN);
    for (size_t i = gt; i < (size_t)1024 * 2304; i += NT) {
      int k = (int)(i / 2304), n = (int)(i % 2304);
      float v = (n < 2240) ? p.in[5][(size_t)k * 2240 + n] : 0.f;
      d[i] = (u16)(pk2(v, 0.f) & 0xffff);
    }
  }
  {
    u16* d = (u16*)(p.ws + OFF_WQ);
    for (size_t i = gt; i < (size_t)384 * 768; i += NT) {
      int k = (int)(i / 768), n = (int)(i % 768);
      int src = (n < 512) ? (n >> 7) * 192 + (n & 127) : ((n - 512) >> 6) * 192 + 128 + ((n - 512) & 63);
      float v = p.in[7][(size_t)k * 768 + src] * p.in[6][k];
      d[i] = (u16)(pk2(v, 0.f) & 0xffff);
    }
  }
  {
    u16* d = (u16*)(p.ws + OFF_WKV);
    for (size_t i = gt; i < (size_t)256 * 1024; i += NT) {
      int k = (int)(i >> 10), n = (int)(i & 1023);
      int src = (n < 512) ? (n >> 7) * 256 + (n & 127) : ((n - 512) >> 7) * 256 + 128 + (n & 127);
      float v = p.in[9][(size_t)k * 1024 + src] * p.in[8][k];
      d[i] = (u16)(pk2(v, 0.f) & 0xffff);
    }
  }
  auto conv8 = [&](const float* src, u16* dst, size_t n8) __attribute__((always_inline)) {
    for (size_t i = gt; i < n8; i += NT) {
      float4 a = ((const float4*)src)[2 * i], b = ((const float4*)src)[2 * i + 1];
      uint4 o; o.x = pk2(a.x, a.y); o.y = pk2(a.z, a.w); o.z = pk2(b.x, b.y); o.w = pk2(b.z, b.w);
      ((uint4*)dst)[i] = o;
    }
  };
  conv8(p.in[19], (u16*)(p.ws + OFF_WOUT), (size_t)1024 * 1024 / 8);
  conv8(p.in[21], (u16*)(p.ws + OFF_WPQ), (size_t)1024 * 2048 / 8);
  conv8(p.in[22], (u16*)(p.ws + OFF_SK), (size_t)16 * 128 * 128 / 8);
}

DI void rownorm_phase(const Params& p, const float* src, const float* gain, int sh_off, int sc_off, u16* dst) {
  const int lane = ltid() & 63;
  const int gw = lbid() * 8 + (ltid() >> 6), NW = lgdim() * 8;
  const float* mod = (const float*)(p.ws + OFF_MOD);
  for (int t = gw; t < T_; t += NW) {
    const int b = t >> 12;
    const float* mb = mod + b * 6144;
#pragma unroll
    for (int c = 0; c < 2; ++c) {
    }
    float xv[16];
#pragma unroll
    for (int c = 0; c < 2; ++c) {
      const float4* sp = (const float4*)(src + (size_t)t * 1024 + c * 512 + lane * 8);
      float4 a = sp[0], bq = sp[1];
      xv[c * 8 + 0] = a.x; xv[c * 8 + 1] = a.y; xv[c * 8 + 2] = a.z; xv[c * 8 + 3] = a.w;
      xv[c * 8 + 4] = bq.x; xv[c * 8 + 5] = bq.y; xv[c * 8 + 6] = bq.z; xv[c * 8 + 7] = bq.w;
    }
    float ss = 0.f;
#pragma unroll
    for (int i = 0; i < 16; ++i) ss += xv[i] * xv[i];
    ss = wave_sum(ss);
    const float rinv = rsqrtf(ss * (1.f / 1024.f) + EPS);
#pragma unroll
    for (int c = 0; c < 2; ++c) {
      const int d0 = c * 512 + lane * 8;
      float o[8];
#pragma unroll
      for (int q = 0; q < 2; ++q) {
        float4 gg = *(const float4*)(gain + d0 + 4 * q);
        float4 sc = *(const float4*)(mb + sc_off + d0 + 4 * q);
        float4 sh = *(const float4*)(mb + sh_off + d0 + 4 * q);
        o[4 * q + 0] = xv[c * 8 + 4 * q + 0] * rinv * gg.x * (1.f + sc.x) + sh.x;
        o[4 * q + 1] = xv[c * 8 + 4 * q + 1] * rinv * gg.y * (1.f + sc.y) + sh.y;
        o[4 * q + 2] = xv[c * 8 + 4 * q + 2] * rinv * gg.z * (1.f + sc.z) + sh.z;
        o[4 * q + 3] = xv[c * 8 + 4 * q + 3] * rinv * gg.w * (1.f + sc.w) + sh.w;
      }
      uint4 ov; ov.x = pk2(o[0], o[1]); ov.y = pk2(o[2], o[3]); ov.z = pk2(o[4], o[5]); ov.w = pk2(o[6], o[7]);
      *(uint4*)(dst + (size_t)t * LDH + d0) = ov;
    }
  }
}

DI void store_tile_bf16_lds(f32x16 (&acc)[4], char* wsm, u16* dst0, size_t ld, int lane) {
  const int h = lane >> 5, r = lane & 31;
#pragma unroll
  for (int c = 0; c < 4; ++c)
#pragma unroll
    for (int gq = 0; gq < 4; ++gq) {
      uint2 v; v.x = pk2(acc[c][4 * gq], acc[c][4 * gq + 1]); v.y = pk2(acc[c][4 * gq + 2], acc[c][4 * gq + 3]);
      *(uint2*)(wsm + r * 272 + (32 * c + 8 * gq + 4 * h) * 2) = v;
    }
#pragma unroll
  for (int j = 0; j < 8; ++j) {
    const int idx = lane + 64 * j, row = idx >> 4, c16 = idx & 15;
    const u32x4 v = *(const u32x4*)(wsm + row * 272 + c16 * 16);
    *(u32x4*)(dst0 + (size_t)row * ld + c16 * 8) = v;
  }
}

template <class AddrFn>
DI void store_rows_bf16_lds(f32x16 (&acc)[4], char* wsm, int lane, AddrFn addr) {
  const int h = lane >> 5, r = lane & 31;
#pragma unroll
  for (int c = 0; c < 4; ++c)
#pragma unroll
    for (int gq = 0; gq < 4; ++gq) {
      uint2 v; v.x = pk2(acc[c][4 * gq], acc[c][4 * gq + 1]); v.y = pk2(acc[c][4 * gq + 2], acc[c][4 * gq + 3]);
      *(uint2*)(wsm + r * 272 + (32 * c + 8 * gq + 4 * h) * 2) = v;
    }
#pragma unroll
  for (int j = 0; j < 8; ++j) {
    const int idx = lane + 64 * j, row = idx >> 4, c16 = idx & 15;
    const u32x4 v = *(const u32x4*)(wsm + row * 272 + c16 * 16);
    *(u32x4*)addr(row, c16) = v;
  }
}

DI void phase_qkv(const Params& p, char* smem) {
  const int G = lgdim();
  const u16* proj = (const u16*)(p.ws + OFF_PROJ);
  const float2* rope = (const float2*)(p.ws + OFF_ROPE);
  u16* Qm = (u16*)(p.ws + OFF_QM); u16* Km = (u16*)(p.ws + OFF_KM); u16* Vm = (u16*)(p.ws + OFF_VM);
  u16* Qd = (u16*)(p.ws + OFF_QD); u16* Kd = (u16*)(p.ws + OFF_KD);
  const float QS = 0.07216878364870322f * LOG2E;
  xcd_tiles(p.ws, 1, 3, [&](int tt, int ft2) __attribute__((always_inline)) {
    const float* qg = p.in[10];
    gemm_tile<384, true>((const u16*)(p.ws + OFF_WQ), 768, ft2 * 256, proj, NPROJ, (size_t)tt * 256, smem,
      [&](f32x16 (&acc)[4], float ss, int t, int h, int wf, char* wbase, int tg) __attribute__((always_inline)) {
        const int ft = ft2 * 2 + wf;
        const float rinv = rsqrtf(ss * (1.f / 384.f) + EPS);
        const int lane = ltid() & 63, tg0 = t & ~31, b = tg0 >> 12, s0 = tg0 & 4095, s = t & 4095;
        char* wsm = wbase + tg * 8704;
        if (ft < 4) {
          float s2 = 0.f;
#pragma unroll
          for (int c = 0; c < 4; ++c)
#pragma unroll
            for (int k = 0; k < 16; ++k) { float v = acc[c][k] * rinv; s2 += v * v; }
          s2 = xsum32(s2);
          const float r2 = rsqrtf(s2 * (1.f / 128.f) + EPS) * rinv * QS;
#pragma unroll
          for (int c = 0; c < 4; ++c)
#pragma unroll
            for (int gq = 0; gq < 4; ++gq) {
              const int d = 32 * c + 8 * gq + 4 * h;
              float4 gg = *(const float4*)(qg + d);
              acc[c][4 * gq] *= r2 * gg.x; acc[c][4 * gq + 1] *= r2 * gg.y;
              acc[c][4 * gq + 2] *= r2 * gg.z; acc[c][4 * gq + 3] *= r2 * gg.w;
            }
          u16* base = Qm + ((size_t)(b * 4 + ft) * S_ + s0) * 192;
          store_rows_bf16_lds(acc, wsm, lane, [&](int row, int c16) __attribute__((always_inline)) { return base + (size_t)row * 192 + c16 * 8; });
        } else {
#pragma unroll
          for (int cp = 0; cp < 2; ++cp) {
            float s2 = 0.f;
#pragma unroll
            for (int k = 0; k < 16; ++k) {
              float v1 = acc[2 * cp][k] * rinv, v2 = acc[2 * cp + 1][k] * rinv;
              s2 += v1 * v1 + v2 * v2;
            }
            s2 = xsum32(s2);
            const float r2 = rsqrtf(s2 * (1.f / 64.f) + EPS) * rinv;
#pragma unroll
            for (int gq = 0; gq < 4; ++gq) {
              const int j = 8 * gq + 4 * h;
              float4 g1 = *(const float4*)(qg + 128 + j), g2 = *(const float4*)(qg + 160 + j);
              const float4* rp = (const float4*)(rope + s * 32 + j);
              float4 cs01 = rp[0], cs23 = rp[1];
              float x1, x2;
              x1 = acc[2 * cp][4 * gq + 0] * r2 * g1.x; x2 = acc[2 * cp + 1][4 * gq + 0] * r2 * g2.x;
              acc[2 * cp][4 * gq + 0] = (x1 * cs01.x - x2 * cs01.y) * QS; acc[2 * cp + 1][4 * gq + 0] = (x2 * cs01.x + x1 * cs01.y) * QS;
              x1 = acc[2 * cp][4 * gq + 1] * r2 * g1.y; x2 = acc[2 * cp + 1][4 * gq + 1] * r2 * g2.y;
              acc[2 * cp][4 * gq + 1] = (x1 * cs01.z - x2 * cs01.w) * QS; acc[2 * cp + 1][4 * gq + 1] = (x2 * cs01.z + x1 * cs01.w) * QS;
              x1 = acc[2 * cp][4 * gq + 2] * r2 * g1.z; x2 = acc[2 * cp + 1][4 * gq + 2] * r2 * g2.z;
              acc[2 * cp][4 * gq + 2] = (x1 * cs23.x - x2 * cs23.y) * QS; acc[2 * cp + 1][4 * gq + 2] = (x2 * cs23.x + x1 * cs23.y) * QS;
              x1 = acc[2 * cp][4 * gq + 3] * r2 * g1.w; x2 = acc[2 * cp + 1][4 * gq + 3] * r2 * g2.w;
              acc[2 * cp][4 * gq + 3] = (x1 * cs23.z - x2 * cs23.w) * QS; acc[2 * cp + 1][4 * gq + 3] = (x2 * cs23.z + x1 * cs23.w) * QS;
            }
          }
          u16* base = Qm + ((size_t)(b * 4 + (ft - 4) * 2) * S_ + s0) * 192 + 128;
          store_rows_bf16_lds(acc, wsm, lane, [&](int row, int c16) __attribute__((always_inline)) {
            return base + (size_t)(c16 >> 3) * S_ * 192 + (size_t)row * 192 + (c16 & 7) * 8; });
        }
      });
  });
  xcd_tiles(p.ws, 2, 4, [&](int tt, int ft2) __attribute__((always_inline)) {
    const float* kg = p.in[11];
    gemm_tile<256, true>((const u16*)(p.ws + OFF_WKV), 1024, ft2 * 256, proj + 384, NPROJ, (size_t)tt * 256, smem,
      [&](f32x16 (&acc)[4], float ss, int t, int h, int wf, char* wbase, int tg) __attribute__((always_inline)) {
        const int ft = ft2 * 2 + wf;
        const float rinv = rsqrtf(ss * (1.f / 256.f) + EPS);
        const int lane = ltid() & 63, tg0 = t & ~31, b = tg0 >> 12, s0 = tg0 & 4095;
        char* wsm = wbase + tg * 8704;
        if (ft < 4) {
          float s2 = 0.f;
#pragma unroll
          for (int c = 0; c < 4; ++c)
#pragma unroll
            for (int k = 0; k < 16; ++k) { float v = acc[c][k] * rinv; s2 += v * v; }
          s2 = xsum32(s2);
          const float r2 = rsqrtf(s2 * (1.f / 128.f) + EPS) * rinv;
#pragma unroll
          for (int c = 0; c < 4; ++c)
#pragma unroll
            for (int gq = 0; gq < 4; ++gq) {
              const int d = 32 * c + 8 * gq + 4 * h;
              float4 gg = *(const float4*)(kg + d);
              acc[c][4 * gq] *= r2 * gg.x; acc[c][4 * gq + 1] *= r2 * gg.y;
              acc[c][4 * gq + 2] *= r2 * gg.z; acc[c][4 * gq + 3] *= r2 * gg.w;
            }
          u16* base = Km + ((size_t)(b * 4 + ft) * S_ + s0) * 192;
          store_rows_bf16_lds(acc, wsm, lane, [&](int row, int c16) __attribute__((always_inline)) { return base + (size_t)row * 192 + c16 * 8; });
        } else {
#pragma unroll
          for (int c = 0; c < 4; ++c)
#pragma unroll
            for (int k = 0; k < 16; ++k) acc[c][k] *= rinv;
          u16* base = Vm + ((size_t)(b * 4 + (ft - 4)) * S_ + s0) * 128;
          store_rows_bf16_lds(acc, wsm, lane, [&](int row, int c16) __attribute__((always_inline)) { return base + (size_t)row * 128 + c16 * 8; });
        }
      });
  });
  {
    const size_t gt = (size_t)lbid() * 512 + ltid(), NT = (size_t)G * 512;
    for (size_t e = gt; e < (size_t)T_ * 17; e += NT) {
      const int t = (int)(e / 17), gi = (int)(e % 17);
      const int b = t >> 12, s = t & 4095;
      const u16* src; const float* gain; float scale; u16* dst; int ncopy = 1; size_t cstride = 0;
      if (gi == 0) {
        src = proj + (size_t)t * NPROJ + 640; gain = p.in[11] + 128; scale = 1.f;
        dst = Km + ((size_t)(b * 4) * S_ + s) * 192 + 128; ncopy = 4; cstride = (size_t)S_ * 192;
      } else if (gi < 9) {
        const int j = gi - 1;
        src = proj + (size_t)t * NPROJ + 704 + j * 64; gain = p.in[12]; scale = 0.125f * LOG2E;
        dst = Qd + ((size_t)(b * 8 + j) * S_ + s) * 64;
      } else {
        const int j = gi - 9;
        src = proj + (size_t)t * NPROJ + 1216 + j * 64; gain = p.in[13]; scale = 1.f;
        dst = Kd + ((size_t)(b * 8 + j) * S_ + s) * 64;
      }
      uint4 raw[8];
#pragma unroll
      for (int q = 0; q < 8; ++q) raw[q] = ((const uint4*)src)[q];
      float ss = 0.f;
#pragma unroll
      for (int q = 0; q < 8; ++q) {
        ss = dot2bf(raw[q].x, raw[q].x, ss); ss = dot2bf(raw[q].y, raw[q].y, ss);
        ss = dot2bf(raw[q].z, raw[q].z, ss); ss = dot2bf(raw[q].w, raw[q].w, ss);
      }
      const float rinv = rsqrtf(ss * (1.f / 64.f) + EPS);
      const float rs = rinv * scale;
#pragma unroll
      for (int q = 0; q < 4; ++q) {
        const unsigned lo[4] = {raw[q].x, raw[q].y, raw[q].z, raw[q].w};
        const unsigned hi[4] = {raw[q + 4].x, raw[q + 4].y, raw[q + 4].z, raw[q + 4].w};
        unsigned o1[4], o2[4];
#pragma unroll
        for (int e2 = 0; e2 < 4; ++e2) {
          const int k = 8 * q + 2 * e2;
          const float4 cs = *(const float4*)(rope + s * 32 + k);
          const float2 ga = *(const float2*)(gain + k), gb = *(const float2*)(gain + 32 + k);
          float x1a = bflo(lo[e2]) * rs * ga.x, x2a = bflo(hi[e2]) * rs * gb.x;
          float x1b = bfhi(lo[e2]) * rs * ga.y, x2b = bfhi(hi[e2]) * rs * gb.y;
          o1[e2] = pk2(x1a * cs.x - x2a * cs.y, x1b * cs.z - x2b * cs.w);
          o2[e2] = pk2(x2a * cs.x + x1a * cs.y, x2b * cs.z + x1b * cs.w);
        }
        uint4 v1 = make_uint4(o1[0], o1[1], o1[2], o1[3]), v2 = make_uint4(o2[0], o2[1], o2[2], o2[3]);
        for (int cpy = 0; cpy < ncopy; ++cpy) {
          ((uint4*)(dst + cpy * cstride))[q] = v1;
          ((uint4*)(dst + cpy * cstride))[q + 4] = v2;
        }
      }
    }
  }
}

template <int NS, int RSK, bool QLDS>
DI void qk_softmax32(const char* kbuf, const bf16x8 (&qf)[NS], const char* qlds, bool needmask, int keybase, int qrow, int h, int r,
                     float& mrun, float& lrun, f32x16 (&O)[4], bf16x8& pf0, bf16x8& pf1) {
  f32x16 sacc;
#pragma unroll
  for (int i = 0; i < 16; ++i) sacc[i] = 0.f;
#pragma unroll
  for (int s = 0; s < NS; ++s) {
    bf16x8 a = *(const bf16x8*)(kbuf + r * RSK + (16 * s + 8 * h) * 2);
    bf16x8 bq;
    if (QLDS) bq = *(const bf16x8*)(qlds + (16 * s + 8 * h) * 2); else bq = qf[s];
    sacc = MFMA(a, bq, sacc);
  }
  if (needmask) {
#pragma unroll
    for (int i = 0; i < 16; ++i) {
      const int key = keybase + 8 * (i >> 2) + 4 * h + (i & 3);
      if (key > qrow) sacc[i] = NEG_INF;
    }
  }
  float mx = sacc[0];
#pragma unroll
  for (int i = 1; i < 16; ++i) mx = fmaxf(mx, sacc[i]);
  mx = xmax32(mx);
  if (__builtin_amdgcn_ballot_w64(mx > mrun + 8.f) != 0ull) {
    const float mnew = fmaxf(mrun, mx);
    const float alpha = __builtin_amdgcn_exp2f(mrun - mnew);
    mrun = mnew;
    lrun *= alpha;
#pragma unroll
    for (int c = 0; c < 4; ++c)
#pragma unroll
      for (int i = 0; i < 16; ++i) O[c][i] *= alpha;
  }
  float rs = 0.f;
#pragma unroll
  for (int i = 0; i < 16; ++i) {
    float pv = __builtin_amdgcn_exp2f(sacc[i] - mrun);
    rs += pv; sacc[i] = pv;
  }
  lrun += rs;
  uint4 pa, pb;
  pa.x = pk2(sacc[0], sacc[1]); pa.y = pk2(sacc[2], sacc[3]); pa.z = pk2(sacc[4], sacc[5]); pa.w = pk2(sacc[6], sacc[7]);
  pb.x = pk2(sacc[8], sacc[9]); pb.y = pk2(sacc[10], sacc[11]); pb.z = pk2(sacc[12], sacc[13]); pb.w = pk2(sacc[14], sacc[15]);
  pf0 = __builtin_bit_cast(bf16x8, pa);
  pf1 = __builtin_bit_cast(bf16x8, pb);
}

template <int DQK, int NMAP>
DI void attn_item(const u16* __restrict__ qb0, const u16* __restrict__ qb1, const u16* __restrict__ kb0,
                  const u16* __restrict__ kb1, const u16* __restrict__ vb, int vstride, int qblk,
                  u16* __restrict__ outp, const float* __restrict__ lamp, const float* __restrict__ subg, char* smem) {
  constexpr int NS = DQK / 16;
  constexpr int RSK = DQK * 2 + 16;
  constexpr int KTILE = 64 * RSK;
  constexpr int VOFF = NMAP * KTILE;
  constexpr int STAGE = VOFF + 64 * 320;
  constexpr int CPR = DQK / 8;
  constexpr int KCH = NMAP * 64 * CPR / 512;
  int tid_ = ltid();
  asm volatile("" : "+v"(tid_));
  const int tid = tid_, lane = tid & 63, w = tid >> 6, h = lane >> 5, r = lane & 31;
  const int blk = (lane >> 4) & 1, q4 = (lane & 15) >> 2, p4 = lane & 3;
  const int q0 = qblk * 256, wrow0 = q0 + 32 * w, qrow = wrow0 + r;
  const int nt = 4 * (qblk + 1);

  constexpr bool QL = (NMAP == 2);
  bf16x8 qfa[NS];
  if (!QL) {
#pragma unroll
    for (int s = 0; s < NS; ++s) qfa[s] = *(const bf16x8*)(qb0 + (size_t)qrow * DQK + 16 * s + 8 * h);
  } else {
#pragma unroll
    for (int s = 0; s < NS; ++s) qfa[s] = bf16x8{0, 0, 0, 0, 0, 0, 0, 0};
#pragma unroll
    for (int i = 0; i < 8; ++i) {
      const int id = tid + 512 * i, mp = id >> 11, rem = id & 2047, row = rem >> 3, c16 = rem & 7;
      *(u32x4*)(smem + 2 * STAGE + mp * 36864 + row * 144 + c16 * 16) =
          *(const u32x4*)((mp ? qb1 : qb0) + (size_t)(q0 + row) * DQK + c16 * 8);
    }
  }
  const char* qla = smem + 2 * STAGE + (32 * w + r) * 144;
  const char* qlb = qla + 36864;
  f32x16 Oa[4], Ob[4];
  float ma = NEG_INF, la = 0.f, mb = NEG_INF, lb = 0.f;
#pragma unroll
  for (int c = 0; c < 4; ++c)
#pragma unroll
    for (int i = 0; i < 16; ++i) { Oa[c][i] = 0.f; if (NMAP == 2) Ob[c][i] = 0.f; }

  u32x4 rk[KCH], rv[2];
  unsigned koff[KCH], voff[2];
#pragma unroll
  for (int i = 0; i < KCH; ++i) {
    const int id = tid + 512 * i;
    if (NMAP == 1) koff[i] = (unsigned)((id / CPR) * DQK + (id % CPR) * 8);
    else koff[i] = (unsigned)((((id & 511) >> 3)) * DQK + (id & 7) * 8);
  }
#pragma unroll
  for (int i = 0; i < 2; ++i) {
    const int id = tid + 512 * i;
    voff[i] = (unsigned)((id >> 4) * vstride + (id & 15) * 8);
  }
  auto gload = [&](int t) __attribute__((always_inline)) {
    const u16* k0t = kb0 + (size_t)t * 64 * DQK;
    const u16* k1t = (NMAP == 2) ? kb1 + (size_t)t * 64 * DQK : k0t;
    const u16* vt = vb + (size_t)t * 64 * vstride;
#pragma unroll
    for (int i = 0; i < KCH; ++i) rk[i] = *(const u32x4*)(((NMAP == 2 && i) ? k1t : k0t) + koff[i]);
#pragma unroll
    for (int i = 0; i < 2; ++i) rv[i] = *(const u32x4*)(vt + voff[i]);
  };
  auto sstore = [&](char* buf) __attribute__((always_inline)) {
#pragma unroll
    for (int i = 0; i < KCH; ++i) {
      const int id = tid + 512 * i;
      if (NMAP == 1) {
        const int row = id / CPR, c16 = id % CPR;
        *(u32x4*)(buf + row * RSK + c16 * 16) = rk[i];
      } else {
        const int rem = id & 511, row = rem >> 3, c16 = rem & 7;
        *(u32x4*)(buf + i * KTILE + row * RSK + c16 * 16) = rk[i];
      }
    }
#pragma unroll
    for (int i = 0; i < 2; ++i) {
      const int id = tid + 512 * i, row = id >> 4, c16 = id & 15;
      *(u32x4*)(buf + VOFF + row * 320 + c16 * 16) = rv[i];
    }
  };

  gload(0);
  sstore(smem);
  gload(1);
  __syncthreads();
  for (int t = 0; t < nt; ++t) {
    char* buf = smem + (t & 1) * STAGE;
    if (t + 1 < nt) {
      sstore(smem + ((t + 1) & 1) * STAGE);
      if (t + 2 < nt) gload(t + 2);
    }
    const int key0 = t * 64;
#pragma unroll
    for (int sub = 0; sub < 2; ++sub) {
      const int ko = sub * 32;
      if (key0 + ko <= wrow0 + 31) {
        const bool needmask = (key0 + ko + 31 > wrow0);
        bf16x8 pa0, pa1, pb0, pb1;
        qk_softmax32<NS, RSK, QL>(buf + ko * RSK, qfa, qla, needmask, key0 + ko, qrow, h, r, ma, la, Oa, pa0, pa1);
        if (NMAP == 2)
          qk_softmax32<NS, RSK, QL>(buf + KTILE + ko * RSK, qfa, qlb, needmask, key0 + ko, qrow, h, r, mb, lb, Ob, pb0, pb1);
#pragma unroll
        for (int ks = 0; ks < 2; ++ks)
#pragma unroll
          for (int c = 0; c < 4; ++c) {
            const char* ap = buf + VOFF + (ko + 16 * ks + 4 * h + q4) * 320 + (32 * c + 16 * blk) * 2 + 8 * p4;
            s16x4 lo = trread(ap), hi = trread(ap + 8 * 320);
            bf16x8 a = __builtin_shufflevector(lo, hi, 0, 1, 2, 3, 4, 5, 6, 7);
            Oa[c] = MFMA(a, ks ? pa1 : pa0, Oa[c]);
            if (NMAP == 2) Ob[c] = MFMA(a, ks ? pb1 : pb0, Ob[c]);
          }
      }
    }
    __syncthreads();
  }
  const float inva = 1.f / xsum32(la);
  if (NMAP == 1) {
#pragma unroll
    for (int c = 0; c < 4; ++c)
#pragma unroll
      for (int i = 0; i < 16; ++i) Oa[c][i] *= inva;
  } else {
    const float li = *lamp / xsum32(lb);
    float s2 = 0.f;
#pragma unroll
    for (int c = 0; c < 4; ++c)
#pragma unroll
      for (int i = 0; i < 16; ++i) {
        float v = Oa[c][i] * inva - li * Ob[c][i];
        Oa[c][i] = v; s2 += v * v;
      }
    s2 = xsum32(s2);
    const float rn = rsqrtf(s2 * (1.f / 128.f) + EPS) * 0.8f;
#pragma unroll
    for (int c = 0; c < 4; ++c)
#pragma unroll
      for (int gq = 0; gq < 4; ++gq) {
        const int d = 32 * c + 8 * gq + 4 * h;
        asm volatile("" ::: "memory");
        float4 gg = *(const float4*)(subg + d);
        Oa[c][4 * gq] *= rn * gg.x; Oa[c][4 * gq + 1] *= rn * gg.y; Oa[c][4 * gq + 2] *= rn * gg.z; Oa[c][4 * gq + 3] *= rn * gg.w;
      }
  }
  {
    u16* base = outp + (size_t)wrow0 * LDH;
    store_rows_bf16_lds(Oa, smem + w * 8704, lane, [&](int row, int c16) __attribute__((always_inline)) { return base + (size_t)row * LDH + c16 * 8; });
  }
  __syncthreads();
}

DI void conv_table_slice(const float* __restrict__ src, uint2* __restrict__ dst, float scale, int slice, int nslices) {
  const size_t groups = (size_t)16384 * 1024 / 16;
  const size_t gt = (size_t)lbid() * 512 + ltid(), NT = (size_t)lgdim() * 512;
  const size_t lo = groups * slice / nslices, hi = groups * (slice + 1) / nslices;
  for (size_t i = lo + gt; i < hi; i += NT) {
    const float4* sp = (const float4*)src + 4 * i;
    float4 a0 = sp[0], a1 = sp[1], a2 = sp[2], a3 = sp[3];
    unsigned w0 = 0, w1 = 0;
    w0 = __builtin_amdgcn_cvt_scalef32_pk_fp4_f32(w0, a0.x * scale, a0.y * scale, 1.0f, 0);
    w0 = __builtin_amdgcn_cvt_scalef32_pk_fp4_f32(w0, a0.z * scale, a0.w * scale, 1.0f, 1);
    w0 = __builtin_amdgcn_cvt_scalef32_pk_fp4_f32(w0, a1.x * scale, a1.y * scale, 1.0f, 2);
    w0 = __builtin_amdgcn_cvt_scalef32_pk_fp4_f32(w0, a1.z * scale, a1.w * scale, 1.0f, 3);
    w1 = __builtin_amdgcn_cvt_scalef32_pk_fp4_f32(w1, a2.x * scale, a2.y * scale, 1.0f, 0);
    w1 = __builtin_amdgcn_cvt_scalef32_pk_fp4_f32(w1, a2.z * scale, a2.w * scale, 1.0f, 1);
    w1 = __builtin_amdgcn_cvt_scalef32_pk_fp4_f32(w1, a3.x * scale, a3.y * scale, 1.0f, 2);
    w1 = __builtin_amdgcn_cvt_scalef32_pk_fp4_f32(w1, a3.z * scale, a3.w * scale, 1.0f, 3);
    dst[i] = make_uint2(w0, w1);
  }
}

DI void phase_attn(const Params& p, char* smem) {
  const int G = lgdim(), g = lbid();
  const u16* Qm = (const u16*)(p.ws + OFF_QM); const u16* Km = (const u16*)(p.ws + OFF_KM);
  const u16* Vm = (const u16*)(p.ws + OFF_VM); const u16* Qd = (const u16*)(p.ws + OFF_QD);
  const u16* Kd = (const u16*)(p.ws + OFF_KD); const u16* proj = (const u16*)(p.ws + OFF_PROJ);
  u16* mixed = (u16*)(p.ws + OFF_H);
  const float* lamp = (const float*)(p.ws + OFF_LAM);
  const int nrounds = (2048 + G - 1) / G;
  for (int k = 0; k * G < 2048; ++k) {
    conv_table_slice(p.in[23], (uint2*)(p.ws + OFF_U), U_SCALE, k, nrounds);
    conv_table_slice(p.in[24], (uint2*)(p.ws + OFF_V), V_SCALE, k, nrounds);
    const int idx = (k & 1) ? k * G + (G - 1 - g) : k * G + g;
    if (idx >= 2048) continue;
    const int level = idx >> 7, qblk = 15 - level, j = idx & 127, type = j & 1, bh = j >> 1;
    const int b = bh >> 2, hd = bh & 3;
    if (type == 0) {
      const size_t ho = (size_t)(b * 4 + hd) * S_;
      attn_item<192, 1>(Qm + ho * 192, nullptr, Km + ho * 192, nullptr, Vm + ho * 128, 128, qblk,
                        mixed + (size_t)b * S_ * LDH + hd * 128, lamp, nullptr, smem);
    } else {
      const size_t h0 = (size_t)(b * 8 + 2 * hd) * S_ * 64, h1 = h0 + (size_t)S_ * 64;
      attn_item<64, 2>(Qd + h0, Qd + h1, Kd + h0, Kd + h1, proj + (size_t)b * S_ * NPROJ + 1728 + hd * 128, NPROJ,
                       qblk, mixed + (size_t)b * S_ * LDH + 512 + hd * 128, lamp, p.in[18], smem);
    }
  }
}

template <int ST>
DI void ins1(float (&T)[16], float s) {
#pragma unroll
  for (int j = 15; j > ST; --j) T[j] = __builtin_amdgcn_fmed3f(T[j - 1], s, T[j]);
  T[ST] = fmaxf(T[ST], s);
}
DI void peer_scores_top16(const char* sk, const u16* __restrict__ pqrow, int lane, float (&T)[16]) {
  const int h = lane >> 5, r = lane & 31;
  bf16x8 bq[8];
#pragma unroll
  for (int s = 0; s < 8; ++s) bq[s] = *(const bf16x8*)(pqrow + 16 * s + 8 * h);
#pragma unroll
  for (int j = 0; j < 16; ++j) T[j] = NEG_INF;
#pragma unroll
  for (int c = 0; c < 4; ++c) {
    f32x16 acc;
#pragma unroll
    for (int i = 0; i < 16; ++i) acc[i] = 0.f;
#pragma unroll
    for (int s = 0; s < 8; ++s) {
      bf16x8 a = *(const bf16x8*)(sk + (32 * c + r) * 272 + (16 * s + 8 * h) * 2);
      acc = MFMA(a, bq[s], acc);
    }
#pragma unroll
    for (int i = 0; i < 16; ++i) {
      const unsigned code = (unsigned)(127 - 32 * c - (i & 3) - 8 * (i >> 2)) - 4u * (unsigned)h;
      ins1<0>(T, __uint_as_float((__float_as_uint(acc[i]) & 0xffffff80u) | code));
    }
  }
  float o[16];
#pragma unroll
  for (int j = 0; j < 16; ++j) {
    auto rr = __builtin_amdgcn_permlane32_swap(__float_as_uint(T[j]), __float_as_uint(T[j]), false, false);
    o[j] = __uint_as_float(h ? rr[0] : rr[1]);
  }
  ins1<0>(T, o[0]); ins1<1>(T, o[1]); ins1<2>(T, o[2]); ins1<3>(T, o[3]);
  ins1<4>(T, o[4]); ins1<5>(T, o[5]); ins1<6>(T, o[6]); ins1<7>(T, o[7]);
  ins1<8>(T, o[8]); ins1<9>(T, o[9]); ins1<10>(T, o[10]); ins1<11>(T, o[11]);
  ins1<12>(T, o[12]); ins1<13>(T, o[13]); ins1<14>(T, o[14]); ins1<15>(T, o[15]);
}

DI float gelu_exact(float x) { return 0.5f * x * (1.f + erff(x * 0.7071067811865476f)); }

DI void load_sk(char* smem, const u16* SK, int hp, int tid) {
#pragma unroll
  for (int i = 0; i < 4; ++i) {
    const int id = tid + 512 * i, row = id >> 4, c16 = id & 15;
    *(u32x4*)(smem + row * 272 + c16 * 16) = *(const u32x4*)(SK + (size_t)hp * 16384 + row * 128 + c16 * 8);
  }
}

DI void peer_route(const Params& p, char* smem, int t0) {
  const int tid = ltid(), lane = tid & 63, w = tid >> 6, h = lane >> 5, r = lane & 31;
  const u16* pq = (const u16*)(p.ws + OFF_PROJ);
  const u16* SK = (const u16*)(p.ws + OFF_SK);
  uint2* topk = (uint2*)(p.ws + OFF_TOPK);
    const int tq = t0 + 32 * w + r;
#pragma unroll 1
    for (int hd = 0; hd < 8; ++hd) {
      float TA[16], TB[16];
      __syncthreads();
      load_sk(smem, SK, hd * 2, tid);
      __syncthreads();
      peer_scores_top16(smem, pq + (size_t)tq * 2048 + (hd * 2) * 128, lane, TA);
      __syncthreads();
      load_sk(smem, SK, hd * 2 + 1, tid);
      __syncthreads();
      peer_scores_top16(smem, pq + (size_t)tq * 2048 + (hd * 2 + 1) * 128, lane, TB);
      float FK[16];
#pragma unroll
      for (int j = 0; j < 16; ++j) FK[j] = NEG_INF;
#pragma unroll
      for (int i = 0; i < 16; ++i)
#pragma unroll
        for (int j = 0; j < 16; ++j)
          if ((i + 1) * (j + 1) <= 16) {
            const float cv = __uint_as_float(__float_as_uint(TA[i]) & 0xffffff80u) + __uint_as_float(__float_as_uint(TB[j]) & 0xffffff80u);
            const float key = __uint_as_float((__float_as_uint(cv) & 0xffffff00u) | (unsigned)(255 - (16 * i + j)));
            const int st = (i + 1) * (j + 1) - 1;
#pragma unroll
            for (int q = 15; q >= 1; --q)
              if (q > st) FK[q] = __builtin_amdgcn_fmed3f(FK[q - 1], key, FK[q]);
            FK[st] = fmaxf(FK[st], key);
          }
      float FV[16]; int FI[16];
#pragma unroll
      for (int m = 0; m < 16; ++m) {
        const unsigned kb = __float_as_uint(FK[m]);
        const int code = 255 - (int)(kb & 255u), ci = code >> 4, cj = code & 15;
        FV[m] = __uint_as_float(kb & 0xffffff00u);
        float ra = TA[0], rb = TB[0];
#pragma unroll
        for (int q = 1; q < 16; ++q) { ra = (ci == q) ? TA[q] : ra; rb = (cj == q) ? TB[q] : rb; }
        FI[m] = (127 - (int)(__float_as_uint(ra) & 127u)) * 128 + (127 - (int)(__float_as_uint(rb) & 127u));
      }
      float e[16], sum = 0.f;
#pragma unroll
      for (int j = 0; j < 16; ++j) { e[j] = expf(FV[j] - FV[0]); sum += e[j]; }
      const float rs = 1.f / sum;
      if (h == 0) {
        u32x4* dst = (u32x4*)(topk + (size_t)tq * 128 + hd * 16);
#pragma unroll
        for (int q = 0; q < 8; ++q) {
          u32x4 o;
          o.x = (unsigned)FI[2 * q]; o.y = __float_as_uint(e[2 * q] * rs);
          o.z = (unsigned)FI[2 * q + 1]; o.w = __float_as_uint(e[2 * q + 1] * rs);
          dst[q] = o;
        }
      }
    }
}

DI void peer_gather(const Params& p, int t0) {
  const int tid = ltid(), lane = tid & 63, w = tid >> 6;
  const uint2* topk = (const uint2*)(p.ws + OFF_TOPK);
  const float* mod = (const float*)(p.ws + OFF_MOD);
  const unsigned char* U8 = (const unsigned char*)(p.ws + OFF_U);
  const unsigned char* V8 = (const unsigned char*)(p.ws + OFF_V);
#pragma unroll 1
  for (int ti = 0; ti < 32; ++ti) {
    const int t = t0 + 32 * w + ti, b = t >> 12;
    const float* mb = mod + b * 6144;
    float* orow = p.out + (size_t)t * 1024 + lane * 16;
    f32x2 xr[8];
#pragma unroll
    for (int q = 0; q < 4; ++q) {
      float4 a = ((const float4*)orow)[q];
      xr[2 * q] = f32x2{a.x, a.y}; xr[2 * q + 1] = f32x2{a.z, a.w};
    }
    float ss = 0.f;
#pragma unroll
    for (int i = 0; i < 8; ++i) ss += xr[i].x * xr[i].x + xr[i].y * xr[i].y;
    ss = wave_sum(ss);
    const float rinv = rsqrtf(ss * (1.f / 1024.f) + EPS);
    f32x2 hf[8];
#pragma unroll
    for (int q = 0; q < 4; ++q) {
      const int d0 = lane * 16 + 4 * q;
      float4 gg = *(const float4*)(p.in[20] + d0);
      float4 sc = *(const float4*)(mb + 4096 + d0);
      float4 sh = *(const float4*)(mb + 3072 + d0);
      hf[2 * q] = f32x2{xr[2 * q].x * rinv * gg.x * (1.f + sc.x) + sh.x, xr[2 * q].y * rinv * gg.y * (1.f + sc.y) + sh.y};
      hf[2 * q + 1] = f32x2{xr[2 * q + 1].x * rinv * gg.z * (1.f + sc.z) + sh.z, xr[2 * q + 1].y * rinv * gg.w * (1.f + sc.w) + sh.w};
    }
    const u32x4 tk = *(const u32x4*)(topk + (size_t)t * 128 + lane * 2);
    f32x2 y[8];
#pragma unroll
    for (int i = 0; i < 8; ++i) y[i] = f32x2{0.f, 0.f};
    uint2 ua[16], va[16], ub[16], vb[16];
    float gA, gB;
    auto issue = [&](int jj, uint2 (&uu)[16], uint2 (&vv)[16], float& gsel) __attribute__((always_inline)) {
      float gs = 0.f;
#pragma unroll
      for (int k = 0; k < 16; ++k) {
        const int l = 8 * jj + (k >> 1);
        const int e = __builtin_amdgcn_readlane((int)((k & 1) ? tk.z : tk.x), l);
        const float g = __uint_as_float(__builtin_amdgcn_readlane((int)((k & 1) ? tk.w : tk.y), l));
        gs = ((lane >> 2) == k) ? g : gs;
        uu[k] = *(const uint2*)(U8 + (size_t)e * 512 + lane * 8);
        vv[k] = *(const uint2*)(V8 + (size_t)e * 512 + lane * 8);
      }
      gsel = gs;
    };
    auto process = [&](const uint2 (&uu)[16], const uint2 (&vv)[16], float gsel) __attribute__((always_inline)) {
      float d[16];
#pragma unroll
      for (int k = 0; k < 16; ++k) {
        f32x2 a2 = f32x2{0.f, 0.f};
        a2 = __builtin_amdgcn_cvt_scalef32_pk_f32_fp4(uu[k].x, 1.0f, 0) * hf[0] + a2;
        a2 = __builtin_amdgcn_cvt_scalef32_pk_f32_fp4(uu[k].x, 1.0f, 1) * hf[1] + a2;
        a2 = __builtin_amdgcn_cvt_scalef32_pk_f32_fp4(uu[k].x, 1.0f, 2) * hf[2] + a2;
        a2 = __builtin_amdgcn_cvt_scalef32_pk_f32_fp4(uu[k].x, 1.0f, 3) * hf[3] + a2;
        a2 = __builtin_amdgcn_cvt_scalef32_pk_f32_fp4(uu[k].y, 1.0f, 0) * hf[4] + a2;
        a2 = __builtin_amdgcn_cvt_scalef32_pk_f32_fp4(uu[k].y, 1.0f, 1) * hf[5] + a2;
        a2 = __builtin_amdgcn_cvt_scalef32_pk_f32_fp4(uu[k].y, 1.0f, 2) * hf[6] + a2;
        a2 = __builtin_amdgcn_cvt_scalef32_pk_f32_fp4(uu[k].y, 1.0f, 3) * hf[7] + a2;
        d[k] = a2.x + a2.y;
      }
      const bool h32 = (lane & 32) != 0, h16 = (lane & 16) != 0, h8 = (lane & 8) != 0, h4 = (lane & 4) != 0;
      float r8[8], r4[4], r2[2];
#pragma unroll
      for (int i = 0; i < 8; ++i) r8[i] = swapsum32(d[i], d[8 + i]);
#pragma unroll
      for (int i = 0; i < 4; ++i) r4[i] = swapsum16(r8[i], r8[4 + i]);
#pragma unroll
      for (int i = 0; i < 2; ++i) r2[i] = (h8 ? r4[2 + i] : r4[i]) + dppmov<0x128>(h8 ? r4[i] : r4[2 + i]);
      float kk = (h4 ? r2[1] : r2[0]) + dppmov<0x141>(h4 ? r2[0] : r2[1]);
      kk += dppmov<0x4E>(kk); kk += dppmov<0xB1>(kk);
      const float coefv = gsel * gelu_exact(kk * (1.f / U_SCALE)) * (1.f / V_SCALE);
#pragma unroll
      for (int k = 0; k < 16; ++k) {
        const float cf = __uint_as_float(__builtin_amdgcn_readlane((int)__float_as_uint(coefv), 4 * k));
        const f32x2 cf2 = f32x2{cf, cf};
        y[0] = __builtin_amdgcn_cvt_scalef32_pk_f32_fp4(vv[k].x, 1.0f, 0) * cf2 + y[0];
        y[1] = __builtin_amdgcn_cvt_scalef32_pk_f32_fp4(vv[k].x, 1.0f, 1) * cf2 + y[1];
        y[2] = __builtin_amdgcn_cvt_scalef32_pk_f32_fp4(vv[k].x, 1.0f, 2) * cf2 + y[2];
        y[3] = __builtin_amdgcn_cvt_scalef32_pk_f32_fp4(vv[k].x, 1.0f, 3) * cf2 + y[3];
        y[4] = __builtin_amdgcn_cvt_scalef32_pk_f32_fp4(vv[k].y, 1.0f, 0) * cf2 + y[4];
        y[5] = __builtin_amdgcn_cvt_scalef32_pk_f32_fp4(vv[k].y, 1.0f, 1) * cf2 + y[5];
        y[6] = __builtin_amdgcn_cvt_scalef32_pk_f32_fp4(vv[k].y, 1.0f, 2) * cf2 + y[6];
        y[7] = __builtin_amdgcn_cvt_scalef32_pk_f32_fp4(vv[k].y, 1.0f, 3) * cf2 + y[7];
      }
    };
    issue(0, ua, va, gA);
#pragma unroll 1
    for (int jj = 0; jj < 8; jj += 2) {
      issue(jj + 1, ub, vb, gB);
      __builtin_amdgcn_sched_barrier(0);
      process(ua, va, gA);
      __builtin_amdgcn_sched_barrier(0);
      issue((jj + 2) & 7, ua, va, gA);
      __builtin_amdgcn_sched_barrier(0);
      process(ub, vb, gB);
      __builtin_amdgcn_sched_barrier(0);
    }
#pragma unroll
    for (int q = 0; q < 4; ++q) {
      float4 g2 = *(const float4*)(mb + 5120 + lane * 16 + 4 * q);
      float4 o;
      o.x = xr[2 * q].x + g2.x * y[2 * q].x; o.y = xr[2 * q].y + g2.y * y[2 * q].y;
      o.z = xr[2 * q + 1].x + g2.z * y[2 * q + 1].x; o.w = xr[2 * q + 1].y + g2.w * y[2 * q + 1].y;
      ((float4*)orow)[q] = o;
    }
  }
}

#define XB_TMO      128
#define XB_XCNT(j)  (256  + 64 * (j))
#define XB_XSUB(j)  (1280 + 64 * (j))
#define XB_XGEN(j)  (2304 + 64 * (j))
#define XB_TOP      3328
#define XB_TOPGEN   3392
#define XB_SPIN_CAP (1u << 18)
#define XLAS __attribute__((address_space(3)))
DI unsigned xb_ld(unsigned* p) { return __hip_atomic_load(p, __ATOMIC_RELAXED, __HIP_MEMORY_SCOPE_AGENT); }
DI unsigned xb_add(unsigned* p, unsigned v) { return __hip_atomic_fetch_add(p, v, __ATOMIC_RELAXED, __HIP_MEMORY_SCOPE_AGENT); }
DI unsigned xb_xcc_id() { return (unsigned)__builtin_amdgcn_s_getreg((3 << 11) | 20) & 0xFu; }
#define XB_SPIN(cond, bar) do { unsigned _sp = 0; while (cond) { __builtin_amdgcn_s_sleep(1); \
    if ((++_sp & 255u) == 0u) { if (xb_ld(&(bar)[XB_TMO])) break; if (_sp > XB_SPIN_CAP) { atomicAdd(&(bar)[XB_TMO], 1u); break; } } } } while (0)
DI void xcd_barrier_complete(unsigned* bar, unsigned x, unsigned& nloc, unsigned& nx) {
  const unsigned G = gridDim.x;
  unsigned sum, cnt, mine, sp = 0u;
  for (;;) {
    sum = 0u; cnt = 0u; mine = 0u;
#pragma unroll
    for (unsigned j = 0; j < 16; ++j) { const unsigned c = xb_ld(&bar[XB_XCNT(j)]); sum += c; cnt += (c > 0u) ? 1u : 0u; mine = (j == x) ? c : mine; }
    if (sum == G) break;
    __builtin_amdgcn_s_sleep(1);
    if ((++sp & 255u) == 0u) { if (xb_ld(&bar[XB_TMO])) break; if (sp > XB_SPIN_CAP) { atomicAdd(&bar[XB_TMO], 1u); break; } }
  }
  nloc = mine > 0u ? mine : 1u; nx = cnt > 0u ? cnt : 1u;
}
DI void xcd_barrier(unsigned* bar, volatile XLAS unsigned* st) {
  asm volatile("s_waitcnt vmcnt(0)" ::: "memory");
  __syncthreads();
  if (threadIdx.x == 0) {
    const unsigned x = xb_xcc_id();
    __builtin_amdgcn_s_waitcnt(0);
    unsigned nloc = st[0], nx = st[1];
    if (nloc == 0u) { xcd_barrier_complete(bar, x, nloc, nx); st[0] = nloc; st[1] = nx; }
    const unsigned old = xb_add(&bar[XB_XSUB(x)], 1u);
    const unsigned gen = old / nloc;
    if (old + 1u == (gen + 1u) * nloc) {
      __builtin_amdgcn_fence(__ATOMIC_RELEASE, "agent");
      asm volatile("s_waitcnt vmcnt(0)" ::: "memory");
      const unsigned og = xb_add(&bar[XB_TOP], 1u);
      const unsigned tg = og / nx;
      if (og + 1u == (tg + 1u) * nx) xb_add(&bar[XB_TOPGEN], 1u);
      else XB_SPIN(xb_ld(&bar[XB_TOPGEN]) == tg, bar);
      __builtin_amdgcn_fence(__ATOMIC_ACQUIRE, "agent");
      xb_add(&bar[XB_XGEN(x)], 1u);
      asm volatile("s_waitcnt vmcnt(0)" ::: "memory");
    } else {
      XB_SPIN(xb_ld(&bar[XB_XGEN(x)]) == gen, bar);
      __builtin_amdgcn_fence(__ATOMIC_ACQUIRE, "agent");
      asm volatile("s_waitcnt vmcnt(0)" ::: "memory");
    }
  }
  __syncthreads();
}

typedef const __attribute__((address_space(4))) Params* KParamsPtr;
__global__ void __launch_bounds__(512) mega(Params p_arg) {
  __shared__ __attribute__((aligned(16))) char smem[151552];
  __shared__ uint4 xb_words;
  if (threadIdx.x == 0) xb_words = make_uint4(0u, 0u, 0u, 0u);
  __syncthreads();
  for (int ph = p_arg.ph_begin; ph < p_arg.ph_end; ++ph) {
    KParamsPtr kp = (KParamsPtr)__builtin_amdgcn_kernarg_segment_ptr();
    asm volatile("" : "+s"(kp));
    Params p;
#pragma unroll
    for (int i = 0; i < 25; ++i) p.in[i] = kp->in[i];
    p.out = kp->out; p.ws = kp->ws; p.ph_begin = 0; p.ph_end = 0;
    const int G = lgdim();
    if (ph == 0) {
      phase0(p, smem);
    } else if (ph == 1) {
      if (threadIdx.x == 0) (void)xb_add(&((unsigned*)(p.ws + OFF_BAR))[XB_XCNT(xb_xcc_id())], 1u);
      rownorm_phase(p, p.in[0], p.in[4], 0, 1024, (u16*)(p.ws + OFF_H));
    } else if (ph == 2) {
      u16* proj = (u16*)(p.ws + OFF_PROJ);
      xcd_tiles(p.ws, 0, 9, [&](int tt, int ft2) __attribute__((always_inline)) {
        gemm_tile<1024, false>((const u16*)(p.ws + OFF_WIN), NPROJ, ft2 * 256, (const u16*)(p.ws + OFF_H), LDH,
                               (size_t)tt * 256, smem, [&](f32x16 (&acc)[4], float, int t, int h, int wf, char* wbase, int tg) __attribute__((always_inline)) {
                                 store_tile_bf16_lds(acc, wbase + tg * 8704, proj + (size_t)(t & ~31) * NPROJ + ft2 * 256 + wf * 128, NPROJ, ltid() & 63);
                               });
      });
    } else if (ph == 3) {
      phase_qkv(p, smem);
    } else if (ph == 4) {
      phase_attn(p, smem);
    } else if (ph == 5) {
      const float* mod = (const float*)(p.ws + OFF_MOD);
      xcd_tiles(p.ws, 3, 4, [&](int tt, int ft2) __attribute__((always_inline)) {
        gemm_tile<1024, false>((const u16*)(p.ws + OFF_WOUT), 1024, ft2 * 256, (const u16*)(p.ws + OFF_H), LDH,
                               (size_t)tt * 256, smem, [&](f32x16 (&acc)[4], float, int t, int h, int wf, char* wbase, int tg) __attribute__((always_inline)) {
                                 const int ft = ft2 * 2 + wf, lane = ltid() & 63, r = lane & 31;
#pragma unroll
                                 for (int c = 0; c < 4; ++c)
#pragma unroll
                                   for (int gq = 0; gq < 4; ++gq)
                                     *(float4*)(wbase + r * 528 + (32 * c + 8 * gq + 4 * h) * 4) =
                                         make_float4(acc[c][4 * gq], acc[c][4 * gq + 1], acc[c][4 * gq + 2], acc[c][4 * gq + 3]);
                                 const int tg0 = t & ~31, b = tg0 >> 12;
#pragma unroll
                                 for (int j = 0; j < 16; ++j) {
                                   const int idx = lane + 64 * j, row = idx >> 5, c16 = idx & 31;
                                   const float4 a = *(const float4*)(wbase + row * 528 + c16 * 16);
                                   const int n = ft * 128 + c16 * 4;
                                   const size_t off = (size_t)(tg0 + row) * 1024 + n;
                                   const float4 xv = *(const float4*)(p.in[0] + off);
                                   const float4 g1 = *(const float4*)(mod + b * 6144 + 2048 + n);
                                   float4 o;
                                   o.x = xv.x + g1.x * a.x; o.y = xv.y + g1.y * a.y; o.z = xv.z + g1.z * a.z; o.w = xv.w + g1.w * a.w;
                                   *(float4*)(p.out + off) = o;
                                 }
                               });
      });
    } else if (ph == 6) {
      rownorm_phase(p, p.out, p.in[20], 3072, 4096, (u16*)(p.ws + OFF_H2));
    } else if (ph == 7) {
      u16* pq = (u16*)(p.ws + OFF_PROJ);
      xcd_tiles(p.ws, 4, 8, [&](int tt, int ft2) __attribute__((always_inline)) {
        gemm_tile<1024, false>((const u16*)(p.ws + OFF_WPQ), 2048, ft2 * 256, (const u16*)(p.ws + OFF_H2), LDH,
                               (size_t)tt * 256, smem, [&](f32x16 (&acc)[4], float, int t, int h, int wf, char* wbase, int tg) __attribute__((always_inline)) {
                                 store_tile_bf16_lds(acc, wbase + tg * 8704, pq + (size_t)(t & ~31) * 2048 + ft2 * 256 + wf * 128, 2048, ltid() & 63);
                               });
      });
    } else {
      for (int tt = lbid(); tt < 256; tt += G) {
        peer_route(p, smem, tt * 256);
        asm volatile("s_waitcnt vmcnt(0)" ::: "memory");
        __syncthreads();
        if (threadIdx.x == 0) {
          __builtin_amdgcn_fence(__ATOMIC_ACQUIRE, "agent");
          asm volatile("s_waitcnt vmcnt(0)" ::: "memory");
        }
        __syncthreads();
        peer_gather(p, tt * 256);
      }
    }
#if COOP
    if (ph + 1 < p_arg.ph_end) {
      if (ph == 0) cg::this_grid().sync();
      else xcd_barrier((unsigned*)(p.ws + OFF_BAR), (volatile XLAS unsigned*)&xb_words);
    }
#endif
  }
}

extern "C" void kernel_launch(void* const* d_in, const int* in_sizes, int n_in, void* d_out, int out_size,
                              void* d_ws, size_t ws_size, hipStream_t stream) {
  static int grid_blocks = 0;
  if (!grid_blocks) {
    int dev = 0, cus = 0, per_cu = 0;
    hipGetDevice(&dev);
    hipDeviceGetAttribute(&cus, hipDeviceAttributeMultiprocessorCount, dev);
    hipOccupancyMaxActiveBlocksPerMultiprocessor(&per_cu, mega, 512, 0);
    if (per_cu < 1) per_cu = 1;
    if (per_cu > 1) per_cu = 1;
    grid_blocks = cus * per_cu;
  }
  Params p{};
  for (int i = 0; i < 25; ++i) p.in[i] = (const float*)d_in[i];
  p.out = (float*)d_out;
  p.ws = (char*)d_ws;
#if COOP
  p.ph_begin = 0; p.ph_end = 9;
  void* args[] = {&p};
  hipError_t e = hipLaunchCooperativeKernel((void*)mega, dim3(grid_blocks), dim3(512), args, 0, stream);
  if (e != hipSuccess) fprintf(stderr, "cooperative launch failed: %s (grid %d)\n", hipGetErrorString(e), grid_blocks);
#else
  for (int ph = 0; ph < 9; ++ph) {
    p.ph_begin = ph; p.ph_end = ph + 1;
    hipLaunchKernelGGL(mega, dim3(grid_blocks), dim3(512), 0, stream, p);
  }
#endif
}
```
